# Optimizing an MI355X kernel written in HIP

```python
import jax, jax.numpy as jnp
from jax import lax
import numpy as np

D_MODEL = 1024
BATCH = 8
SEQ = 2048
DEPTH = 1
DEC_BATCH = 128
DEC_SEQ = 1
PAST_LEN = 16384
PAGE_SIZE = 128

D_MIX = 2 * D_MODEL
D_LRU = D_MIX // 2
D_SSD = D_MIX - D_LRU
LRU_HEADS = 16
LRU_BS = D_LRU // LRU_HEADS
LRU_C = 8.0
SSD_HEAD_DIM = 64
SSD_HEADS = D_SSD // SSD_HEAD_DIM
SSD_GROUPS = 2
SSD_STATE = 128
SSD_CHUNK = 128
D_XBC = D_SSD + 2 * SSD_GROUPS * SSD_STATE
CONV_W = 4
D_FF = 256 * ((8 * D_MODEL // 3 + 255) // 256)
D_IN = 2 * D_LRU + D_SSD + D_XBC + SSD_HEADS
EPS = 1e-6

kernel_name = "hymba_rglru_ssd_macaron_step"


def rmsnorm(x, g):
    xf = x.astype(jnp.float32)
    y = xf * lax.rsqrt(jnp.mean(xf * xf, axis=-1, keepdims=True) + EPS)
    return (y * g.astype(jnp.float32)).astype(x.dtype)


def swiglu(x, w_gate, w_up, w_down):
    return (jax.nn.silu(x @ w_gate) * (x @ w_up)) @ w_down


def causal_conv(x, buf, w, b):
    L = x.shape[1]
    ext = jnp.concatenate([buf.astype(x.dtype), x], axis=1)
    y = b
    for k in range(CONV_W):
        y = y + ext[:, k:k + L] * w[k]
    return y, ext[:, L:]


def _lin_combine(left, right):
    a_l, b_l = left
    a_r, b_r = right
    return a_l * a_r, a_r * b_l + b_r


def rg_lru(x, h0, gate_a_w, gate_a_b, gate_x_w, gate_x_b, lam):
    B, L, _ = x.shape
    f32 = jnp.float32
    xf = x.astype(f32)
    xb = xf.reshape(B, L, LRU_HEADS, LRU_BS)
    r = jax.nn.sigmoid(jnp.einsum('blhi,hij->blhj', xb, gate_a_w.astype(f32)).reshape(B, L, D_LRU) + gate_a_b.astype(f32))
    ig = jax.nn.sigmoid(jnp.einsum('blhi,hij->blhj', xb, gate_x_w.astype(f32)).reshape(B, L, D_LRU) + gate_x_b.astype(f32))
    log_a = -LRU_C * r * jax.nn.softplus(-lam.astype(f32))
    a = jnp.exp(log_a)
    u = jnp.sqrt(-jnp.expm1(2.0 * log_a)) * (ig * xf)
    u = u.at[:, 0].add(a[:, 0] * h0.astype(f32))
    _, h = lax.associative_scan(_lin_combine, (a, u), axis=1)
    return h, h[:, -1]


def ssd_scan(x, dt, A, Bm, Cm, h0):
    B, L, H, P = x.shape
    G, N = Bm.shape[2], Bm.shape[3]
    E = H // G
    Q = SSD_CHUNK if L >= SSD_CHUNK else L
    pad = (-L) % Q
    if pad:
        def _p(t):
            return jnp.pad(t, ((0, 0), (0, pad)) + ((0, 0),) * (t.ndim - 2))
        x, dt, Bm, Cm = _p(x), _p(dt), _p(Bm), _p(Cm)
    Lp = L + pad
    nc = Lp // Q
    xc = x.reshape(B, nc, Q, G, E, P)
    dtc = dt.reshape(B, nc, Q, G, E)
    Bc = Bm.reshape(B, nc, Q, G, N)
    Cc = Cm.reshape(B, nc, Q, G, N)
    Acs = jnp.cumsum(dtc * A.reshape(G, E), axis=2)
    seg = Acs[:, :, :, None] - Acs[:, :, None, :]
    causal = jnp.tril(jnp.ones((Q, Q), dtype=bool))[:, :, None, None]
    Lmat = jnp.exp(jnp.where(causal, seg, -jnp.inf))
    xdt = xc * dtc[..., None]
    CB = jnp.einsum('bcign,bcjgn->bcijg', Cc, Bc)
    y_diag = jnp.einsum('bcijg,bcijge,bcjgep->bcigep', CB, Lmat, xdt)
    decay_s = jnp.exp(Acs[:, :, -1:] - Acs)
    states = jnp.einsum('bcjgn,bcjge,bcjgep->bcgepn', Bc, decay_s, xdt)
    chunk_decay = jnp.exp(Acs[:, :, -1])

    def step(h, inp):
        st, dec = inp
        return h * dec[..., None, None] + st, h

    hT, h_prev = lax.scan(step, h0.reshape(B, G, E, P, N),
                          (jnp.moveaxis(states, 1, 0), jnp.moveaxis(chunk_decay, 1, 0)))
    h_prev = jnp.moveaxis(h_prev, 0, 1)
    y_off = jnp.einsum('bcign,bcige,bcgepn->bcigep', Cc, jnp.exp(Acs), h_prev)
    y = (y_diag + y_off).reshape(B, Lp, H, P)[:, :L]
    return y, hT.reshape(B, H, P, N)


def run_layer(x, lru_conv_buf, lru_h0, ssd_conv_buf, ssd_h0,
              ffn1_norm, ffn1_w_gate, ffn1_w_up, ffn1_w_down, mix_norm, w_in,
              lru_conv_w, lru_conv_b, lru_gate_a_w, lru_gate_a_b, lru_gate_x_w, lru_gate_x_b,
              lru_lambda, lru_out_norm, ssd_conv_w, ssd_conv_b, ssd_dt_bias, ssd_a_log, ssd_d,
              ssd_norm, w_out, ffn2_norm, ffn2_w_gate, ffn2_w_up, ffn2_w_down):
    B, L, _ = x.shape
    f32 = jnp.float32
    x = x + 0.5 * swiglu(rmsnorm(x, ffn1_norm), ffn1_w_gate, ffn1_w_up, ffn1_w_down)
    u = rmsnorm(x, mix_norm)
    proj = u @ w_in
    o1 = D_LRU
    o2 = 2 * D_LRU
    o3 = o2 + D_SSD
    o4 = o3 + D_XBC
    lru_x, lru_y, ssd_z, ssd_xbc, ssd_dt = jnp.split(proj, [o1, o2, o3, o4], axis=-1)
    lru_xc, new_lru_conv = causal_conv(lru_x, lru_conv_buf, lru_conv_w, lru_conv_b)
    h, lru_hT = rg_lru(lru_xc, lru_h0, lru_gate_a_w, lru_gate_a_b, lru_gate_x_w, lru_gate_x_b, lru_lambda)
    lru_out = rmsnorm(h * jax.nn.gelu(lru_y.astype(f32)), lru_out_norm).astype(x.dtype)
    xbc_c, new_ssd_conv = causal_conv(ssd_xbc, ssd_conv_buf, ssd_conv_w, ssd_conv_b)
    xbc_c = jax.nn.silu(xbc_c).astype(f32)
    xs, Bm, Cm = jnp.split(xbc_c, [D_SSD, D_SSD + SSD_GROUPS * SSD_STATE], axis=-1)
    xs = xs.reshape(B, L, SSD_HEADS, SSD_HEAD_DIM)
    Bm = Bm.reshape(B, L, SSD_GROUPS, SSD_STATE)
    Cm = Cm.reshape(B, L, SSD_GROUPS, SSD_STATE)
    dt = jax.nn.softplus(ssd_dt.astype(f32) + ssd_dt_bias.astype(f32))
    A = -jnp.exp(ssd_a_log.astype(f32))
    y, ssd_hT = ssd_scan(xs, dt, A, Bm, Cm, ssd_h0.astype(f32))
    y = (y + ssd_d.astype(f32)[:, None] * xs).reshape(B, L, D_SSD)
    gated = (y * jax.nn.silu(ssd_z.astype(f32))).reshape(B, L, SSD_GROUPS, D_SSD // SSD_GROUPS)
    ssd_out = rmsnorm(gated, ssd_norm.reshape(SSD_GROUPS, D_SSD // SSD_GROUPS)).reshape(B, L, D_SSD).astype(x.dtype)
    x = x + jnp.concatenate([lru_out, ssd_out], axis=-1) @ w_out
    x = x + 0.5 * swiglu(rmsnorm(x, ffn2_norm), ffn2_w_gate, ffn2_w_up, ffn2_w_down)
    return x, (new_lru_conv, lru_hT, new_ssd_conv, ssd_hT)


def setup_inputs(seed: int = 0) -> dict:
    key = jax.random.key(seed)
    ks = iter(jax.random.split(key, 40))

    def nrm(shape, scale):
        return jax.random.normal(next(ks), shape, jnp.float32) * scale

    def gain(shape):
        return 1.0 + nrm(shape, 0.05)

    lam_u = jax.random.uniform(next(ks), (DEPTH, D_LRU), jnp.float32, 0.9, 0.999)
    base = lam_u ** (1.0 / LRU_C)
    lru_lambda = jnp.log(base) - jnp.log1p(-base)
    dt0 = jnp.exp(jax.random.uniform(next(ks), (DEPTH, SSD_HEADS), jnp.float32, np.log(1e-3), np.log(1e-1)))
    ssd_dt_bias = dt0 + jnp.log(-jnp.expm1(-dt0))
    ssd_a_log = jnp.log(jax.random.uniform(next(ks), (DEPTH, SSD_HEADS), jnp.float32, 1.0, 16.0))
    return {
        "x_prompt": nrm((BATCH, SEQ, D_MODEL), 1.0),
        "x_sample": nrm((DEC_BATCH, DEC_SEQ, D_MODEL), 1.0),
        "state_lru_conv": nrm((DEPTH, DEC_BATCH, CONV_W - 1, D_LRU), 1.0),
        "state_lru_h": nrm((DEPTH, DEC_BATCH, D_LRU), 0.5),
        "state_ssd_conv": nrm((DEPTH, DEC_BATCH, CONV_W - 1, D_XBC), 1.0),
        "state_ssd_h": nrm((DEPTH, DEC_BATCH, SSD_HEADS, SSD_HEAD_DIM, SSD_STATE), 0.1),
        "ffn1_norm": gain((DEPTH, D_MODEL)),
        "ffn1_w_gate": nrm((DEPTH, D_MODEL, D_FF), D_MODEL ** -0.5),
        "ffn1_w_up": nrm((DEPTH, D_MODEL, D_FF), D_MODEL ** -0.5),
        "ffn1_w_down": nrm((DEPTH, D_FF, D_MODEL), D_FF ** -0.5),
        "mix_norm": gain((DEPTH, D_MODEL)),
        "w_in": nrm((DEPTH, D_MODEL, D_IN), D_MODEL ** -0.5),
        "lru_conv_w": nrm((DEPTH, CONV_W, D_LRU), CONV_W ** -0.5),
        "lru_conv_b": nrm((DEPTH, D_LRU), 0.02),
        "lru_gate_a_w": nrm((DEPTH, LRU_HEADS, LRU_BS, LRU_BS), LRU_BS ** -0.5),
        "lru_gate_a_b": nrm((DEPTH, D_LRU), 0.02),
        "lru_gate_x_w": nrm((DEPTH, LRU_HEADS, LRU_BS, LRU_BS), LRU_BS ** -0.5),
        "lru_gate_x_b": nrm((DEPTH, D_LRU), 0.02),
        "lru_lambda": lru_lambda,
        "lru_out_norm": gain((DEPTH, D_LRU)),
        "ssd_conv_w": nrm((DEPTH, CONV_W, D_XBC), CONV_W ** -0.5),
        "ssd_conv_b": nrm((DEPTH, D_XBC), 0.02),
        "ssd_dt_bias": ssd_dt_bias,
        "ssd_a_log": ssd_a_log,
        "ssd_d": 1.0 + nrm((DEPTH, SSD_HEADS), 0.1),
        "ssd_norm": gain((DEPTH, D_SSD)),
        "w_out": nrm((DEPTH, D_MIX, D_MODEL), D_MIX ** -0.5),
        "ffn2_norm": gain((DEPTH, D_MODEL)),
        "ffn2_w_gate": nrm((DEPTH, D_MODEL, D_FF), D_MODEL ** -0.5),
        "ffn2_w_up": nrm((DEPTH, D_MODEL, D_FF), D_MODEL ** -0.5),
        "ffn2_w_down": nrm((DEPTH, D_FF, D_MODEL), D_FF ** -0.5),
        "final_norm": gain((D_MODEL,)),
    }


def reference(x_prompt, x_sample, state_lru_conv, state_lru_h, state_ssd_conv, state_ssd_h,
              ffn1_norm, ffn1_w_gate, ffn1_w_up, ffn1_w_down, mix_norm, w_in,
              lru_conv_w, lru_conv_b, lru_gate_a_w, lru_gate_a_b, lru_gate_x_w, lru_gate_x_b,
              lru_lambda, lru_out_norm, ssd_conv_w, ssd_conv_b, ssd_dt_bias, ssd_a_log, ssd_d,
              ssd_norm, w_out, ffn2_norm, ffn2_w_gate, ffn2_w_up, ffn2_w_down, final_norm):
    xp = x_prompt
    xs = x_sample
    p_states = []
    s_states = []
    for l in range(DEPTH):
        lw = (ffn1_norm[l], ffn1_w_gate[l], ffn1_w_up[l], ffn1_w_down[l], mix_norm[l], w_in[l],
              lru_conv_w[l], lru_conv_b[l], lru_gate_a_w[l], lru_gate_a_b[l], lru_gate_x_w[l],
              lru_gate_x_b[l], lru_lambda[l], lru_out_norm[l], ssd_conv_w[l], ssd_conv_b[l],
              ssd_dt_bias[l], ssd_a_log[l], ssd_d[l], ssd_norm[l], w_out[l],
              ffn2_norm[l], ffn2_w_gate[l], ffn2_w_up[l], ffn2_w_down[l])
        xp, sp = run_layer(xp,
                           jnp.zeros((BATCH, CONV_W - 1, D_LRU), xp.dtype),
                           jnp.zeros((BATCH, D_LRU), jnp.float32),
                           jnp.zeros((BATCH, CONV_W - 1, D_XBC), xp.dtype),
                           jnp.zeros((BATCH, SSD_HEADS, SSD_HEAD_DIM, SSD_STATE), jnp.float32),
                           *lw)
        xs, ss = run_layer(xs, state_lru_conv[l], state_lru_h[l], state_ssd_conv[l], state_ssd_h[l], *lw)
        p_states.append(sp)
        s_states.append(ss)
    y_prompt = rmsnorm(xp, final_norm)
    y_sample = rmsnorm(xs, final_norm)
    prompt_lru_conv = jnp.stack([s[0] for s in p_states])
    prompt_lru_h = jnp.stack([s[1] for s in p_states])
    prompt_ssd_conv = jnp.stack([s[2] for s in p_states])
    prompt_ssd_h = jnp.stack([s[3] for s in p_states])
    sample_lru_conv = jnp.stack([s[0] for s in s_states])
    sample_lru_h = jnp.stack([s[1] for s in s_states])
    sample_ssd_conv = jnp.stack([s[2] for s in s_states])
    sample_ssd_h = jnp.stack([s[3] for s in s_states])
    return (y_prompt, y_sample, prompt_lru_conv, prompt_lru_h, prompt_ssd_conv, prompt_ssd_h,
            sample_lru_conv, sample_lru_h, sample_ssd_conv, sample_ssd_h)
```

```cpp
#include <hip/hip_runtime.h>
#include <cstdio>
#include <cstdint>

constexpr int TP = 16384;
constexpr int TS = 128;
constexpr int MREAL = TP + TS;
constexpr int MPAD = 16640;
constexpr int DM = 1024, FF = 2816, NGU = 2 * FF, NIN = 4624, NINP = 4864, PW = 4608, DMIX = 2048;
constexpr int SEQ = 2048, NB = 8, DLRU = 1024, DXBC = 1536, NHEAD = 16;
constexpr float EPS = 1e-6f;

namespace pg8 {
#define PG8_LAS __attribute__((address_space(3)))
typedef unsigned short bf16_t;
typedef short bf16x8 __attribute__((ext_vector_type(8)));
typedef float f32x4 __attribute__((ext_vector_type(4)));
typedef unsigned u32x4 __attribute__((ext_vector_type(4)));
typedef unsigned u32x2 __attribute__((ext_vector_type(2)));
constexpr int BM = 256, BK = 64, HALF = 128, HTB = HALF * BK * 2  , STAGE_BYTES = 8 * HTB, NXCD = 8, WGM = 8;

__host__ __device__ __forceinline__ int lds_byte(int r, int c) { const int st = (r >> 4) * 2 + (c >> 5), rr = r & 15, cc = c & 31, ob = rr * 64 + cc * 2; return st * 1024 + (ob ^ (((ob >> 9) & 1) << 5)); }
__host__ __device__ __forceinline__ void stage_rc(int b, int& R, int& C) { const int st = b / 1024, sb = b % 1024, swz = sb ^ (((sb >> 9) & 1) << 5); R = (st >> 1) * 16 + swz / 64; C = (st & 1) * 32 + (swz % 64) / 2; }
__host__ __device__ __forceinline__ int perm32(int rho) { const int n = rho >> 4, i = rho & 15; return 8 * (i >> 2) + 4 * n + (i & 3); }

struct Unit { int pm, pn; };
struct Gemm { const bf16_t* A; const bf16_t* Bt; int M, N, K, lda; };

struct StaticOrder {
    int nM, nN, nwg, G, c;
    __host__ __device__ void init(int M, int N, int G_, int c_) { nM = M / BM; nN = N / BM; nwg = nM * nN; G = G_; c = c_; }
    __host__ __device__ bool next(int i, Unit& u) const {
        const long L = (long)i * G + c; if (L >= nwg) return false;
        int wgid = (int)L; { const int q = nwg / NXCD, r = nwg % NXCD, xcd = wgid % NXCD, off = wgid / NXCD; wgid = (xcd < r ? xcd * (q + 1) : r * (q + 1) + (xcd - r) * q) + off; }
        const int nig = WGM * nN, gid = wgid / nig, fm = gid * WGM, gsz = (nM - fm) < WGM ? (nM - fm) : WGM;
        u.pm = fm + ((wgid % nig) % gsz); u.pn = (wgid % nig) / gsz; return true;
    }
    __device__ __forceinline__ void a_ready(const Unit&) const {}
    __device__ __forceinline__ void done(const Unit&) const {}
};

__device__ __forceinline__ unsigned cvt_pk_bf16(float lo, float hi) { unsigned r; asm volatile("v_cvt_pk_bf16_f32 %0, %1, %2" : "=v"(r) : "v"(lo), "v"(hi)); return r; }
__device__ __forceinline__ float silu_f(float x) { return x * __builtin_amdgcn_rcpf(1.0f + __builtin_amdgcn_exp2f(-1.44269504f * x)); }
__device__ __forceinline__ float rstd16(const float* ss) {
    const f32x4 a = *(const f32x4*)ss, b = *(const f32x4*)(ss + 4), c = *(const f32x4*)(ss + 8), d = *(const f32x4*)(ss + 12);
    const float s = (((a[0] + a[1]) + (a[2] + a[3])) + ((b[0] + b[1]) + (b[2] + b[3]))) + (((c[0] + c[1]) + (c[2] + c[3])) + ((d[0] + d[1]) + (d[2] + d[3])));
    return __builtin_amdgcn_rsqf(s * (1.0f / 1024.0f) + EPS);
}


struct EpiSwiGLU {
    static constexpr bool PERM = true, AFTER_DRAIN = false;
    bf16_t* H; const float* SS;
    __device__ __forceinline__ void operator()(const f32x4 (&acc)[2][2][4][2], const Unit& u, int wr, int wc, int fr, int fq) const {
        const int row0 = u.pm * BM + wr * 64 + fr, col0 = u.pn * HALF + wc * 32 + 8 * fq;
#pragma unroll
        for (int ai = 0; ai < 2; ++ai)
#pragma unroll
            for (int m = 0; m < 4; ++m) {
                const int row = row0 + ai * HALF + m * 16;
                const float rs = rstd16(SS + (size_t)row * 16);
                float hv[8];
#pragma unroll
                for (int n = 0; n < 2; ++n)
#pragma unroll
                    for (int j = 0; j < 4; ++j) hv[4 * n + j] = silu_f(acc[ai][0][m][n][j] * rs) * (acc[ai][1][m][n][j] * rs);
                u32x4 w; w.x = cvt_pk_bf16(hv[0], hv[1]); w.y = cvt_pk_bf16(hv[2], hv[3]); w.z = cvt_pk_bf16(hv[4], hv[5]); w.w = cvt_pk_bf16(hv[6], hv[7]);
                *(u32x4*)(H + (size_t)row * FF + col0) = w;
            }
    }
};
struct EpiResid {
    static constexpr bool PERM = false, AFTER_DRAIN = false;
    const float* basep; const float* bases; float* out; bf16_t* xbf; float* SSo; float scale;
    __device__ __forceinline__ void operator()(const f32x4 (&acc)[2][2][4][2], const Unit& u, int wr, int wc, int fr, int fq) const {
#pragma unroll
        for (int ai = 0; ai < 2; ++ai)
#pragma unroll
            for (int m = 0; m < 4; ++m) {
                const int row = u.pm * BM + ai * HALF + wr * 64 + m * 16 + fr; const bool real = row < MREAL; const int rr = real ? row : 0;
                const float* brow = rr < TP ? basep + (size_t)rr * DM : bases + (size_t)(rr - TP) * DM;
                float ss = 0.f;
#pragma unroll
                for (int bj = 0; bj < 2; ++bj)
#pragma unroll
                    for (int n = 0; n < 2; ++n) {
                        const int col = u.pn * BM + bj * HALF + wc * 32 + n * 16 + 4 * fq;
                        f32x4 v = *(const f32x4*)(brow + col) + acc[ai][bj][m][n] * scale;
                        if (!real) v = (f32x4){0.f, 0.f, 0.f, 0.f};
                        ss += (v[0] * v[0] + v[1] * v[1]) + (v[2] * v[2] + v[3] * v[3]);
                        if (real) *(f32x4*)(out + (size_t)row * DM + col) = v;
                        u32x2 w; w.x = cvt_pk_bf16(v[0], v[1]); w.y = cvt_pk_bf16(v[2], v[3]);
                        *(u32x2*)(xbf + (size_t)row * DM + col) = w;
                    }
                ss += __shfl_xor(ss, 16); ss += __shfl_xor(ss, 32);
                if (fq == 0) SSo[(size_t)row * 16 + u.pn * 4 + wc] = ss;
            }
    }
};
struct EpiP {
    static constexpr bool PERM = true, AFTER_DRAIN = false;
    bf16_t* P; float* DT; const float* SS;
    __device__ __forceinline__ void operator()(const f32x4 (&acc)[2][2][4][2], const Unit& u, int wr, int wc, int fr, int fq) const {
        const int row0 = u.pm * BM + wr * 64 + fr;
#pragma unroll
        for (int ai = 0; ai < 2; ++ai)
#pragma unroll
            for (int m = 0; m < 4; ++m) {
                const int row = row0 + ai * HALF + m * 16;
                const float rs = rstd16(SS + (size_t)row * 16);
                if (u.pn < 18) {
#pragma unroll
                    for (int bj = 0; bj < 2; ++bj) {
                        const f32x4 v0 = acc[ai][bj][m][0] * rs, v1 = acc[ai][bj][m][1] * rs;
                        u32x4 w; w.x = cvt_pk_bf16(v0[0], v0[1]); w.y = cvt_pk_bf16(v0[2], v0[3]); w.z = cvt_pk_bf16(v1[0], v1[1]); w.w = cvt_pk_bf16(v1[2], v1[3]);
                        *(u32x4*)(P + (size_t)row * PW + u.pn * BM + bj * HALF + wc * 32 + 8 * fq) = w;
                    }
                } else if (wc == 0 && fq < 2) {
                    *(f32x4*)(DT + (size_t)row * 16 + 8 * fq) = acc[ai][0][m][0] * rs;
                    *(f32x4*)(DT + (size_t)row * 16 + 8 * fq + 4) = acc[ai][0][m][1] * rs;
                }
            }
    }
};

template <class Epi, class Sched, bool ALIGN_EPI = false, bool SP2 = false>
__device__ __forceinline__ void gemm_phase(PG8_LAS unsigned char* lds, const Gemm g, const Sched& S, const Epi& E) {
    const int tid = threadIdx.x, wid = __builtin_amdgcn_readfirstlane(tid >> 6), lane = tid & 63, wr = wid >> 2, wc = wid & 3, fr = lane & 15, fq = lane >> 4;
    const int K = g.K, nt = K / BK;
    unsigned voffA[2], voffB[2];
#pragma unroll
    for (int i = 0; i < 2; ++i) { int R, C; stage_rc(tid * 16 + i * 8192, R, C); const int Rb = Epi::PERM ? ((R & ~31) + perm32(R & 31)) : R;
        voffA[i] = (unsigned)(R * g.lda + C) * 2u; voffB[i] = (unsigned)(Rb * K + C) * 2u; }
    const size_t kstep = (size_t)(BK * 2);
    const size_t hstepA = (size_t)HALF * g.lda * 2, hstepB = (size_t)HALF * K * 2;
    const size_t tstepA = 2 * hstepA, tstepB = 2 * hstepB;
    const unsigned ldsw = (unsigned)wid * 1024u;
    const int aoff = lds_byte(wr * 64 + fr, fq * 8), boff = lds_byte(wc * 32 + fr, fq * 8);
#define PG8_SA(b, h) (((b) * 2 + (h)) * HTB)
#define PG8_SB(b, h) ((4 + (b) * 2 + (h)) * HTB)
#define PG8_STAGE(bufoff, gbase, voff) do { _Pragma("unroll") for (int _i = 0; _i < 2; ++_i) \
        __builtin_amdgcn_global_load_lds((const unsigned*)((const char*)(gbase) + (voff)[_i]), (PG8_LAS unsigned*)(lds + (bufoff) + ldsw + _i * 8192), 16, 0, 0); } while (0)
#define PG8_LDA(dst, b, h) do { _Pragma("unroll") for (int m = 0; m < 4; ++m) _Pragma("unroll") for (int k = 0; k < 2; ++k) dst[m][k] = *(const PG8_LAS bf16x8*)(lds + PG8_SA(b, h) + aoff + m * 2048 + k * 1024); } while (0)
#define PG8_LDB(dst, b, h) do { _Pragma("unroll") for (int n = 0; n < 2; ++n) _Pragma("unroll") for (int k = 0; k < 2; ++k) dst[n][k] = *(const PG8_LAS bf16x8*)(lds + PG8_SB(b, h) + boff + n * 2048 + k * 1024); } while (0)
#define PG8_MMA(ai, bj, At, Bt) do { __builtin_amdgcn_s_setprio(1); _Pragma("unroll") for (int m = 0; m < 4; ++m) _Pragma("unroll") for (int n = 0; n < 2; ++n) _Pragma("unroll") for (int k = 0; k < 2; ++k) \
        acc[ai][bj][m][n] = __builtin_amdgcn_mfma_f32_16x16x32_bf16(Bt[n][k], At[m][k], acc[ai][bj][m][n], 0, 0, 0); __builtin_amdgcn_s_setprio(0); } while (0)
#define PG8_WAIT_V(n) asm volatile("s_waitcnt vmcnt(" #n ")" ::: "memory")
#define PG8_WAIT_L(n) asm volatile("s_waitcnt lgkmcnt(" #n ")" ::: "memory")
#define PG8_BAR __builtin_amdgcn_s_barrier()
#define PG8_SCHED __builtin_amdgcn_sched_barrier(0)
    Unit cur, nxt; int ui = 0;
    if (!S.next(0, cur)) return;
    f32x4 acc[2][2][4][2];
#pragma unroll
    for (int a = 0; a < 2; ++a)
#pragma unroll
        for (int b = 0; b < 2; ++b)
#pragma unroll
            for (int m = 0; m < 4; ++m)
#pragma unroll
                for (int n = 0; n < 2; ++n) acc[a][b][m][n] = (f32x4){0.f, 0.f, 0.f, 0.f};
    bf16x8 At[4][2], B0[2][2], B1[2][2];
    const char* cA = (const char*)g.A + (size_t)cur.pm * tstepA; const char* cB = (const char*)g.Bt + (size_t)cur.pn * tstepB;
    S.a_ready(cur);
    if constexpr (SP2) {
        PG8_STAGE(PG8_SB(0, 0), cB, voffB); PG8_STAGE(PG8_SB(0, 1), cB + hstepB, voffB); PG8_STAGE(PG8_SA(0, 0), cA, voffA); PG8_STAGE(PG8_SA(0, 1), cA + hstepA, voffA);
        if (wr == 1) PG8_BAR;
        PG8_WAIT_V(2); PG8_BAR;
        PG8_STAGE(PG8_SB(1, 0), cB + kstep, voffB); PG8_STAGE(PG8_SA(1, 0), cA + kstep, voffA); PG8_STAGE(PG8_SB(1, 1), cB + hstepB + kstep, voffB);
        PG8_WAIT_V(6); PG8_BAR;
    } else {
        PG8_STAGE(PG8_SB(0, 0), cB, voffB); PG8_STAGE(PG8_SA(0, 0), cA, voffA); PG8_STAGE(PG8_SB(0, 1), cB + hstepB, voffB); PG8_STAGE(PG8_SA(0, 1), cA + hstepA, voffA);
        if (wr == 1) PG8_BAR;
        PG8_WAIT_V(4); PG8_BAR;
        PG8_STAGE(PG8_SB(1, 0), cB + kstep, voffB); PG8_STAGE(PG8_SA(1, 0), cA + kstep, voffA); PG8_STAGE(PG8_SB(1, 1), cB + hstepB + kstep, voffB);
        PG8_WAIT_V(6); PG8_BAR;
    }
    for (;;) {
        const bool has_next = S.next(ui + 1, nxt);
        const char* nA = has_next ? (const char*)g.A + (size_t)nxt.pm * tstepA : cA; const char* nB = has_next ? (const char*)g.Bt + (size_t)nxt.pn * tstepB : cB;
        for (int t = 0; t < nt; t += 2) {
            const bool last = (t == nt - 2);
            const char* a1 = cA + (size_t)(t + 1) * kstep;
            const char* a2 = last ? nA : cA + (size_t)(t + 2) * kstep; const char* b2 = last ? nB : cB + (size_t)(t + 2) * kstep;
            const char* a3 = a2 + kstep; const char* b3 = b2 + kstep;
            if (last && has_next) S.a_ready(nxt);
            if constexpr (SP2) {
            PG8_LDB(B0, 0, 0); PG8_LDB(B1, 0, 1); PG8_SCHED; PG8_LDA(At, 0, 0); PG8_STAGE(PG8_SA(1, 1), a1 + hstepA, voffA);
            PG8_WAIT_V(8); PG8_WAIT_L(0); PG8_BAR; PG8_MMA(0, 0, At, B0); PG8_MMA(0, 1, At, B1); PG8_BAR; PG8_SCHED;
            PG8_LDA(At, 0, 1); PG8_STAGE(PG8_SB(0, 0), b2, voffB); PG8_STAGE(PG8_SB(0, 1), b2 + hstepB, voffB); PG8_STAGE(PG8_SA(0, 0), a2, voffA);
            PG8_WAIT_V(8); PG8_WAIT_L(0); PG8_BAR; PG8_MMA(1, 0, At, B0); PG8_MMA(1, 1, At, B1); PG8_BAR; PG8_SCHED;
            PG8_LDB(B0, 1, 0); PG8_LDB(B1, 1, 1); PG8_SCHED; PG8_LDA(At, 1, 0); PG8_STAGE(PG8_SA(0, 1), a2 + hstepA, voffA);
            PG8_WAIT_V(8); PG8_WAIT_L(0); PG8_BAR; PG8_MMA(0, 0, At, B0); PG8_MMA(0, 1, At, B1); PG8_BAR; PG8_SCHED;
            PG8_LDA(At, 1, 1); PG8_STAGE(PG8_SB(1, 0), b3, voffB); PG8_STAGE(PG8_SB(1, 1), b3 + hstepB, voffB); PG8_STAGE(PG8_SA(1, 0), a3, voffA);
            PG8_WAIT_V(8); PG8_WAIT_L(0); PG8_BAR; PG8_MMA(1, 0, At, B0); PG8_MMA(1, 1, At, B1); PG8_BAR; PG8_SCHED;
            } else {
            PG8_LDB(B0, 0, 0); PG8_SCHED; PG8_LDA(At, 0, 0); PG8_STAGE(PG8_SA(1, 1), a1 + hstepA, voffA);
            PG8_WAIT_L(8); PG8_BAR; PG8_WAIT_L(0); PG8_MMA(0, 0, At, B0); PG8_BAR; PG8_SCHED;
            PG8_LDB(B1, 0, 1); PG8_STAGE(PG8_SB(0, 0), b2, voffB);
            PG8_BAR; PG8_WAIT_L(0); PG8_MMA(0, 1, At, B1); PG8_BAR;
            PG8_LDA(At, 0, 1); PG8_STAGE(PG8_SA(0, 0), a2, voffA);
            PG8_BAR; PG8_WAIT_L(0); PG8_MMA(1, 0, At, B0); PG8_BAR; PG8_SCHED;
            PG8_STAGE(PG8_SB(0, 1), b2 + hstepB, voffB);
            PG8_WAIT_V(6); PG8_BAR; PG8_MMA(1, 1, At, B1); PG8_BAR;
            PG8_LDB(B0, 1, 0); PG8_SCHED; PG8_LDA(At, 1, 0); PG8_STAGE(PG8_SA(0, 1), a2 + hstepA, voffA);
            PG8_WAIT_L(8); PG8_BAR; PG8_WAIT_L(0); PG8_MMA(0, 0, At, B0); PG8_BAR; PG8_SCHED;
            PG8_LDB(B1, 1, 1); PG8_STAGE(PG8_SB(1, 0), b3, voffB);
            PG8_BAR; PG8_WAIT_L(0); PG8_MMA(0, 1, At, B1); PG8_BAR;
            PG8_LDA(At, 1, 1); PG8_STAGE(PG8_SA(1, 0), a3, voffA);
            PG8_BAR; PG8_WAIT_L(0); PG8_MMA(1, 0, At, B0); PG8_BAR; PG8_SCHED;
            PG8_STAGE(PG8_SB(1, 1), b3 + hstepB, voffB);
            PG8_WAIT_V(6); PG8_BAR; PG8_MMA(1, 1, At, B1); PG8_BAR;
            }
        }
        if constexpr (ALIGN_EPI) { if (wr == 0) PG8_BAR; }
        if constexpr (!Epi::AFTER_DRAIN) { E(acc, cur, wr, wc, fr, fq); S.done(cur); }
        if (!has_next) break;
#pragma unroll
        for (int a = 0; a < 2; ++a)
#pragma unroll
            for (int b = 0; b < 2; ++b)
#pragma unroll
                for (int m = 0; m < 4; ++m)
#pragma unroll
                    for (int n = 0; n < 2; ++n) acc[a][b][m][n] = (f32x4){0.f, 0.f, 0.f, 0.f};
        cur = nxt; cA = nA; cB = nB; ++ui;
        if constexpr (ALIGN_EPI) { if (wr == 1) PG8_BAR; }
    }
    PG8_WAIT_V(0);
    if constexpr (!ALIGN_EPI) { if (wr == 0) PG8_BAR; }
    PG8_BAR;
    if constexpr (Epi::AFTER_DRAIN) { E.fused(acc, cur, wr, wc, fr, fq, lds, wid, lane); S.done(cur); }
#undef PG8_SA
#undef PG8_SB
#undef PG8_STAGE
#undef PG8_LDA
#undef PG8_LDB
#undef PG8_MMA
#undef PG8_WAIT_V
#undef PG8_WAIT_L
#undef PG8_BAR
#undef PG8_SCHED
}
}

constexpr size_t MiB = 1u << 20;
constexpr size_t WS_CTL = 0, CTL_ZERO_BYTES = 1 * MiB;
constexpr size_t WS_WGU1 = 2 * MiB;
constexpr size_t WS_WD1 = 13 * MiB;
constexpr size_t WS_WIN = 19 * MiB;
constexpr size_t WS_WOUT = 29 * MiB;
constexpr size_t WS_WGU2 = 33 * MiB;
constexpr size_t WS_WD2 = 44 * MiB;
constexpr size_t WS_XBF = 50 * MiB;
constexpr size_t WS_SS0 = 83 * MiB, WS_SS1 = 85 * MiB, WS_SS2 = 87 * MiB, WS_SSL = 89 * MiB, WS_SSS = 91 * MiB;
constexpr size_t WS_DT = 93 * MiB;
constexpr size_t WS_P = 96 * MiB;
constexpr size_t WS_END = 243 * MiB;
static_assert(WS_P + (size_t)MPAD * PW * 2 <= WS_END && WS_XBF + (size_t)MPAD * DM * 2 <= WS_SS0 && WS_WD2 + (size_t)DM * FF * 2 <= WS_XBF, "d_ws map");
constexpr int CW_TMO = 0;
constexpr int CW_BAR = 4096;

constexpr size_t O_YP = 0, O_YS = 16777216, O_PLC = 16908288, O_PLH = 16932864, O_PSC = 16941056, O_PSH = 16977920,
                 O_SLC = 18026496, O_SLH = 18419712, O_SSC = 18550784, O_SSH = 19140608, O_END = 35917824;

constexpr int RING_OFF = 0, RING_BYTES = 131072;
constexpr int LDS_BYTES = 163840;
constexpr int MISC_OFF = LDS_BYTES - 256;
constexpr int NWAVES = 8;

#define GAS __attribute__((address_space(1)))
#define LAS __attribute__((address_space(3)))
typedef unsigned short bf16;
typedef unsigned v4u __attribute__((ext_vector_type(4)));
typedef float f32x4 __attribute__((ext_vector_type(4)));
typedef short bf16x8 __attribute__((ext_vector_type(8)));
typedef GAS unsigned gu32;
typedef GAS unsigned long long gu64;
#define RLX_AGENT __ATOMIC_RELAXED, __HIP_MEMORY_SCOPE_AGENT
#define LDS_WAIT() asm volatile("s_waitcnt lgkmcnt(0)" ::: "memory")
#define VM_WAIT() asm volatile("s_waitcnt vmcnt(0)" ::: "memory")
__device__ __forceinline__ unsigned long long rt() { return __builtin_amdgcn_s_memrealtime(); }
__device__ __forceinline__ unsigned f2bf(float f) { unsigned u = __builtin_bit_cast(unsigned, f); return (u + 0x7fffu + ((u >> 16) & 1u)) >> 16; }
__device__ __forceinline__ unsigned pk2(float lo, float hi) { return f2bf(lo) | (f2bf(hi) << 16); }

#define XB_TMO      128
#define XB_XCNT(j)  (256  + 64 * (j))
#define XB_XSUB(j)  (1280 + 64 * (j))
#define XB_XGEN(j)  (2304 + 64 * (j))
#define XB_TOP      3328
#define XB_TOPGEN   3392
#define XCD_BAR_WORDS 3456
#define XB_SPIN_CAP (1u << 18)

__device__ __forceinline__ unsigned xb_ld(unsigned* p)              { return __hip_atomic_load(p, __ATOMIC_RELAXED, __HIP_MEMORY_SCOPE_AGENT); }
__device__ __forceinline__ unsigned xb_add(unsigned* p, unsigned v) { return __hip_atomic_fetch_add(p, v, __ATOMIC_RELAXED, __HIP_MEMORY_SCOPE_AGENT); }
__device__ __forceinline__ unsigned xb_xcc_id() { return (unsigned)__builtin_amdgcn_s_getreg((3 << 11) | 20) & 0xFu; }
#define XB_SPIN(cond, bar) do { unsigned _sp = 0; while (cond) { __builtin_amdgcn_s_sleep(1); \
    if ((++_sp & 255u) == 0u) { if (xb_ld(&(bar)[XB_TMO])) break; if (_sp > XB_SPIN_CAP) { atomicAdd(&(bar)[XB_TMO], 1u); break; } } } } while (0)

struct XcdBarrier {
    unsigned* bar; unsigned x;
    volatile LAS unsigned* st;
};

__device__ __forceinline__ XcdBarrier xcd_barrier_post(unsigned* bar, volatile LAS unsigned* st) {
    XcdBarrier b; b.bar = bar; b.x = xb_xcc_id(); b.st = st;
    if (threadIdx.x == 0) (void)xb_add(&bar[XB_XCNT(b.x)], 1u);
    return b;
}
__device__ __forceinline__ void xcd_barrier_complete(unsigned* bar, unsigned x, unsigned& nloc, unsigned& nx) {
    const unsigned G = gridDim.x * gridDim.y * gridDim.z;
    unsigned sum, cnt, mine, sp = 0u;
    for (;;) {
        sum = 0u; cnt = 0u; mine = 0u;
#pragma unroll
        for (unsigned j = 0; j < 16; ++j) { const unsigned c = xb_ld(&bar[XB_XCNT(j)]); sum += c; cnt += (c > 0u) ? 1u : 0u; mine = (j == x) ? c : mine; }
        if (sum == G) break;
        __builtin_amdgcn_s_sleep(1);
        if ((++sp & 255u) == 0u) { if (xb_ld(&bar[XB_TMO])) break; if (sp > XB_SPIN_CAP) { atomicAdd(&bar[XB_TMO], 1u); break; } }
    }
    nloc = mine > 0u ? mine : 1u; nx = cnt > 0u ? cnt : 1u;
}

__device__ __forceinline__ void xcd_barrier(const XcdBarrier& b) {
    asm volatile("s_waitcnt vmcnt(0)" ::: "memory");
    __syncthreads();
    if (threadIdx.x == 0) {
        unsigned* bar = b.bar;
        __builtin_amdgcn_s_waitcnt(0);
        unsigned nloc = b.st[0], nx = b.st[1];
        if (nloc == 0u) { xcd_barrier_complete(bar, b.x, nloc, nx); b.st[0] = nloc; b.st[1] = nx; }
        const unsigned old = xb_add(&bar[XB_XSUB(b.x)], 1u);
        const unsigned gen = old / nloc;
        if (old + 1u == (gen + 1u) * nloc) {
            __builtin_amdgcn_fence(__ATOMIC_RELEASE, "agent");
            asm volatile("s_waitcnt vmcnt(0)" ::: "memory");
            const unsigned og = xb_add(&bar[XB_TOP], 1u);
            const unsigned tg = og / nx;
            if (og + 1u == (tg + 1u) * nx) xb_add(&bar[XB_TOPGEN], 1u);
            else XB_SPIN(xb_ld(&bar[XB_TOPGEN]) == tg, bar);
            __builtin_amdgcn_fence(__ATOMIC_ACQUIRE, "agent");
            xb_add(&bar[XB_XGEN(b.x)], 1u);
            asm volatile("s_waitcnt vmcnt(0)" ::: "memory");
        } else {
            XB_SPIN(xb_ld(&bar[XB_XGEN(b.x)]) == gen, bar);
            __builtin_amdgcn_fence(__ATOMIC_ACQUIRE, "agent");
            asm volatile("s_waitcnt vmcnt(0)" ::: "memory");
        }
    }
    __syncthreads();
}

struct Args { const float* in[32]; float* out; unsigned char* ws; };
enum { I_XP = 0, I_XS, I_SLC, I_SLH, I_SSC, I_SSH, I_F1N, I_F1G, I_F1U, I_F1D, I_MIXN, I_WIN, I_LCW, I_LCB, I_LGAW, I_LGAB, I_LGXW, I_LGXB,
       I_LAM, I_LON, I_SCW, I_SCB, I_SDTB, I_SALOG, I_SD, I_SNORM, I_WOUT, I_F2N, I_F2G, I_F2U, I_F2D, I_FINN };

__device__ __forceinline__ float wave_sum(float v) {
#pragma unroll
    for (int o = 1; o < 64; o <<= 1) v += __shfl_xor(v, o);
    return v;
}
__device__ __forceinline__ float bf_lo(unsigned w) { return __uint_as_float(w << 16); }
__device__ __forceinline__ float bf_hi(unsigned w) { return __uint_as_float(w & 0xffff0000u); }

__device__ __forceinline__ void tr_item(const float* src, int ld, int col0, int nvalid, const float* gain, int k0, bf16* dst, int K, int row0, LAS float* scr, int lane) {
    const int cc = lane & 31, ccl = cc < nvalid ? cc : 0;
#pragma unroll 8
    for (int i = 0; i < 32; ++i) { const int kk = 2 * i + (lane >> 5);
        float v = src[(size_t)(k0 + kk) * ld + col0 + ccl];
        if (gain) v *= gain[k0 + kk];
        scr[kk * 33 + cc] = cc < nvalid ? v : 0.f; }
    LDS_WAIT(); asm volatile("" ::: "memory");
    const int c = lane & 7;
#pragma unroll
    for (int j = 0; j < 4; ++j) { const int n = (lane >> 3) + 8 * j; const LAS float* s = scr + (8 * c) * 33 + n;
        v4u o; o.x = pk2(s[0 * 33], s[1 * 33]); o.y = pk2(s[2 * 33], s[3 * 33]); o.z = pk2(s[4 * 33], s[5 * 33]); o.w = pk2(s[6 * 33], s[7 * 33]);
        *(GAS v4u*)(dst + (size_t)(row0 + n) * K + k0 + 8 * c) = o; }
    LDS_WAIT(); asm volatile("" ::: "memory");
}
__device__ __forceinline__ void tr_gu(const float* wg, const float* wu, const float* gain, bf16* dst, int it, LAS float* scr, int lane) {
    constexpr int NRB = NGU / 32; const int kb = it / NRB, rb = it % NRB, tile = rb >> 3, w = rb & 7;
    tr_item(w < 4 ? wg : wu, FF, 128 * tile + 32 * (w & 3), 32, gain, 64 * kb, dst, DM, 32 * rb, scr, lane);
}
__device__ __forceinline__ void p0_prologue(const Args& a, LAS unsigned char* lds, int vcu, int G, int wave, int lane) {
    unsigned char* ws = a.ws;
    LAS float* scr = (LAS float*)(lds + wave * 16384);
    const int gw = vcu * NWAVES + wave, NGW = G * NWAVES;
    constexpr int I_GU = (DM / 64) * (NGU / 32), I_D = (FF / 64) * (DM / 32), I_IN = (DM / 64) * (NINP / 32), I_OUT = (DMIX / 64) * (DM / 32);
    constexpr int NITEMS = 2 * I_GU + 2 * I_D + I_IN + I_OUT;
    for (int it = gw; it < NITEMS; it += NGW) {
        int r = it;
        if (r < I_GU) { tr_gu(a.in[I_F1G], a.in[I_F1U], a.in[I_F1N], (bf16*)(ws + WS_WGU1), r, scr, lane); continue; } r -= I_GU;
        if (r < I_GU) { tr_gu(a.in[I_F2G], a.in[I_F2U], a.in[I_F2N], (bf16*)(ws + WS_WGU2), r, scr, lane); continue; } r -= I_GU;
        if (r < I_D) { const int kb = r / (DM / 32), rb = r % (DM / 32); tr_item(a.in[I_F1D], DM, 32 * rb, 32, nullptr, 64 * kb, (bf16*)(ws + WS_WD1), FF, 32 * rb, scr, lane); continue; } r -= I_D;
        if (r < I_D) { const int kb = r / (DM / 32), rb = r % (DM / 32); tr_item(a.in[I_F2D], DM, 32 * rb, 32, nullptr, 64 * kb, (bf16*)(ws + WS_WD2), FF, 32 * rb, scr, lane); continue; } r -= I_D;
        if (r < I_IN) { const int kb = r / (NINP / 32), rb = r % (NINP / 32); const int nv = NIN - 32 * rb < 0 ? 0 : (NIN - 32 * rb > 32 ? 32 : NIN - 32 * rb);
            tr_item(a.in[I_WIN], NIN, nv > 0 ? 32 * rb : 0, nv, a.in[I_MIXN], 64 * kb, (bf16*)(ws + WS_WIN), DM, 32 * rb, scr, lane); continue; } r -= I_IN;
        { const int kb = r / (DM / 32), rb = r % (DM / 32); const int k0 = 64 * kb;
          const float* gain = k0 < DLRU ? a.in[I_LON] : a.in[I_SNORM] - DLRU;
          tr_item(a.in[I_WOUT], DM, 32 * rb, 32, gain, k0, (bf16*)(ws + WS_WOUT), DMIX, 32 * rb, scr, lane); }
    }
    bf16* xbf = (bf16*)(ws + WS_XBF); float* ss0 = (float*)(ws + WS_SS0);
    for (int m = gw; m < MPAD; m += NGW) {
        f32x4 v[4]; float s = 0.f;
        if (m < MREAL) { const GAS f32x4* xr = (const GAS f32x4*)(m < TP ? a.in[I_XP] + (size_t)m * DM : a.in[I_XS] + (size_t)(m - TP) * DM) + lane;
#pragma unroll
            for (int j = 0; j < 4; ++j) { v[j] = xr[64 * j]; s += (v[j].x * v[j].x + v[j].y * v[j].y) + (v[j].z * v[j].z + v[j].w * v[j].w); }
        } else {
#pragma unroll
            for (int j = 0; j < 4; ++j) v[j] = (f32x4){0.f, 0.f, 0.f, 0.f};
        }
        s = wave_sum(s);
        GAS unsigned long long* o8 = (GAS unsigned long long*)(xbf + (size_t)m * DM) + lane;
#pragma unroll
        for (int j = 0; j < 4; ++j) o8[64 * j] = (unsigned long long)pk2(v[j].x, v[j].y) | ((unsigned long long)pk2(v[j].z, v[j].w) << 32);
        if (lane < 16) ss0[(size_t)m * 16 + lane] = lane == 0 ? s : 0.f;
    }
}

__device__ __forceinline__ void p9_final_norm(const Args& a, int vcu, int G, int wave, int lane) {
    const int gw = vcu * NWAVES + wave, NGW = G * NWAVES;
    const GAS f32x4* gn = (const GAS f32x4*)a.in[I_FINN] + lane;
    f32x4 gv[4];
#pragma unroll
    for (int j = 0; j < 4; ++j) gv[j] = gn[64 * j];
    for (int m = gw; m < MREAL; m += NGW) {
        GAS f32x4* xr = (GAS f32x4*)(a.out + (size_t)m * DM) + lane;
        f32x4 v[4]; float s = 0.f;
#pragma unroll
        for (int j = 0; j < 4; ++j) { v[j] = xr[64 * j]; s += (v[j].x * v[j].x + v[j].y * v[j].y) + (v[j].z * v[j].z + v[j].w * v[j].w); }
        const float rs = 1.0f / sqrtf(wave_sum(s) * (1.0f / DM) + EPS);
#pragma unroll
        for (int j = 0; j < 4; ++j) xr[64 * j] = v[j] * rs * gv[j];
    }
}

__device__ __forceinline__ float softplus_f(float x) { return x > 20.f ? x : log1pf(expf(x)); }
__device__ __forceinline__ float sigmoid_f(float x) { return 1.0f / (1.0f + expf(-x)); }
__device__ __forceinline__ float gelu_tanh_f(float y) { const float v = 0.7978845608f * (y + 0.044715f * y * y * y); const float th = 1.0f - 2.0f / (expf(2.0f * v) + 1.0f); return 0.5f * y * (1.0f + th); }
__device__ __forceinline__ float bf1(const bf16* p) { return __uint_as_float((unsigned)(*p) << 16); }
__device__ __forceinline__ bf16 f2bf1(float f) { return (bf16)f2bf(f); }

__device__ __forceinline__ void naive_lru(const Args& a, LAS float* Wl, LAS float* xcl, int hd, int row0, int nseq, int L, bool sample, int lane) {
    bf16* P = (bf16*)(a.ws + WS_P); float* SSL = (float*)(a.ws + WS_SSL);
    const float* Wa = a.in[I_LGAW] + (size_t)hd * 4096; const float* Wx = a.in[I_LGXW] + (size_t)hd * 4096;
    for (int i = 0; i < 64; ++i) { Wl[i * 64 + lane] = Wa[i * 64 + lane]; Wl[4096 + i * 64 + lane] = Wx[i * 64 + lane]; }
    LDS_WAIT();
    const int ch = hd * 64 + lane;
    const float cw0 = a.in[I_LCW][ch], cw1 = a.in[I_LCW][DLRU + ch], cw2 = a.in[I_LCW][2 * DLRU + ch], cw3 = a.in[I_LCW][3 * DLRU + ch], cb = a.in[I_LCB][ch];
    const float ba = a.in[I_LGAB][ch], bx = a.in[I_LGXB][ch], sp = 8.0f * softplus_f(-a.in[I_LAM][ch]);
    for (int s = 0; s < nseq; ++s) {
        float xm3 = 0.f, xm2 = 0.f, xm1 = 0.f, h = 0.f;
        if (sample) { xm3 = a.in[I_SLC][(size_t)(s * 3 + 0) * DLRU + ch]; xm2 = a.in[I_SLC][(size_t)(s * 3 + 1) * DLRU + ch]; xm1 = a.in[I_SLC][(size_t)(s * 3 + 2) * DLRU + ch]; h = a.in[I_SLH][(size_t)s * DLRU + ch]; }
        for (int t = 0; t < L; ++t) {
            const size_t row = (size_t)row0 + (size_t)s * L + t;
            const float x0 = bf1(P + row * PW + ch);
            const float xc = cb + cw0 * xm3 + cw1 * xm2 + cw2 * xm1 + cw3 * x0;
            xm3 = xm2; xm2 = xm1; xm1 = x0;
            xcl[lane] = xc; LDS_WAIT(); asm volatile("" ::: "memory");
            float ga = ba, gx = bx;
#pragma unroll 8
            for (int i = 0; i < 64; ++i) { const float xi = xcl[i]; ga += xi * Wl[i * 64 + lane]; gx += xi * Wl[4096 + i * 64 + lane]; }
            LDS_WAIT(); asm volatile("" ::: "memory");
            const float r = sigmoid_f(ga), ig = sigmoid_f(gx), log_a = -r * sp, av = expf(log_a), u = sqrtf(-expm1f(2.0f * log_a)) * (ig * xc);
            h = av * h + u;
            const float gv = h * gelu_tanh_f(bf1(P + row * PW + DLRU + ch));
            const float ss = wave_sum(gv * gv);
            if (lane == 0) SSL[row * 16 + hd] = ss;
            P[row * PW + DLRU + ch] = f2bf1(gv);
        }
        if (sample) { a.out[O_SLH + (size_t)s * DLRU + ch] = h;
            a.out[O_SLC + (size_t)(s * 3 + 0) * DLRU + ch] = xm3; a.out[O_SLC + (size_t)(s * 3 + 1) * DLRU + ch] = xm2; a.out[O_SLC + (size_t)(s * 3 + 2) * DLRU + ch] = xm1; }
        else { const int b = row0 / SEQ; a.out[O_PLH + (size_t)b * DLRU + ch] = h;
            a.out[O_PLC + (size_t)(b * 3 + 0) * DLRU + ch] = xm3; a.out[O_PLC + (size_t)(b * 3 + 1) * DLRU + ch] = xm2; a.out[O_PLC + (size_t)(b * 3 + 2) * DLRU + ch] = xm1; }
    }
}

__device__ __forceinline__ void naive_ssd(const Args& a, LAS float* sc, int h, int row0, int L, bool sample, int s, int tid) {
    bf16* P = (bf16*)(a.ws + WS_P); float* SSS = (float*)(a.ws + WS_SSS); const float* DT = (const float*)(a.ws + WS_DT);
    const int g = h >> 3, p = tid >> 3, nb = tid & 7;
    LAS float* xs = sc; LAS float* Bv = sc + 64; LAS float* Cv = sc + 192; LAS float* ssq = sc + 320; LAS float* dd = sc + 384;
    const float Ah = -expf(a.in[I_SALOG][h]), dtb = a.in[I_SDTB][h], Dh = a.in[I_SD][h];
    const int cch = tid < 64 ? h * 64 + tid : (tid < 192 ? 1024 + g * 128 + (tid - 64) : 1280 + g * 128 + (tid - 192));
    float cw0 = 0.f, cw1 = 0.f, cw2 = 0.f, cw3 = 0.f, cb = 0.f, xm3 = 0.f, xm2 = 0.f, xm1 = 0.f;
    if (tid < 320) { cw0 = a.in[I_SCW][cch]; cw1 = a.in[I_SCW][DXBC + cch]; cw2 = a.in[I_SCW][2 * DXBC + cch]; cw3 = a.in[I_SCW][3 * DXBC + cch]; cb = a.in[I_SCB][cch];
        if (sample) { xm3 = a.in[I_SSC][(size_t)(s * 3 + 0) * DXBC + cch]; xm2 = a.in[I_SSC][(size_t)(s * 3 + 1) * DXBC + cch]; xm1 = a.in[I_SSC][(size_t)(s * 3 + 2) * DXBC + cch]; } }
    float hst[16];
    const size_t sbase = ((size_t)(s * NHEAD + h) * 64 + p) * 128 + nb * 16;
#pragma unroll
    for (int k = 0; k < 16; ++k) hst[k] = sample ? a.in[I_SSH][sbase + k] : 0.f;
    for (int t = 0; t < L; ++t) {
        const size_t row = (size_t)row0 + t;
        if (tid < 320) { const float x0 = bf1(P + row * PW + 3072 + cch); const float v = cb + cw0 * xm3 + cw1 * xm2 + cw2 * xm1 + cw3 * x0; xm3 = xm2; xm2 = xm1; xm1 = x0;
            sc[tid] = v / (1.0f + expf(-v)); }
        if (tid == 320) { const float dt = softplus_f(DT[row * 16 + h] + dtb); dd[0] = dt; dd[1] = expf(dt * Ah); }
        __syncthreads();
        const float dt = dd[0], dA = dd[1], xp = xs[p], xdt = dt * xp; float yp = 0.f;
#pragma unroll
        for (int k = 0; k < 16; ++k) { hst[k] = hst[k] * dA + xdt * Bv[nb * 16 + k]; yp += Cv[nb * 16 + k] * hst[k]; }
        yp += __shfl_xor(yp, 1); yp += __shfl_xor(yp, 2); yp += __shfl_xor(yp, 4);
        if (nb == 0) { const float y = yp + Dh * xp; const float z = bf1(P + row * PW + 2048 + h * 64 + p); const float gv = y * (z / (1.0f + expf(-z)));
            ssq[p] = gv * gv; P[row * PW + 2048 + h * 64 + p] = f2bf1(gv); }
        __syncthreads();
        if (tid == 0) { float ssum = 0.f; for (int i = 0; i < 64; ++i) ssum += ssq[i]; SSS[row * 16 + h] = ssum; }
    }
    float* so = a.out + (sample ? O_SSH : O_PSH) + sbase;
#pragma unroll
    for (int k = 0; k < 16; ++k) so[k] = hst[k];
    if (tid < 320) { float* co = a.out + (sample ? O_SSC : O_PSC) + (size_t)(s * 3) * DXBC + cch; co[0] = xm3; co[DXBC] = xm2; co[2 * DXBC] = xm1; }
    __syncthreads();
}

__device__ __forceinline__ void mixer_phase(const Args& a, LAS unsigned char* lds, int vcu, int G, int tid) {
    const int wave = __builtin_amdgcn_readfirstlane(tid >> 6), lane = tid & 63;
    LAS float* fl = (LAS float*)lds;
    const int half = G / 2;
    if (vcu < half) {
        for (int u = vcu; u < NB * NHEAD; u += half) naive_ssd(a, fl, u & 15, (u >> 4) * SEQ, SEQ, false, u >> 4, tid);
    } else {
        const int v = vcu - half, nv = G - half;
        if (wave == 0) {
            for (int u = v; u < NB * NHEAD; u += nv) naive_lru(a, fl + 1024, fl + 1024 + 8192, u & 15, (u >> 4) * SEQ, 1, SEQ, false, lane);
            for (int u = v; u < NHEAD; u += nv) naive_lru(a, fl + 1024, fl + 1024 + 8192, u, TP, TS, 1, true, lane);
        }
        for (int u = v; u < TS * NHEAD; u += nv) naive_ssd(a, fl, u & 15, TP + (u >> 4), 1, true, u >> 4, tid);
    }
}

__device__ __forceinline__ void norm_phase(const Args& a, int vcu, int G, int wave, int lane) {
    bf16* P = (bf16*)(a.ws + WS_P); const float* SSL = (const float*)(a.ws + WS_SSL); const float* SSS = (const float*)(a.ws + WS_SSS);
    const int gw = vcu * NWAVES + wave, NGW = G * NWAVES;
    for (int m = gw; m < MREAL; m += NGW) {
        float sl = 0.f, s0 = 0.f, s1 = 0.f;
#pragma unroll
        for (int k = 0; k < 16; ++k) sl += SSL[(size_t)m * 16 + k];
#pragma unroll
        for (int k = 0; k < 8; ++k) { s0 += SSS[(size_t)m * 16 + k]; s1 += SSS[(size_t)m * 16 + 8 + k]; }
        const float rl = 1.0f / sqrtf(sl * (1.0f / 1024.0f) + EPS), r0 = 1.0f / sqrtf(s0 * (1.0f / 512.0f) + EPS), r1 = 1.0f / sqrtf(s1 * (1.0f / 512.0f) + EPS);
        GAS v4u* pr = (GAS v4u*)(P + (size_t)m * PW + DLRU) + lane;
#pragma unroll
        for (int j = 0; j < 4; ++j) { const float r = j < 2 ? rl : (j == 2 ? r0 : r1);
            v4u w = pr[64 * j];
            w.x = pk2(bf_lo(w.x) * r, bf_hi(w.x) * r); w.y = pk2(bf_lo(w.y) * r, bf_hi(w.y) * r); w.z = pk2(bf_lo(w.z) * r, bf_hi(w.z) * r); w.w = pk2(bf_lo(w.w) * r, bf_hi(w.w) * r);
            pr[64 * j] = w; }
    }
}

__global__ void __launch_bounds__(NWAVES * 64, 2) fwd_megakernel(Args args) {
    extern __shared__ __attribute__((aligned(16))) unsigned char lds_raw[];
    LAS unsigned char* lds = (LAS unsigned char*)lds_raw;
    volatile LAS unsigned* MISC = (volatile LAS unsigned*)(lds + MISC_OFF);
    const int tid = threadIdx.x, lane = tid & 63, wave = __builtin_amdgcn_readfirstlane(tid >> 6);
    const int G = gridDim.x; const int bx = blockIdx.x; const int vcu = (G % 8 == 0) ? (bx % 8) * (G / 8) + bx / 8 : bx;
    unsigned char* ws = args.ws;
    gu32* ctl = (gu32*)(ws + WS_CTL);
    if (tid < 64) MISC[tid] = 0u;
    __syncthreads();
    XcdBarrier bar = xcd_barrier_post((unsigned*)(ctl + CW_BAR), MISC + 8);
#define GRID_BAR() xcd_barrier(bar)
    bf16* const XBF = (bf16*)(ws + WS_XBF); bf16* const PB = (bf16*)(ws + WS_P); bf16* const HB = (bf16*)(ws + WS_P);
    float* const SS0 = (float*)(ws + WS_SS0); float* const SS1 = (float*)(ws + WS_SS1); float* const SS2 = (float*)(ws + WS_SS2);
    float* const DT = (float*)(ws + WS_DT);
    float* const out = args.out;

    p0_prologue(args, lds, vcu, G, wave, lane);
    GRID_BAR();
    { pg8::Gemm g{XBF, (const bf16*)(ws + WS_WGU1), MPAD, NGU, DM, DM}; pg8::StaticOrder S; S.init(MPAD, NGU, G, bx);
      pg8::EpiSwiGLU E{HB, SS0};
      pg8::gemm_phase<pg8::EpiSwiGLU, pg8::StaticOrder, true, true>(lds + RING_OFF, g, S, E); }
    GRID_BAR();
    { pg8::Gemm g{HB, (const bf16*)(ws + WS_WD1), MPAD, DM, FF, FF}; pg8::StaticOrder S; S.init(MPAD, DM, G, bx);
      pg8::EpiResid E{args.in[I_XP], args.in[I_XS], out, XBF, SS1, 0.5f};
      pg8::gemm_phase<pg8::EpiResid, pg8::StaticOrder, true, true>(lds + RING_OFF, g, S, E); }
    GRID_BAR();
    { pg8::Gemm g{XBF, (const bf16*)(ws + WS_WIN), MPAD, NINP, DM, DM}; pg8::StaticOrder S; S.init(MPAD, NINP, G, bx);
      pg8::EpiP E{PB, DT, SS1};
      pg8::gemm_phase<pg8::EpiP, pg8::StaticOrder, true, true>(lds + RING_OFF, g, S, E); }
    GRID_BAR();
    mixer_phase(args, lds, vcu, G, tid);
    GRID_BAR();
    norm_phase(args, vcu, G, wave, lane);
    GRID_BAR();
    { pg8::Gemm g{PB + DLRU, (const bf16*)(ws + WS_WOUT), MPAD, DM, DMIX, PW}; pg8::StaticOrder S; S.init(MPAD, DM, G, bx);
      pg8::EpiResid E{out, out + (size_t)TP * DM, out, XBF, SS2, 1.0f};
      pg8::gemm_phase<pg8::EpiResid, pg8::StaticOrder, true, true>(lds + RING_OFF, g, S, E); }
    GRID_BAR();
    { pg8::Gemm g{XBF, (const bf16*)(ws + WS_WGU2), MPAD, NGU, DM, DM}; pg8::StaticOrder S; S.init(MPAD, NGU, G, bx);
      pg8::EpiSwiGLU E{HB, SS2};
      pg8::gemm_phase<pg8::EpiSwiGLU, pg8::StaticOrder, true, true>(lds + RING_OFF, g, S, E); }
    GRID_BAR();
    { pg8::Gemm g{HB, (const bf16*)(ws + WS_WD2), MPAD, DM, FF, FF}; pg8::StaticOrder S; S.init(MPAD, DM, G, bx);
      pg8::EpiResid E{out, out + (size_t)TP * DM, out, XBF, SS0, 0.5f};
      pg8::gemm_phase<pg8::EpiResid, pg8::StaticOrder, true, true>(lds + RING_OFF, g, S, E); }
    GRID_BAR();
    p9_final_norm(args, vcu, G, wave, lane);
}

extern "C" void kernel_launch(void* const* d_in, const int* in_sizes, int n_in, void* d_out, int out_size, void* d_ws, size_t ws_size, hipStream_t stream) {
    static int grid = 0;
    if (grid == 0) {
        if (n_in != 32 || in_sizes[0] != TP * DM || (size_t)out_size != O_END || ws_size < WS_END) {
            fprintf(stderr, "kernel_launch: unexpected shapes: n_in %d, in0 %d, out %d, ws %zu (need >= %zu); nothing launched\n", n_in, n_in > 0 ? in_sizes[0] : -1, out_size, ws_size, (size_t)WS_END); grid = -1; return; }
        int dev = 0, cus = 0, per_cu = 0;
        if (hipGetDevice(&dev) != hipSuccess || hipDeviceGetAttribute(&cus, hipDeviceAttributeMultiprocessorCount, dev) != hipSuccess) { fprintf(stderr, "kernel_launch: device query failed\n"); grid = -1; return; }
        if (hipFuncSetAttribute((const void*)fwd_megakernel, hipFuncAttributeMaxDynamicSharedMemorySize, LDS_BYTES) != hipSuccess) { fprintf(stderr, "kernel_launch: hipFuncSetAttribute failed\n"); grid = -1; return; }
        if (hipOccupancyMaxActiveBlocksPerMultiprocessor(&per_cu, (const void*)fwd_megakernel, NWAVES * 64, LDS_BYTES) != hipSuccess || per_cu < 1) {
            fprintf(stderr, "kernel_launch: occupancy query says %d workgroups per CU\n", per_cu); per_cu = 1; }
        (void)hipGetLastError();
        grid = cus;
        fprintf(stderr, "kernel_launch: grid %d (occupancy query %d per CU), ws %zu\n", grid, per_cu, ws_size);
    }
    if (grid < 0) return;
    (void)hipMemsetAsync((char*)d_ws + WS_CTL, 0, CTL_ZERO_BYTES, stream);
    Args a{};
    for (int i = 0; i < 32; ++i) a.in[i] = (const float*)d_in[i];
    a.out = (float*)d_out; a.ws = (unsigned char*)d_ws;
    hipLaunchKernelGGL(fwd_megakernel, dim3(grid), dim3(NWAVES * 64), LDS_BYTES, stream, a);
}
```

```cpp
#include <hip/hip_runtime.h>
#include <cstdio>
#include <cstdint>

constexpr int TP = 16384;
constexpr int TS = 128;
constexpr int MREAL = TP + TS;
constexpr int MPAD = 16640;
constexpr int DM = 1024, FF = 2816, NGU = 2 * FF, NIN = 4624, NINP = 4864, PW = 4608, DMIX = 2048;
constexpr int SEQ = 2048, NB = 8, DLRU = 1024, DXBC = 1536, NHEAD = 16;
constexpr float EPS = 1e-6f;

namespace pg8 {
#define PG8_LAS __attribute__((address_space(3)))
typedef unsigned short bf16_t;
typedef short bf16x8 __attribute__((ext_vector_type(8)));
typedef float f32x4 __attribute__((ext_vector_type(4)));
typedef unsigned u32x4 __attribute__((ext_vector_type(4)));
typedef unsigned u32x2 __attribute__((ext_vector_type(2)));
constexpr int BM = 256, BK = 64, HALF = 128, HTB = HALF * BK * 2  , STAGE_BYTES = 8 * HTB, NXCD = 8, WGM = 8;

__host__ __device__ __forceinline__ int lds_byte(int r, int c) { const int st = (r >> 4) * 2 + (c >> 5), rr = r & 15, cc = c & 31, ob = rr * 64 + cc * 2; return st * 1024 + (ob ^ (((ob >> 9) & 1) << 5)); }
__host__ __device__ __forceinline__ void stage_rc(int b, int& R, int& C) { const int st = b / 1024, sb = b % 1024, swz = sb ^ (((sb >> 9) & 1) << 5); R = (st >> 1) * 16 + swz / 64; C = (st & 1) * 32 + (swz % 64) / 2; }
__host__ __device__ __forceinline__ int perm32(int rho) { const int n = rho >> 4, i = rho & 15; return 8 * (i >> 2) + 4 * n + (i & 3); }

struct Unit { int pm, pn, ui; };
struct Gemm { const bf16_t* A; const bf16_t* Bt; int M, N, K, lda; };

struct StaticOrder {
    int nM, nN, nwg, G, c;
    __host__ __device__ void init(int M, int N, int G_, int c_) { nM = M / BM; nN = N / BM; nwg = nM * nN; G = G_; c = c_; }
    __host__ __device__ bool next(int i, Unit& u) const {
        const long L = (long)i * G + c; if (L >= nwg) return false;
        int wgid = (int)L; { const int q = nwg / NXCD, r = nwg % NXCD, xcd = wgid % NXCD, off = wgid / NXCD; wgid = (xcd < r ? xcd * (q + 1) : r * (q + 1) + (xcd - r) * q) + off; }
        const int nig = WGM * nN, gid = wgid / nig, fm = gid * WGM, gsz = (nM - fm) < WGM ? (nM - fm) : WGM;
        u.pm = fm + ((wgid % nig) % gsz); u.pn = (wgid % nig) / gsz; u.ui = i; return true;
    }
    __device__ __forceinline__ void a_ready(const Unit&) const {}
    __device__ __forceinline__ void done(const Unit&) const {}
};

typedef __bf16 bf16v2 __attribute__((ext_vector_type(2)));
typedef float f32v2 __attribute__((ext_vector_type(2)));
__device__ __forceinline__ unsigned cvt_pk_bf16(float lo, float hi) { const f32v2 v = {lo, hi}; return __builtin_bit_cast(unsigned, __builtin_convertvector(v, bf16v2)); }
__device__ __forceinline__ float bfly16(float a, float b) { const auto r = __builtin_amdgcn_permlane16_swap(__builtin_bit_cast(unsigned, a), __builtin_bit_cast(unsigned, b), false, false);
    return __builtin_bit_cast(float, (unsigned)r[0]) + __builtin_bit_cast(float, (unsigned)r[1]); }
__device__ __forceinline__ float dpp_xor1(float v) { return __builtin_bit_cast(float, __builtin_amdgcn_update_dpp(0, __builtin_bit_cast(int, v), 0xB1, 0xF, 0xF, false)); }
__device__ __forceinline__ float dpp_xor2(float v) { return __builtin_bit_cast(float, __builtin_amdgcn_update_dpp(0, __builtin_bit_cast(int, v), 0x4E, 0xF, 0xF, false)); }
__device__ __forceinline__ float dpp_xor8(float v) { return __builtin_bit_cast(float, __builtin_amdgcn_update_dpp(0, __builtin_bit_cast(int, v), 0x128, 0xF, 0xF, false)); }
__device__ __forceinline__ float dpp_xor4(float v, bool bit2) { const int i = __builtin_bit_cast(int, v);
    const int a = __builtin_amdgcn_update_dpp(0, i, 0x124, 0xF, 0xF, false), b = __builtin_amdgcn_update_dpp(0, i, 0x12C, 0xF, 0xF, false);
    return __builtin_bit_cast(float, bit2 ? a : b); }
__device__ __forceinline__ float bfly32(float a, float b) { const auto r = __builtin_amdgcn_permlane32_swap(__builtin_bit_cast(unsigned, a), __builtin_bit_cast(unsigned, b), false, false);
    return __builtin_bit_cast(float, (unsigned)r[0]) + __builtin_bit_cast(float, (unsigned)r[1]); }
__device__ __forceinline__ float silu_f(float x) { return x * __builtin_amdgcn_rcpf(1.0f + __builtin_amdgcn_exp2f(-1.44269504f * x)); }
__device__ __forceinline__ float rstd16(const float* ss) {
    const f32x4 a = *(const f32x4*)ss, b = *(const f32x4*)(ss + 4), c = *(const f32x4*)(ss + 8), d = *(const f32x4*)(ss + 12);
    const float s = (((a[0] + a[1]) + (a[2] + a[3])) + ((b[0] + b[1]) + (b[2] + b[3]))) + (((c[0] + c[1]) + (c[2] + c[3])) + ((d[0] + d[1]) + (d[2] + d[3])));
    return __builtin_amdgcn_rsqf(s * (1.0f / 1024.0f) + EPS);
}

__device__ __forceinline__ float rstd_row(const float* SS, const float* SSX, int row) {
    if (SSX != nullptr && row >= TP) { const float* p = SSX + (size_t)(row - TP) * 64; float s = 0.f;
#pragma unroll
        for (int k = 0; k < 16; ++k) { const f32x4 a = *(const f32x4*)(p + 4 * k); s += (a[0] + a[1]) + (a[2] + a[3]); }
        return __builtin_amdgcn_rsqf(s * (1.0f / 1024.0f) + EPS); }
    return rstd16(SS + (size_t)row * 16);
}

template <class Sched> __device__ __forceinline__ void fill_rstd_table(const Sched& S, const float* SS, const float* SSX, PG8_LAS float* tab) {
    int t = threadIdx.x; asm volatile("" : "+v"(t));
    const int r = t & 255, i0 = t >> 8;
    int row[4]; bool ok[4]; f32x4 q[4][4];
#pragma unroll
    for (int k = 0; k < 4; ++k) { Unit u; ok[k] = (i0 + 2 * k < 8) && S.next(i0 + 2 * k, u); row[k] = ok[k] ? u.pm * BM + r : 0; }
#pragma unroll
    for (int k = 0; k < 4; ++k) if (ok[k] && !(SSX != nullptr && row[k] >= TP)) { const float* ss = SS + (size_t)row[k] * 16;
        q[k][0] = *(const f32x4*)ss; q[k][1] = *(const f32x4*)(ss + 4); q[k][2] = *(const f32x4*)(ss + 8); q[k][3] = *(const f32x4*)(ss + 12); }
#pragma unroll
    for (int k = 0; k < 4; ++k) if (ok[k]) {
        float v;
        if (SSX != nullptr && row[k] >= TP) v = rstd_row(SS, SSX, row[k]);
        else { const f32x4 a = q[k][0], b = q[k][1], c = q[k][2], d = q[k][3];
            const float s = (((a[0] + a[1]) + (a[2] + a[3])) + ((b[0] + b[1]) + (b[2] + b[3]))) + (((c[0] + c[1]) + (c[2] + c[3])) + ((d[0] + d[1]) + (d[2] + d[3])));
            v = __builtin_amdgcn_rsqf(s * (1.0f / 1024.0f) + EPS); }
        tab[(i0 + 2 * k) * 256 + r] = v; }
    __syncthreads();
}


struct EpiSwiGLU {
    static constexpr bool PERM = true, AFTER_DRAIN = false, KSEG = false;
    bf16_t* H; const PG8_LAS float* tab;
    __device__ __forceinline__ void operator()(const f32x4 (&acc)[2][2][4][2], const Unit& u, int wr, int wc, int fr, int fq) const {
        const int row0 = u.pm * BM + wr * 64 + fr, col0 = u.pn * HALF + wc * 32 + 8 * fq;
#pragma unroll
        for (int ai = 0; ai < 2; ++ai)
#pragma unroll
            for (int m = 0; m < 4; ++m) {
                const int row = row0 + ai * HALF + m * 16;
                const float rs = tab[u.ui * 256 + (row - u.pm * BM)];
                float hv[8];
#pragma unroll
                for (int n = 0; n < 2; ++n)
#pragma unroll
                    for (int j = 0; j < 4; ++j) hv[4 * n + j] = silu_f(acc[ai][0][m][n][j] * rs) * (acc[ai][1][m][n][j] * rs);
                u32x4 w; w.x = cvt_pk_bf16(hv[0], hv[1]); w.y = cvt_pk_bf16(hv[2], hv[3]); w.z = cvt_pk_bf16(hv[4], hv[5]); w.w = cvt_pk_bf16(hv[6], hv[7]);
                *(u32x4*)(H + (size_t)row * FF + col0) = w;
            }
    }
};
template <bool KSEG_, bool BBF_, bool DRAIN_ = false> struct EpiResidT {
    static constexpr bool PERM = true, AFTER_DRAIN = DRAIN_, KSEG = KSEG_;
    const float* basep; const float* bases; bf16_t* xbf; float* SSo; float scale; const PG8_LAS float* tab;
    __device__ __forceinline__ void rescale(f32x4 (&acc)[2][2][4][2], int which, int wr, int fr) const {
#pragma unroll
        for (int ai = 0; ai < 2; ++ai)
#pragma unroll
            for (int m = 0; m < 4; ++m) { const float f = tab[(ai * HALF + wr * 64 + m * 16 + fr) * 4 + which];
#pragma unroll
                for (int bj = 0; bj < 2; ++bj)
#pragma unroll
                    for (int n = 0; n < 2; ++n) acc[ai][bj][m][n] = acc[ai][bj][m][n] * f; }
    }
    __device__ __forceinline__ void finish_group(const f32x4 (&acc)[2][2][4][2], const Unit& u, int ai, int m, int wr, int wc, int fr, int fq, const f32x4 (&b)[2][2]) const {
        const int row = u.pm * BM + ai * HALF + wr * 64 + m * 16 + fr; const bool real = row < MREAL;
        const float sc = KSEG_ ? scale * tab[(ai * HALF + wr * 64 + m * 16 + fr) * 4 + 2] : scale;
        float ss = 0.f;
#pragma unroll
        for (int bj = 0; bj < 2; ++bj) {
            f32x4 v0 = b[bj][0] + acc[ai][bj][m][0] * sc, v1 = b[bj][1] + acc[ai][bj][m][1] * sc;
            if (!real) { v0 = (f32x4){0.f, 0.f, 0.f, 0.f}; v1 = v0; }
            ss += ((v0[0] * v0[0] + v0[1] * v0[1]) + (v0[2] * v0[2] + v0[3] * v0[3])) + ((v1[0] * v1[0] + v1[1] * v1[1]) + (v1[2] * v1[2] + v1[3] * v1[3]));
            u32x4 w; w.x = cvt_pk_bf16(v0[0], v0[1]); w.y = cvt_pk_bf16(v0[2], v0[3]); w.z = cvt_pk_bf16(v1[0], v1[1]); w.w = cvt_pk_bf16(v1[2], v1[3]);
            *(u32x4*)(xbf + (size_t)row * DM + u.pn * BM + bj * HALF + wc * 32 + 8 * fq) = w; }
        ss = bfly16(ss, ss); ss = bfly32(ss, ss);
        if (fq == 0) SSo[(size_t)row * 16 + u.pn * 4 + wc] = ss;
    }
    __device__ __forceinline__ void unpack_bf(const u32x4 w, f32x4 (&b)[2]) const {
        b[0] = (f32x4){__uint_as_float(w.x << 16), __uint_as_float(w.x & 0xffff0000u), __uint_as_float(w.y << 16), __uint_as_float(w.y & 0xffff0000u)};
        b[1] = (f32x4){__uint_as_float(w.z << 16), __uint_as_float(w.z & 0xffff0000u), __uint_as_float(w.w << 16), __uint_as_float(w.w & 0xffff0000u)}; }
    __device__ __forceinline__ void operator()(const f32x4 (&acc)[2][2][4][2], const Unit& u, int wr, int wc, int fr, int fq) const {
#pragma unroll
        for (int ai = 0; ai < 2; ++ai)
#pragma unroll
            for (int m = 0; m < 4; ++m) {
                const int row = u.pm * BM + ai * HALF + wr * 64 + m * 16 + fr; const int rr = row < MREAL ? row : 0;
                const float* brow = rr < TP ? basep + (size_t)rr * DM : bases + (size_t)(rr - TP) * DM;
                f32x4 b[2][2];
#pragma unroll
                for (int bj = 0; bj < 2; ++bj) { const int col = u.pn * BM + bj * HALF + wc * 32 + 8 * fq;
                    if (BBF_) unpack_bf(*(const u32x4*)(xbf + (size_t)row * DM + col), b[bj]);
                    else { b[bj][0] = *(const f32x4*)(brow + col); b[bj][1] = *(const f32x4*)(brow + col + 4); } }
                finish_group(acc, u, ai, m, wr, wc, fr, fq, b);
            }
    }
    __device__ __forceinline__ void fused(const f32x4 (&acc)[2][2][4][2], const Unit& u, int wr, int wc, int fr, int fq, PG8_LAS unsigned char*, int, int) const {
        static_assert(!DRAIN_ || BBF_, "the drained epilogue preloads a bf16 residual tile");
        u32x4 pre[2][4][2];
#pragma unroll
        for (int ai = 0; ai < 2; ++ai)
#pragma unroll
            for (int m = 0; m < 4; ++m)
#pragma unroll
                for (int bj = 0; bj < 2; ++bj) pre[ai][m][bj] = *(const u32x4*)(xbf + (size_t)(u.pm * BM + ai * HALF + wr * 64 + m * 16 + fr) * DM + u.pn * BM + bj * HALF + wc * 32 + 8 * fq);
#pragma unroll
        for (int ai = 0; ai < 2; ++ai)
#pragma unroll
            for (int m = 0; m < 4; ++m) { f32x4 b[2][2]; unpack_bf(pre[ai][m][0], b[0]); unpack_bf(pre[ai][m][1], b[1]); finish_group(acc, u, ai, m, wr, wc, fr, fq, b); }
    }
};
struct SegOrder : StaticOrder {
    const float* SSL; const float* SSS; PG8_LAS float* tab;
    __device__ __forceinline__ void a_ready(const Unit& u) const {
        const int t = threadIdx.x;
        if (t < 256) { const size_t row = (size_t)u.pm * BM + t; float sl = 0.f, s0 = 0.f, s1 = 0.f;
#pragma unroll
            for (int k = 0; k < 4; ++k) { const f32x4 a = *(const f32x4*)(SSL + row * 16 + 4 * k); sl += (a[0] + a[1]) + (a[2] + a[3]); }
#pragma unroll
            for (int k = 0; k < 2; ++k) { const f32x4 a = *(const f32x4*)(SSS + row * 16 + 4 * k), b = *(const f32x4*)(SSS + row * 16 + 8 + 4 * k); s0 += (a[0] + a[1]) + (a[2] + a[3]); s1 += (b[0] + b[1]) + (b[2] + b[3]); }
            const float r0 = 1.0f / sqrtf(sl * (1.0f / 1024.0f) + EPS), r1 = 1.0f / sqrtf(s0 * (1.0f / 512.0f) + EPS), r2 = 1.0f / sqrtf(s1 * (1.0f / 512.0f) + EPS);
            *(PG8_LAS f32x4*)(tab + t * 4) = (f32x4){r0 / r1, r1 / r2, r2, 0.f}; }
        asm volatile("s_waitcnt lgkmcnt(0)" ::: "memory"); __builtin_amdgcn_s_barrier(); asm volatile("" ::: "memory");
    }
};
struct EpiP {
    static constexpr bool PERM = true, AFTER_DRAIN = false, KSEG = false;
    bf16_t* P; float* DT; const PG8_LAS float* tab;
    __device__ __forceinline__ void operator()(const f32x4 (&acc)[2][2][4][2], const Unit& u, int wr, int wc, int fr, int fq) const {
        const int row0 = u.pm * BM + wr * 64 + fr;
#pragma unroll
        for (int ai = 0; ai < 2; ++ai)
#pragma unroll
            for (int m = 0; m < 4; ++m) {
                const int row = row0 + ai * HALF + m * 16;
                const float rs = tab[u.ui * 256 + (row - u.pm * BM)];
                if (u.pn < 18) {
#pragma unroll
                    for (int bj = 0; bj < 2; ++bj) {
                        const f32x4 v0 = acc[ai][bj][m][0] * rs, v1 = acc[ai][bj][m][1] * rs;
                        u32x4 w; w.x = cvt_pk_bf16(v0[0], v0[1]); w.y = cvt_pk_bf16(v0[2], v0[3]); w.z = cvt_pk_bf16(v1[0], v1[1]); w.w = cvt_pk_bf16(v1[2], v1[3]);
                        *(u32x4*)(P + (size_t)row * PW + u.pn * BM + bj * HALF + wc * 32 + 8 * fq) = w;
                    }
                } else if (wc == 0 && fq < 2) {
                    *(f32x4*)(DT + (size_t)row * 16 + 8 * fq) = acc[ai][0][m][0] * rs;
                    *(f32x4*)(DT + (size_t)row * 16 + 8 * fq + 4) = acc[ai][0][m][1] * rs;
                }
            }
    }
};

template <class Epi, class Sched, bool ALIGN_EPI = false, bool SP2 = false>
__device__ __forceinline__ void gemm_phase(PG8_LAS unsigned char* lds, const Gemm g, const Sched& S, const Epi& E) {
    int tid_ = threadIdx.x; asm volatile("" : "+v"(tid_));
    const int tid = tid_, wid = __builtin_amdgcn_readfirstlane(tid >> 6), lane = tid & 63, wr = wid >> 2, wc = wid & 3, fr = lane & 15, fq = lane >> 4;
    const int K = g.K, nt = K / BK;
    unsigned voffA[2], voffB[2];
#pragma unroll
    for (int i = 0; i < 2; ++i) { int R, C; stage_rc(tid * 16 + i * 8192, R, C); const int Rb = Epi::PERM ? ((R & ~31) + perm32(R & 31)) : R;
        voffA[i] = (unsigned)(R * g.lda + C) * 2u; voffB[i] = (unsigned)(Rb * K + C) * 2u; }
    const size_t kstep = (size_t)(BK * 2);
    const size_t hstepA = (size_t)HALF * g.lda * 2, hstepB = (size_t)HALF * K * 2;
    const size_t tstepA = 2 * hstepA, tstepB = 2 * hstepB;
    const unsigned ldsw = (unsigned)wid * 1024u;
    const int aoff = lds_byte(wr * 64 + fr, fq * 8), boff = lds_byte(wc * 32 + fr, fq * 8);
#define PG8_SA(b, h) (((b) * 2 + (h)) * HTB)
#define PG8_SB(b, h) ((4 + (b) * 2 + (h)) * HTB)
#define PG8_STAGE(bufoff, gbase, voff) do { _Pragma("unroll") for (int _i = 0; _i < 2; ++_i) \
        __builtin_amdgcn_global_load_lds((const unsigned*)((const char*)(gbase) + (voff)[_i]), (PG8_LAS unsigned*)(lds + (bufoff) + ldsw + _i * 8192), 16, 0, 0); } while (0)
#define PG8_LDA(dst, b, h) do { _Pragma("unroll") for (int m = 0; m < 4; ++m) _Pragma("unroll") for (int k = 0; k < 2; ++k) dst[m][k] = *(const PG8_LAS bf16x8*)(lds + PG8_SA(b, h) + aoff + m * 2048 + k * 1024); } while (0)
#define PG8_LDB(dst, b, h) do { _Pragma("unroll") for (int n = 0; n < 2; ++n) _Pragma("unroll") for (int k = 0; k < 2; ++k) dst[n][k] = *(const PG8_LAS bf16x8*)(lds + PG8_SB(b, h) + boff + n * 2048 + k * 1024); } while (0)
#define PG8_MMA(ai, bj, At, Bt) do { __builtin_amdgcn_s_setprio(1); _Pragma("unroll") for (int m = 0; m < 4; ++m) _Pragma("unroll") for (int n = 0; n < 2; ++n) _Pragma("unroll") for (int k = 0; k < 2; ++k) \
        acc[ai][bj][m][n] = __builtin_amdgcn_mfma_f32_16x16x32_bf16(Bt[n][k], At[m][k], acc[ai][bj][m][n], 0, 0, 0); __builtin_amdgcn_s_setprio(0); } while (0)
#define PG8_WAIT_V(n) asm volatile("s_waitcnt vmcnt(" #n ")" ::: "memory")
#define PG8_WAIT_L(n) asm volatile("s_waitcnt lgkmcnt(" #n ")" ::: "memory")
#define PG8_BAR __builtin_amdgcn_s_barrier()
#define PG8_SCHED __builtin_amdgcn_sched_barrier(0)
#if defined(PROBE_GEMM)
#define PG8_PSTAMP(j_) do { if (blockIdx.x == 0 && threadIdx.x == 0) { volatile PG8_LAS unsigned* ms_ = (volatile PG8_LAS unsigned*)(lds + (163840 - 1024)); const unsigned ix_ = ms_[60]; const unsigned long long t_ = __builtin_amdgcn_s_memrealtime(); \
        ms_[64 + 6 * ix_ + 2 * (j_)] = (unsigned)t_; ms_[65 + 6 * ix_ + 2 * (j_)] = (unsigned)(t_ >> 32); if ((j_) == 2) ms_[60] = ix_ + 1; } } while (0)
#else
#define PG8_PSTAMP(j_) do { } while (0)
#endif
    Unit cur, nxt; int ui = 0;
    if (!S.next(0, cur)) return;
    PG8_PSTAMP(0);
    f32x4 acc[2][2][4][2];
#pragma unroll
    for (int a = 0; a < 2; ++a)
#pragma unroll
        for (int b = 0; b < 2; ++b)
#pragma unroll
            for (int m = 0; m < 4; ++m)
#pragma unroll
                for (int n = 0; n < 2; ++n) acc[a][b][m][n] = (f32x4){0.f, 0.f, 0.f, 0.f};
    bf16x8 At[4][2], B0[2][2], B1[2][2];
    const char* cA = (const char*)g.A + (size_t)cur.pm * tstepA; const char* cB = (const char*)g.Bt + (size_t)cur.pn * tstepB;
    S.a_ready(cur);
    if constexpr (SP2) {
        PG8_STAGE(PG8_SB(0, 0), cB, voffB); PG8_STAGE(PG8_SB(0, 1), cB + hstepB, voffB); PG8_STAGE(PG8_SA(0, 0), cA, voffA); PG8_STAGE(PG8_SA(0, 1), cA + hstepA, voffA);
        if (wr == 1) PG8_BAR;
        PG8_WAIT_V(2); PG8_BAR;
        PG8_STAGE(PG8_SB(1, 0), cB + kstep, voffB); PG8_STAGE(PG8_SA(1, 0), cA + kstep, voffA); PG8_STAGE(PG8_SB(1, 1), cB + hstepB + kstep, voffB);
        PG8_WAIT_V(6); PG8_BAR;
    } else {
        PG8_STAGE(PG8_SB(0, 0), cB, voffB); PG8_STAGE(PG8_SA(0, 0), cA, voffA); PG8_STAGE(PG8_SB(0, 1), cB + hstepB, voffB); PG8_STAGE(PG8_SA(0, 1), cA + hstepA, voffA);
        if (wr == 1) PG8_BAR;
        PG8_WAIT_V(4); PG8_BAR;
        PG8_STAGE(PG8_SB(1, 0), cB + kstep, voffB); PG8_STAGE(PG8_SA(1, 0), cA + kstep, voffA); PG8_STAGE(PG8_SB(1, 1), cB + hstepB + kstep, voffB);
        PG8_WAIT_V(6); PG8_BAR;
    }
    for (;;) {
        const bool has_next = S.next(ui + 1, nxt);
        const char* nA = has_next ? (const char*)g.A + (size_t)nxt.pm * tstepA : cA; const char* nB = has_next ? (const char*)g.Bt + (size_t)nxt.pn * tstepB : cB;
        for (int t = 0; t < nt; t += 2) {
            if constexpr (Epi::KSEG) { if (t == 16 || t == 24) E.rescale(acc, t == 16 ? 0 : 1, wr, fr); }
            const bool last = (t == nt - 2);
            const char* a1 = cA + (size_t)(t + 1) * kstep;
            const char* a2 = last ? nA : cA + (size_t)(t + 2) * kstep; const char* b2 = last ? nB : cB + (size_t)(t + 2) * kstep;
            const char* a3 = a2 + kstep; const char* b3 = b2 + kstep;
            if (last && has_next) S.a_ready(nxt);
            if constexpr (SP2) {
            PG8_LDB(B0, 0, 0); PG8_LDB(B1, 0, 1); PG8_SCHED; PG8_LDA(At, 0, 0); PG8_STAGE(PG8_SA(1, 1), a1 + hstepA, voffA);
            PG8_WAIT_V(8); PG8_WAIT_L(0); PG8_BAR; PG8_MMA(0, 0, At, B0); PG8_MMA(0, 1, At, B1); PG8_BAR; PG8_SCHED;
            PG8_LDA(At, 0, 1); PG8_STAGE(PG8_SB(0, 0), b2, voffB); PG8_STAGE(PG8_SB(0, 1), b2 + hstepB, voffB); PG8_STAGE(PG8_SA(0, 0), a2, voffA);
            PG8_WAIT_V(8); PG8_WAIT_L(0); PG8_BAR; PG8_MMA(1, 0, At, B0); PG8_MMA(1, 1, At, B1); PG8_BAR; PG8_SCHED;
            PG8_LDB(B0, 1, 0); PG8_LDB(B1, 1, 1); PG8_SCHED; PG8_LDA(At, 1, 0); PG8_STAGE(PG8_SA(0, 1), a2 + hstepA, voffA);
            PG8_WAIT_V(8); PG8_WAIT_L(0); PG8_BAR; PG8_MMA(0, 0, At, B0); PG8_MMA(0, 1, At, B1); PG8_BAR; PG8_SCHED;
            PG8_LDA(At, 1, 1); PG8_STAGE(PG8_SB(1, 0), b3, voffB); PG8_STAGE(PG8_SB(1, 1), b3 + hstepB, voffB); PG8_STAGE(PG8_SA(1, 0), a3, voffA);
            PG8_WAIT_V(8); PG8_WAIT_L(0); PG8_BAR; PG8_MMA(1, 0, At, B0); PG8_MMA(1, 1, At, B1); PG8_BAR; PG8_SCHED;
            } else {
            PG8_LDB(B0, 0, 0); PG8_SCHED; PG8_LDA(At, 0, 0); PG8_STAGE(PG8_SA(1, 1), a1 + hstepA, voffA);
            PG8_WAIT_L(8); PG8_BAR; PG8_WAIT_L(0); PG8_MMA(0, 0, At, B0); PG8_BAR; PG8_SCHED;
            PG8_LDB(B1, 0, 1); PG8_STAGE(PG8_SB(0, 0), b2, voffB);
            PG8_BAR; PG8_WAIT_L(0); PG8_MMA(0, 1, At, B1); PG8_BAR;
            PG8_LDA(At, 0, 1); PG8_STAGE(PG8_SA(0, 0), a2, voffA);
            PG8_BAR; PG8_WAIT_L(0); PG8_MMA(1, 0, At, B0); PG8_BAR; PG8_SCHED;
            PG8_STAGE(PG8_SB(0, 1), b2 + hstepB, voffB);
            PG8_WAIT_V(6); PG8_BAR; PG8_MMA(1, 1, At, B1); PG8_BAR;
            PG8_LDB(B0, 1, 0); PG8_SCHED; PG8_LDA(At, 1, 0); PG8_STAGE(PG8_SA(0, 1), a2 + hstepA, voffA);
            PG8_WAIT_L(8); PG8_BAR; PG8_WAIT_L(0); PG8_MMA(0, 0, At, B0); PG8_BAR; PG8_SCHED;
            PG8_LDB(B1, 1, 1); PG8_STAGE(PG8_SB(1, 0), b3, voffB);
            PG8_BAR; PG8_WAIT_L(0); PG8_MMA(0, 1, At, B1); PG8_BAR;
            PG8_LDA(At, 1, 1); PG8_STAGE(PG8_SA(1, 0), a3, voffA);
            PG8_BAR; PG8_WAIT_L(0); PG8_MMA(1, 0, At, B0); PG8_BAR; PG8_SCHED;
            PG8_STAGE(PG8_SB(1, 1), b3 + hstepB, voffB);
            PG8_WAIT_V(6); PG8_BAR; PG8_MMA(1, 1, At, B1); PG8_BAR;
            }
        }
        if constexpr (ALIGN_EPI) { if (wr == 0) PG8_BAR; }
        if (!has_next) PG8_PSTAMP(1);
        if constexpr (!Epi::AFTER_DRAIN) { E(acc, cur, wr, wc, fr, fq); S.done(cur); }
        if (!has_next) break;
#pragma unroll
        for (int a = 0; a < 2; ++a)
#pragma unroll
            for (int b = 0; b < 2; ++b)
#pragma unroll
                for (int m = 0; m < 4; ++m)
#pragma unroll
                    for (int n = 0; n < 2; ++n) acc[a][b][m][n] = (f32x4){0.f, 0.f, 0.f, 0.f};
        cur = nxt; cA = nA; cB = nB; ++ui;
        if constexpr (ALIGN_EPI) { if (wr == 1) PG8_BAR; }
    }
    PG8_PSTAMP(2);
    PG8_WAIT_V(0);
    if constexpr (!ALIGN_EPI) { if (wr == 0) PG8_BAR; }
    PG8_BAR;
    if constexpr (Epi::AFTER_DRAIN) { E.fused(acc, cur, wr, wc, fr, fq, lds, wid, lane); S.done(cur); }
#undef PG8_SA
#undef PG8_SB
#undef PG8_STAGE
#undef PG8_LDA
#undef PG8_LDB
#undef PG8_MMA
#undef PG8_WAIT_V
#undef PG8_WAIT_L
#undef PG8_BAR
#undef PG8_SCHED
}
}

constexpr size_t MiB = 1u << 20;
constexpr size_t WS_CTL = 0, CTL_ZERO_BYTES = 1 * MiB;
constexpr size_t WS_WGU1 = 2 * MiB;
constexpr size_t WS_WD1 = 13 * MiB;
constexpr size_t WS_WIN = 19 * MiB;
constexpr size_t WS_WOUT = 29 * MiB;
constexpr size_t WS_WGU2 = 33 * MiB;
constexpr size_t WS_WD2 = 44 * MiB;
constexpr size_t WS_XBF = 50 * MiB;
constexpr size_t WS_SS0 = 83 * MiB, WS_SS1 = 85 * MiB, WS_SS2 = 87 * MiB, WS_SSL = 89 * MiB, WS_SSS = 91 * MiB;
constexpr size_t WS_SSX1 = WS_SS1 + 3 * MiB / 2, WS_SSX2 = WS_SS2 + 3 * MiB / 2;
constexpr size_t WS_DT = 93 * MiB;
constexpr size_t WS_P = 96 * MiB;
constexpr size_t WS_END = 243 * MiB;
static_assert(WS_P + (size_t)MPAD * PW * 2 <= WS_END && WS_XBF + (size_t)MPAD * DM * 2 <= WS_SS0 && WS_WD2 + (size_t)DM * FF * 2 <= WS_XBF, "d_ws map");
constexpr int CW_TMO = 0;
constexpr int CW_BAR = 4096;

constexpr size_t O_YP = 0, O_YS = 16777216, O_PLC = 16908288, O_PLH = 16932864, O_PSC = 16941056, O_PSH = 16977920,
                 O_SLC = 18026496, O_SLH = 18419712, O_SSC = 18550784, O_SSH = 19140608, O_END = 35917824;

constexpr int RING_OFF = 0, RING_BYTES = 131072;
constexpr int LDS_BYTES = 163840;
constexpr int MISC_OFF = LDS_BYTES - 1024;
constexpr int NWAVES = 8;

#define GAS __attribute__((address_space(1)))
#define LAS __attribute__((address_space(3)))
typedef unsigned short bf16;
typedef unsigned v4u __attribute__((ext_vector_type(4)));
typedef float f32x4 __attribute__((ext_vector_type(4)));
typedef short bf16x8 __attribute__((ext_vector_type(8)));
typedef GAS unsigned gu32;
typedef GAS unsigned long long gu64;
#define RLX_AGENT __ATOMIC_RELAXED, __HIP_MEMORY_SCOPE_AGENT
#define LDS_WAIT() asm volatile("s_waitcnt lgkmcnt(0)" ::: "memory")
#define VM_WAIT() asm volatile("s_waitcnt vmcnt(0)" ::: "memory")
__device__ __forceinline__ unsigned long long rt() { return __builtin_amdgcn_s_memrealtime(); }
__device__ __forceinline__ unsigned f2bf(float f) { unsigned u = __builtin_bit_cast(unsigned, f); return (u + 0x7fffu + ((u >> 16) & 1u)) >> 16; }
__device__ __forceinline__ unsigned pk2(float lo, float hi) { return f2bf(lo) | (f2bf(hi) << 16); }

#define XB_TMO      128
#define XB_XCNT(j)  (256  + 64 * (j))
#define XB_XSUB(j)  (1280 + 64 * (j))
#define XB_XGEN(j)  (2304 + 64 * (j))
#define XB_TOP      3328
#define XB_TOPGEN   3392
#define XCD_BAR_WORDS 3456
#define XB_SPIN_CAP (1u << 18)

__device__ __forceinline__ unsigned xb_ld(unsigned* p)              { return __hip_atomic_load(p, __ATOMIC_RELAXED, __HIP_MEMORY_SCOPE_AGENT); }
__device__ __forceinline__ unsigned xb_add(unsigned* p, unsigned v) { return __hip_atomic_fetch_add(p, v, __ATOMIC_RELAXED, __HIP_MEMORY_SCOPE_AGENT); }
__device__ __forceinline__ unsigned xb_xcc_id() { return (unsigned)__builtin_amdgcn_s_getreg((3 << 11) | 20) & 0xFu; }
#define XB_SPIN(cond, bar) do { unsigned _sp = 0; while (cond) { __builtin_amdgcn_s_sleep(1); \
    if ((++_sp & 255u) == 0u) { if (xb_ld(&(bar)[XB_TMO])) break; if (_sp > XB_SPIN_CAP) { atomicAdd(&(bar)[XB_TMO], 1u); break; } } } } while (0)

struct XcdBarrier {
    unsigned* bar; unsigned x;
    volatile LAS unsigned* st;
};

__device__ __forceinline__ XcdBarrier xcd_barrier_post(unsigned* bar, volatile LAS unsigned* st) {
    XcdBarrier b; b.bar = bar; b.x = xb_xcc_id(); b.st = st;
    if (threadIdx.x == 0) (void)xb_add(&bar[XB_XCNT(b.x)], 1u);
    return b;
}
__device__ __forceinline__ void xcd_barrier_complete(unsigned* bar, unsigned x, unsigned& nloc, unsigned& nx) {
    const unsigned G = gridDim.x * gridDim.y * gridDim.z;
    unsigned sum, cnt, mine, sp = 0u;
    for (;;) {
        sum = 0u; cnt = 0u; mine = 0u;
#pragma unroll
        for (unsigned j = 0; j < 16; ++j) { const unsigned c = xb_ld(&bar[XB_XCNT(j)]); sum += c; cnt += (c > 0u) ? 1u : 0u; mine = (j == x) ? c : mine; }
        if (sum == G) break;
        __builtin_amdgcn_s_sleep(1);
        if ((++sp & 255u) == 0u) { if (xb_ld(&bar[XB_TMO])) break; if (sp > XB_SPIN_CAP) { atomicAdd(&bar[XB_TMO], 1u); break; } }
    }
    nloc = mine > 0u ? mine : 1u; nx = cnt > 0u ? cnt : 1u;
}

__device__ __forceinline__ void xcd_barrier(const XcdBarrier& b) {
    asm volatile("s_waitcnt vmcnt(0)" ::: "memory");
    __syncthreads();
    if (threadIdx.x == 0) {
        unsigned* bar = b.bar;
        __builtin_amdgcn_s_waitcnt(0);
        unsigned nloc = b.st[0], nx = b.st[1];
        if (nloc == 0u) { xcd_barrier_complete(bar, b.x, nloc, nx); b.st[0] = nloc; b.st[1] = nx; }
        const unsigned old = xb_add(&bar[XB_XSUB(b.x)], 1u);
        const unsigned gen = old / nloc;
        if (old + 1u == (gen + 1u) * nloc) {
            __builtin_amdgcn_fence(__ATOMIC_RELEASE, "agent");
            asm volatile("s_waitcnt vmcnt(0)" ::: "memory");
            const unsigned og = xb_add(&bar[XB_TOP], 1u);
            const unsigned tg = og / nx;
            if (og + 1u == (tg + 1u) * nx) xb_add(&bar[XB_TOPGEN], 1u);
            else XB_SPIN(xb_ld(&bar[XB_TOPGEN]) == tg, bar);
            __builtin_amdgcn_fence(__ATOMIC_ACQUIRE, "agent");
            xb_add(&bar[XB_XGEN(b.x)], 1u);
            asm volatile("s_waitcnt vmcnt(0)" ::: "memory");
        } else {
            XB_SPIN(xb_ld(&bar[XB_XGEN(b.x)]) == gen, bar);
            __builtin_amdgcn_fence(__ATOMIC_ACQUIRE, "agent");
            asm volatile("s_waitcnt vmcnt(0)" ::: "memory");
        }
    }
    __syncthreads();
}

struct Args { const float* in[32]; float* out; unsigned char* ws; };
enum { I_XP = 0, I_XS, I_SLC, I_SLH, I_SSC, I_SSH, I_F1N, I_F1G, I_F1U, I_F1D, I_MIXN, I_WIN, I_LCW, I_LCB, I_LGAW, I_LGAB, I_LGXW, I_LGXB,
       I_LAM, I_LON, I_SCW, I_SCB, I_SDTB, I_SALOG, I_SD, I_SNORM, I_WOUT, I_F2N, I_F2G, I_F2U, I_F2D, I_FINN };

__device__ __forceinline__ float wave_sum(float v) {
#pragma unroll
    for (int o = 1; o < 64; o <<= 1) v += __shfl_xor(v, o);
    return v;
}
__device__ __forceinline__ float bf_lo(unsigned w) { return __uint_as_float(w << 16); }
__device__ __forceinline__ float bf_hi(unsigned w) { return __uint_as_float(w & 0xffff0000u); }

__device__ __forceinline__ void tr_item(const float* src, int ld, int col0, int nvalid, const float* gain, int k0, bf16* dst, int K, int row0, LAS float* scr, int lane) {
    const int ksub = lane >> 4, n4 = (lane & 15) * 4;
    f32x4 v[16];
    const bool ok = n4 < nvalid;
    const float* sp = src + (size_t)(k0 + ksub) * ld + col0 + (ok ? n4 : 0);
    float gq[16];
#pragma unroll
    for (int i = 0; i < 16; ++i) gq[i] = gain ? gain[k0 + 4 * i + ksub] : 1.0f;
#pragma unroll
    for (int i = 0; i < 16; ++i) v[i] = __builtin_nontemporal_load((const f32x4*)(sp + (size_t)(4 * i) * ld));
#pragma unroll
    for (int i = 0; i < 16; ++i) { const int kk = 4 * i + ksub; const float gg = gq[i];
        f32x4 x = ok ? v[i] * gg : (f32x4){0.f, 0.f, 0.f, 0.f};
        LAS float* d = scr + kk * 65 + n4; d[0] = x[0]; d[1] = x[1]; d[2] = x[2]; d[3] = x[3]; }
    LDS_WAIT(); asm volatile("" ::: "memory");
    const int c = lane & 7;
#pragma unroll
    for (int j = 0; j < 8; ++j) { const int n = (lane >> 3) + 8 * j; const LAS float* s = scr + (8 * c) * 65 + n;
        v4u o; o.x = pg8::cvt_pk_bf16(s[0 * 65], s[1 * 65]); o.y = pg8::cvt_pk_bf16(s[2 * 65], s[3 * 65]); o.z = pg8::cvt_pk_bf16(s[4 * 65], s[5 * 65]); o.w = pg8::cvt_pk_bf16(s[6 * 65], s[7 * 65]);
        *(GAS v4u*)(dst + (size_t)(row0 + n) * K + k0 + 8 * c) = o; }
    LDS_WAIT(); asm volatile("" ::: "memory");
}
__device__ __forceinline__ void tr_gu(const float* wg, const float* wu, const float* gain, bf16* dst, int it, LAS float* scr, int lane) {
    constexpr int NRB = NGU / 64; const int kb = it / NRB, rb = it % NRB, tile = rb >> 2, w = rb & 3;
    tr_item(w < 2 ? wg : wu, FF, 128 * tile + 64 * (w & 1), 64, gain, 64 * kb, dst, DM, 64 * rb, scr, lane);
}
constexpr int I_GU = (DM / 64) * (NGU / 64), I_D = (FF / 64) * (DM / 64), I_IN = (DM / 64) * (NINP / 64), I_OUT = (DMIX / 64) * (DM / 64);
constexpr int IT_WD1 = I_GU, IT_WIN = IT_WD1 + I_D, IT_WOUT = IT_WIN + I_IN, IT_WGU2 = IT_WOUT + I_OUT, IT_WD2 = IT_WGU2 + I_GU, IT_END = IT_WD2 + I_D;
__device__ __forceinline__ void tr_range(const Args& a, LAS unsigned char* lds, int lo, int hi, int wk, int nwk, int wave, int lane_in) {
    int lane = lane_in; asm volatile("" : "+v"(lane));
    unsigned char* ws = a.ws;
    LAS float* scr = (LAS float*)(lds + wave * 17408);
    for (int it = lo + wk; it < hi; it += nwk) {
        int r = it;
        if (r < IT_WD1) { tr_gu(a.in[I_F1G], a.in[I_F1U], a.in[I_F1N], (bf16*)(ws + WS_WGU1), r, scr, lane); continue; }
        if (r < IT_WIN) { r -= IT_WD1; const int kb = r / (DM / 64), rb = r % (DM / 64); tr_item(a.in[I_F1D], DM, 64 * rb, 64, nullptr, 64 * kb, (bf16*)(ws + WS_WD1), FF, 64 * rb, scr, lane); continue; }
        if (r < IT_WOUT) { r -= IT_WIN; const int kb = r / (NINP / 64), rb = r % (NINP / 64); const int nv = NIN - 64 * rb < 0 ? 0 : (NIN - 64 * rb > 64 ? 64 : NIN - 64 * rb);
            tr_item(a.in[I_WIN], NIN, nv > 0 ? 64 * rb : 0, nv, a.in[I_MIXN], 64 * kb, (bf16*)(ws + WS_WIN), DM, 64 * rb, scr, lane); continue; }
        if (r < IT_WGU2) { r -= IT_WOUT; const int kb = r / (DM / 64), rb = r % (DM / 64); const int k0 = 64 * kb;
            const float* gain = k0 < DLRU ? a.in[I_LON] : a.in[I_SNORM] - DLRU;
            tr_item(a.in[I_WOUT], DM, 64 * rb, 64, gain, k0, (bf16*)(ws + WS_WOUT), DMIX, 64 * rb, scr, lane); continue; }
        if (r < IT_WD2) { tr_gu(a.in[I_F2G], a.in[I_F2U], a.in[I_F2N], (bf16*)(ws + WS_WGU2), r - IT_WGU2, scr, lane); continue; }
        { r -= IT_WD2; const int kb = r / (DM / 64), rb = r % (DM / 64); tr_item(a.in[I_F2D], DM, 64 * rb, 64, nullptr, 64 * kb, (bf16*)(ws + WS_WD2), FF, 64 * rb, scr, lane); }
    }
}
__device__ __forceinline__ void p0_prologue(const Args& a, LAS unsigned char* lds, int vcu, int G, int wave, int lane) {
    unsigned char* ws = a.ws;
    const int gw = vcu * NWAVES + wave, NGW = G * NWAVES;
    tr_range(a, lds, 0, IT_WD1, gw, NGW, wave, lane);
    bf16* xbf = (bf16*)(ws + WS_XBF); float* ss0 = (float*)(ws + WS_SS0);
    for (int m = gw; m < MPAD; m += NGW) {
        f32x4 v[2][2]; float s = 0.f;
        if (m < MREAL) { const GAS f32x4* xr = (const GAS f32x4*)(m < TP ? a.in[I_XP] + (size_t)m * DM : a.in[I_XS] + (size_t)(m - TP) * DM) + 2 * lane;
#pragma unroll
            for (int j = 0; j < 2; ++j) { v[j][0] = __builtin_nontemporal_load(xr + 128 * j); v[j][1] = __builtin_nontemporal_load(xr + 128 * j + 1);
                s += ((v[j][0].x * v[j][0].x + v[j][0].y * v[j][0].y) + (v[j][0].z * v[j][0].z + v[j][0].w * v[j][0].w)) + ((v[j][1].x * v[j][1].x + v[j][1].y * v[j][1].y) + (v[j][1].z * v[j][1].z + v[j][1].w * v[j][1].w)); }
        } else {
#pragma unroll
            for (int j = 0; j < 2; ++j) { v[j][0] = (f32x4){0.f, 0.f, 0.f, 0.f}; v[j][1] = v[j][0]; }
        }
        s = wave_sum(s);
        GAS v4u* o16 = (GAS v4u*)(xbf + (size_t)m * DM) + lane;
#pragma unroll
        for (int j = 0; j < 2; ++j) o16[64 * j] = (v4u){pg8::cvt_pk_bf16(v[j][0].x, v[j][0].y), pg8::cvt_pk_bf16(v[j][0].z, v[j][0].w), pg8::cvt_pk_bf16(v[j][1].x, v[j][1].y), pg8::cvt_pk_bf16(v[j][1].z, v[j][1].w)};
        if (lane < 16) ss0[(size_t)m * 16 + lane] = lane == 0 ? s : 0.f;
    }
}
__device__ __forceinline__ int light_rank(int nwg, int G, int c, int& nlight) {
    const int rem = nwg % G; nlight = rem == 0 ? 0 : G - rem; return (rem != 0 && c >= rem) ? c - rem : -1;
}

__device__ __forceinline__ void p9_final_norm(const Args& a, int vcu, int G, int wave, int lane) {
    const int gw = vcu * NWAVES + wave, NGW = G * NWAVES;
    const bf16* xbf = (const bf16*)(a.ws + WS_XBF); const float* SS = (const float*)(a.ws + WS_SS0); const float* SSX = (const float*)(a.ws + WS_SSX1);
    const GAS f32x4* gn = (const GAS f32x4*)a.in[I_FINN] + 2 * lane;
    f32x4 gv[2][2];
#pragma unroll
    for (int j = 0; j < 2; ++j) { gv[j][0] = gn[128 * j]; gv[j][1] = gn[128 * j + 1]; }
    for (int m = gw; m < MREAL; m += NGW) {
        const float rs = pg8::rstd_row(SS, SSX, m);
        const GAS v4u* xr = (const GAS v4u*)(xbf + (size_t)m * DM) + lane; GAS f32x4* yr = (GAS f32x4*)(a.out + (size_t)m * DM) + 2 * lane;
#pragma unroll
        for (int j = 0; j < 2; ++j) { const v4u w = xr[64 * j];
            __builtin_nontemporal_store((f32x4){bf_lo(w.x), bf_hi(w.x), bf_lo(w.y), bf_hi(w.y)} * rs * gv[j][0], yr + 128 * j);
            __builtin_nontemporal_store((f32x4){bf_lo(w.z), bf_hi(w.z), bf_lo(w.w), bf_hi(w.w)} * rs * gv[j][1], yr + 128 * j + 1); }
    }
}

template <bool SEG3, bool BBF>
__device__ __forceinline__ void small_gemm_resid(const bf16* A, int lda, const bf16* Bt, int K, int id, const float* base, bf16* xbf, float* SSX, float scale,
                                                 const float* SSL, const float* SSS, LAS unsigned char* red, int tid_in) {
    int tid = tid_in; asm volatile("" : "+v"(tid));
    const int wid = __builtin_amdgcn_readfirstlane(tid >> 6), lane = tid & 63, fr = lane & 15, fq = lane >> 4;
    const int rg = id & 3, u = id >> 2, rh = wid >> 2, kq = wid & 3, Kq = K >> 2;
    const int s = rg * 32 + rh * 16 + fr; const size_t row = (size_t)TP + s;
    const bf16* ap = A + row * lda + kq * Kq + fq * 8; const bf16* bp = Bt + (size_t)(u * 16 + fr) * K + kq * Kq + fq * 8;
    f32x4 acc = (f32x4){0.f, 0.f, 0.f, 0.f};
    constexpr int NB = SEG3 ? 8 : 11;
    for (int k0 = 0; k0 < Kq; k0 += NB * 32) {
        bf16x8 av[NB], bv[NB];
#pragma unroll
        for (int ks = 0; ks < NB; ++ks) if (k0 + ks * 32 < Kq) { av[ks] = *(const bf16x8*)(ap + k0 + ks * 32); bv[ks] = *(const bf16x8*)(bp + k0 + ks * 32); }
#pragma unroll
        for (int ks = 0; ks < NB; ++ks) if (k0 + ks * 32 < Kq) acc = __builtin_amdgcn_mfma_f32_16x16x32_bf16(bv[ks], av[ks], acc, 0, 0, 0);
    }
    if (SEG3) { float sm = 0.f;
        if (kq < 2) {
#pragma unroll
            for (int k = 0; k < 16; ++k) sm += SSL[row * 16 + k];
            sm *= (1.0f / 1024.0f);
        } else {
#pragma unroll
            for (int k = 0; k < 8; ++k) sm += SSS[row * 16 + (kq - 2) * 8 + k];
            sm *= (1.0f / 512.0f); }
        acc = acc * (1.0f / sqrtf(sm + EPS)); }
    *(LAS f32x4*)(red + (wid * 64 + lane) * 16) = acc;
    __syncthreads();
    if (kq == 0) {
        f32x4 tot = acc;
#pragma unroll
        for (int q = 1; q < 4; ++q) tot += *(const LAS f32x4*)(red + ((wid + q) * 64 + lane) * 16);
        const int col = u * 16 + 4 * fq;
        f32x4 bv;
        if (BBF) { const pg8::u32x2 b2 = *(const pg8::u32x2*)(xbf + row * DM + col); bv = (f32x4){bf_lo(b2.x), bf_hi(b2.x), bf_lo(b2.y), bf_hi(b2.y)}; }
        else bv = *(const f32x4*)(base + (size_t)s * DM + col);
        const f32x4 v = bv + tot * scale;
        pg8::u32x2 w; w.x = pg8::cvt_pk_bf16(v[0], v[1]); w.y = pg8::cvt_pk_bf16(v[2], v[3]);
        *(pg8::u32x2*)(xbf + row * DM + col) = w;
        float ss = (v[0] * v[0] + v[1] * v[1]) + (v[2] * v[2] + v[3] * v[3]);
        ss = pg8::bfly16(ss, ss); ss = pg8::bfly32(ss, ss);
        if (fq == 0) SSX[(size_t)s * 64 + u] = ss;
    }
    __syncthreads();
}

__device__ __forceinline__ float softplus_f(float x) { return x > 20.f ? x : log1pf(expf(x)); }
__device__ __forceinline__ float sigmoid_f(float x) { return 1.0f / (1.0f + expf(-x)); }
__device__ __forceinline__ float gelu_tanh_f(float y) { const float v = 0.7978845608f * (y + 0.044715f * y * y * y); const float th = 1.0f - 2.0f / (expf(2.0f * v) + 1.0f); return 0.5f * y * (1.0f + th); }
__device__ __forceinline__ float bf1(const bf16* p) { return __uint_as_float((unsigned)(*p) << 16); }
__device__ __forceinline__ bf16 f2bf1(float f) { return (bf16)f2bf(f); }

__device__ __forceinline__ void naive_lru(const Args& a, LAS float* Wl, LAS float* xcl, int hd, int row0, int nseq, int L, bool sample, int lane) {
    bf16* P = (bf16*)(a.ws + WS_P); float* SSL = (float*)(a.ws + WS_SSL);
    const float* Wa = a.in[I_LGAW] + (size_t)hd * 4096; const float* Wx = a.in[I_LGXW] + (size_t)hd * 4096;
    for (int i = 0; i < 64; ++i) { Wl[i * 64 + lane] = Wa[i * 64 + lane]; Wl[4096 + i * 64 + lane] = Wx[i * 64 + lane]; }
    LDS_WAIT();
    const int ch = hd * 64 + lane;
    const float cw0 = a.in[I_LCW][ch], cw1 = a.in[I_LCW][DLRU + ch], cw2 = a.in[I_LCW][2 * DLRU + ch], cw3 = a.in[I_LCW][3 * DLRU + ch], cb = a.in[I_LCB][ch];
    const float ba = a.in[I_LGAB][ch], bx = a.in[I_LGXB][ch], sp = 8.0f * softplus_f(-a.in[I_LAM][ch]);
    for (int s = 0; s < nseq; ++s) {
        float xm3 = 0.f, xm2 = 0.f, xm1 = 0.f, h = 0.f;
        if (sample) { xm3 = a.in[I_SLC][(size_t)(s * 3 + 0) * DLRU + ch]; xm2 = a.in[I_SLC][(size_t)(s * 3 + 1) * DLRU + ch]; xm1 = a.in[I_SLC][(size_t)(s * 3 + 2) * DLRU + ch]; h = a.in[I_SLH][(size_t)s * DLRU + ch]; }
        for (int t = 0; t < L; ++t) {
            const size_t row = (size_t)row0 + (size_t)s * L + t;
            const float x0 = bf1(P + row * PW + ch);
            const float xc = cb + cw0 * xm3 + cw1 * xm2 + cw2 * xm1 + cw3 * x0;
            xm3 = xm2; xm2 = xm1; xm1 = x0;
            xcl[lane] = xc; LDS_WAIT(); asm volatile("" ::: "memory");
            float ga = ba, gx = bx;
#pragma unroll 8
            for (int i = 0; i < 64; ++i) { const float xi = xcl[i]; ga += xi * Wl[i * 64 + lane]; gx += xi * Wl[4096 + i * 64 + lane]; }
            LDS_WAIT(); asm volatile("" ::: "memory");
            const float r = sigmoid_f(ga), ig = sigmoid_f(gx), log_a = -r * sp, av = expf(log_a), u = sqrtf(-expm1f(2.0f * log_a)) * (ig * xc);
            h = av * h + u;
            const float gv = h * gelu_tanh_f(bf1(P + row * PW + DLRU + ch));
            const float ss = wave_sum(gv * gv);
            if (lane == 0) SSL[row * 16 + hd] = ss;
            P[row * PW + DLRU + ch] = f2bf1(gv);
        }
        if (sample) { a.out[O_SLH + (size_t)s * DLRU + ch] = h;
            a.out[O_SLC + (size_t)(s * 3 + 0) * DLRU + ch] = xm3; a.out[O_SLC + (size_t)(s * 3 + 1) * DLRU + ch] = xm2; a.out[O_SLC + (size_t)(s * 3 + 2) * DLRU + ch] = xm1; }
        else { const int b = row0 / SEQ; a.out[O_PLH + (size_t)b * DLRU + ch] = h;
            a.out[O_PLC + (size_t)(b * 3 + 0) * DLRU + ch] = xm3; a.out[O_PLC + (size_t)(b * 3 + 1) * DLRU + ch] = xm2; a.out[O_PLC + (size_t)(b * 3 + 2) * DLRU + ch] = xm1; }
    }
}

__device__ __forceinline__ void naive_ssd(const Args& a, LAS float* sc, int h, int row0, int L, bool sample, int s, int tid) {
    bf16* P = (bf16*)(a.ws + WS_P); float* SSS = (float*)(a.ws + WS_SSS); const float* DT = (const float*)(a.ws + WS_DT);
    const int g = h >> 3, p = tid >> 3, nb = tid & 7;
    LAS float* xs = sc; LAS float* Bv = sc + 64; LAS float* Cv = sc + 192; LAS float* ssq = sc + 320; LAS float* dd = sc + 384;
    const float Ah = -expf(a.in[I_SALOG][h]), dtb = a.in[I_SDTB][h], Dh = a.in[I_SD][h];
    const int cch = tid < 64 ? h * 64 + tid : (tid < 192 ? 1024 + g * 128 + (tid - 64) : 1280 + g * 128 + (tid - 192));
    float cw0 = 0.f, cw1 = 0.f, cw2 = 0.f, cw3 = 0.f, cb = 0.f, xm3 = 0.f, xm2 = 0.f, xm1 = 0.f;
    if (tid < 320) { cw0 = a.in[I_SCW][cch]; cw1 = a.in[I_SCW][DXBC + cch]; cw2 = a.in[I_SCW][2 * DXBC + cch]; cw3 = a.in[I_SCW][3 * DXBC + cch]; cb = a.in[I_SCB][cch];
        if (sample) { xm3 = a.in[I_SSC][(size_t)(s * 3 + 0) * DXBC + cch]; xm2 = a.in[I_SSC][(size_t)(s * 3 + 1) * DXBC + cch]; xm1 = a.in[I_SSC][(size_t)(s * 3 + 2) * DXBC + cch]; } }
    float hst[16];
    const size_t sbase = ((size_t)(s * NHEAD + h) * 64 + p) * 128 + nb * 16;
#pragma unroll
    for (int k = 0; k < 16; ++k) hst[k] = sample ? a.in[I_SSH][sbase + k] : 0.f;
    for (int t = 0; t < L; ++t) {
        const size_t row = (size_t)row0 + t;
        if (tid < 320) { const float x0 = bf1(P + row * PW + 3072 + cch); const float v = cb + cw0 * xm3 + cw1 * xm2 + cw2 * xm1 + cw3 * x0; xm3 = xm2; xm2 = xm1; xm1 = x0;
            sc[tid] = v / (1.0f + expf(-v)); }
        if (tid == 320) { const float dt = softplus_f(DT[row * 16 + h] + dtb); dd[0] = dt; dd[1] = expf(dt * Ah); }
        __syncthreads();
        const float dt = dd[0], dA = dd[1], xp = xs[p], xdt = dt * xp; float yp = 0.f;
#pragma unroll
        for (int k = 0; k < 16; ++k) { hst[k] = hst[k] * dA + xdt * Bv[nb * 16 + k]; yp += Cv[nb * 16 + k] * hst[k]; }
        yp += __shfl_xor(yp, 1); yp += __shfl_xor(yp, 2); yp += __shfl_xor(yp, 4);
        if (nb == 0) { const float y = yp + Dh * xp; const float z = bf1(P + row * PW + 2048 + h * 64 + p); const float gv = y * (z / (1.0f + expf(-z)));
            ssq[p] = gv * gv; P[row * PW + 2048 + h * 64 + p] = f2bf1(gv); }
        __syncthreads();
        if (tid == 0) { float ssum = 0.f; for (int i = 0; i < 64; ++i) ssum += ssq[i]; SSS[row * 16 + h] = ssum; }
    }
    float* so = a.out + (sample ? O_SSH : O_PSH) + sbase;
#pragma unroll
    for (int k = 0; k < 16; ++k) so[k] = hst[k];
    if (tid < 320) { float* co = a.out + (sample ? O_SSC : O_PSC) + (size_t)(s * 3) * DXBC + cch; co[0] = xm3; co[DXBC] = xm2; co[2 * DXBC] = xm1; }
    __syncthreads();
}


constexpr int MS = 272;
constexpr int XNS = 144;
constexpr int L_CN = 0, L_BN = 34816, L_XN = 69632, L_XWN = L_XN + 128 * XNS, L_H = L_XWN + 128 * XNS, L_ACS = L_H + 64 * MS, L_DTJ = L_ACS + 1024, L_WJ = L_DTJ + 1024, L_MSC = L_WJ + 1024;
constexpr int L_XCW = L_MSC + 128;
constexpr int L_GJ = L_XCW + 1280;
static_assert(L_GJ + 1024 <= MISC_OFF && L_MSC + 64 <= L_XCW, "mixer LDS map");
__device__ __forceinline__ unsigned cvtpk(float lo, float hi) { return pg8::cvt_pk_bf16(lo, hi); }
__device__ __forceinline__ float silu_fast(float x) { return x * __builtin_amdgcn_rcpf(1.0f + __builtin_amdgcn_exp2f(-1.44269504f * x)); }
__device__ __forceinline__ float exp_fast(float x) { return __builtin_amdgcn_exp2f(1.44269504f * x); }
typedef unsigned v2u __attribute__((ext_vector_type(2)));
typedef short s4v_t __attribute__((ext_vector_type(4)));
#define LDTR(addr_) (__builtin_bit_cast(v2u, __builtin_amdgcn_ds_read_tr16_b64_v4i16((LAS s4v_t*)(addr_))))
#define MFMA16(a, b, c) __builtin_amdgcn_mfma_f32_16x16x32_bf16((a), (b), (c), 0, 0, 0)
#define LDFRAG(base, row, ks) (*(const LAS bf16x8*)(lds + (base) + (row) * MS + (ks) * 64 + fq * 16))
#define OPQ_IDX() int tid = tid_in; asm volatile("" : "+v"(tid)); const int lane = tid & 63, fr = lane & 15, fq = lane >> 4; (void)fr; (void)fq; (void)lane

struct ConvW { f32x4 w[4][2], b[2]; };
__device__ __forceinline__ void load_convw(ConvW& c, const float* cw, const float* cb, int ld, int ch) {
#pragma unroll
    for (int k = 0; k < 4; ++k) { c.w[k][0] = *(const f32x4*)(cw + k * ld + ch); c.w[k][1] = *(const f32x4*)(cw + k * ld + ch + 4); }
    c.b[0] = *(const f32x4*)(cb + ch); c.b[1] = *(const f32x4*)(cb + ch + 4);
}
__device__ __forceinline__ void unpack8(const v4u v, float (&x)[8]) { x[0] = bf_lo(v.x); x[1] = bf_hi(v.x); x[2] = bf_lo(v.y); x[3] = bf_hi(v.y); x[4] = bf_lo(v.z); x[5] = bf_hi(v.z); x[6] = bf_lo(v.w); x[7] = bf_hi(v.w); }
__device__ __forceinline__ void conv_tok(const ConvW& c, const float (&r0)[8], const float (&r1)[8], const float (&r2)[8], const float (&r3)[8], float (&o)[8]) {
#pragma unroll
    for (int q = 0; q < 8; ++q) o[q] = c.b[q >> 2][q & 3] + c.w[0][q >> 2][q & 3] * r0[q] + c.w[1][q >> 2][q & 3] * r1[q] + c.w[2][q >> 2][q & 3] * r2[q] + c.w[3][q >> 2][q & 3] * r3[q];
}


struct SPair { const f32x4* hin; f32x4* hout; f32x4 B4, C4; float dt, dA, xv, yacc, Dh, zv; bf16* zp; float* sss; float pp0, pp1, pp2, pp3, pp4, pp5, pp6, pp7; };
__device__ __forceinline__ void sp_begin(SPair& sp, const Args& a, int q, int lane) {
    bf16* P = (bf16*)(a.ws + WS_P); const float* DT = (const float*)(a.ws + WS_DT);
    const int s = q >> 4, h = q & 15, g = h >> 3; const size_t row = (size_t)TP + s;
    const float* cw = a.in[I_SCW]; const float* cb = a.in[I_SCB]; const float* cs = a.in[I_SSC] + (size_t)s * 3 * DXBC; float* cso = a.out + O_SSC + (size_t)s * 3 * DXBC;
    float sv[5];
    {
        float x0[5], x1[5], x2[5], xn[5], w0[5], w1[5], w2[5], w3[5], bb[5];
#pragma unroll
        for (int k = 0; k < 5; ++k) {
            const int ch = k == 0 ? h * 64 + lane : (k < 3 ? 1024 : 1280) + g * 128 + lane + ((k - 1) & 1) * 64;
            x0[k] = cs[ch]; x1[k] = cs[DXBC + ch]; x2[k] = cs[2 * DXBC + ch]; xn[k] = bf1(P + row * PW + 3072 + ch);
            bb[k] = cb[ch]; w0[k] = cw[ch]; w1[k] = cw[DXBC + ch]; w2[k] = cw[2 * DXBC + ch]; w3[k] = cw[3 * DXBC + ch]; }
        asm volatile("s_waitcnt vmcnt(0)" ::: "memory");
#pragma unroll
        for (int k = 0; k < 5; ++k) {
            const int ch = k == 0 ? h * 64 + lane : (k < 3 ? 1024 : 1280) + g * 128 + lane + ((k - 1) & 1) * 64;
            sv[k] = silu_fast(bb[k] + w0[k] * x0[k] + w1[k] * x1[k] + w2[k] * x2[k] + w3[k] * xn[k]);
            if (k == 0 || (h & 7) == 0) { cso[ch] = x1[k]; cso[DXBC + ch] = x2[k]; cso[2 * DXBC + ch] = xn[k]; } }
    }
    const int nb = 4 * (lane & 31);
#pragma unroll
    for (int j = 0; j < 4; ++j) { const int src = (nb + j) & 63; const bool hi = (nb + j) >= 64;
        const float b0 = __shfl(sv[1], src), b1 = __shfl(sv[2], src), c0 = __shfl(sv[3], src), c1 = __shfl(sv[4], src);
        sp.B4[j] = hi ? b1 : b0; sp.C4[j] = hi ? c1 : c0; }
    sp.xv = sv[0];
    sp.dt = softplus_f(DT[row * 16 + h] + a.in[I_SDTB][h]); sp.dA = exp_fast(sp.dt * -expf(a.in[I_SALOG][h])); sp.Dh = a.in[I_SD][h];
    sp.hin = (const f32x4*)(a.in[I_SSH] + (size_t)q * 8192) + lane; sp.hout = (f32x4*)(a.out + O_SSH + (size_t)q * 8192) + lane;
    sp.yacc = 0.f; sp.pp0 = sp.pp1 = sp.pp2 = sp.pp3 = sp.pp4 = sp.pp5 = sp.pp6 = sp.pp7 = 0.f; sp.zp = P + row * PW + 2048 + h * 64 + lane; sp.sss = (float*)(a.ws + WS_SSS) + row * 16 + h;
    sp.zv = bf1(sp.zp);
}
__device__ __forceinline__ void sp_prefetch(const SPair& sp, int c, f32x4& h0, f32x4& h1) { h0 = __builtin_nontemporal_load(sp.hin + (2 * c) * 64); h1 = __builtin_nontemporal_load(sp.hin + (2 * c + 1) * 64); }
__device__ __forceinline__ void sp_step(SPair& sp, int c, const f32x4 h0, const f32x4 h1, int lane) {
    const int hf = lane >> 5;
    const float xa0 = __shfl(sp.xv, 4 * c), xa1 = __shfl(sp.xv, 4 * c + 1), xb0 = __shfl(sp.xv, 4 * c + 2), xb1 = __shfl(sp.xv, 4 * c + 3);
    const float xd0 = sp.dt * (hf ? xa1 : xa0), xd1 = sp.dt * (hf ? xb1 : xb0);
    const f32x4 n0 = h0 * sp.dA + sp.B4 * xd0, n1 = h1 * sp.dA + sp.B4 * xd1;
    __builtin_nontemporal_store(n0, sp.hout + (2 * c) * 64); __builtin_nontemporal_store(n1, sp.hout + (2 * c + 1) * 64);
    const float p0 = (sp.C4[0] * n0[0] + sp.C4[1] * n0[1]) + (sp.C4[2] * n0[2] + sp.C4[3] * n0[3]), p1 = (sp.C4[0] * n1[0] + sp.C4[1] * n1[1]) + (sp.C4[2] * n1[2] + sp.C4[3] * n1[3]);
    const int cc = c & 3;
    if (cc == 0) { sp.pp0 = p0; sp.pp1 = p1; } else if (cc == 1) { sp.pp2 = p0; sp.pp3 = p1; } else if (cc == 2) { sp.pp4 = p0; sp.pp5 = p1; } else { sp.pp6 = p0; sp.pp7 = p1;
        const bool u4 = lane & 16, u3 = lane & 8, u2 = lane & 4;
        float a0 = pg8::bfly16(sp.pp0, sp.pp4), a1 = pg8::bfly16(sp.pp1, sp.pp5), a2 = pg8::bfly16(sp.pp2, sp.pp6), a3 = pg8::bfly16(sp.pp3, sp.pp7);
        float b0 = (u3 ? a2 : a0) + pg8::dpp_xor8(u3 ? a0 : a2), b1 = (u3 ? a3 : a1) + pg8::dpp_xor8(u3 ? a1 : a3);
        float t = (u2 ? b1 : b0) + pg8::dpp_xor4(u2 ? b0 : b1, u2);
        t += pg8::dpp_xor2(t); t += pg8::dpp_xor1(t);
        const int src = 32 * (lane & 1) + 16 * ((lane >> 3) & 1) + 8 * ((lane >> 2) & 1) + 4 * ((lane >> 1) & 1);
        const float got = __shfl(t, src);
        if ((lane >> 4) == (c >> 2)) sp.yacc = got; }
}
__device__ __forceinline__ void sp_end(SPair& sp, int lane) {
    const float y = sp.yacc + sp.Dh * sp.xv, gv = y * silu_fast(sp.zv);
    const float ss = wave_sum(gv * gv);
    *sp.zp = f2bf1(gv);
    if (lane == 0) *sp.sss = ss;
}

__device__ __forceinline__ void ssd_prepass(const Args& a, int vcu, int G, int tid_in) {
    int tid = tid_in; asm volatile("" : "+v"(tid));
    const bf16* P = (const bf16*)(a.ws + WS_P); bf16* BCc = (bf16*)a.out;
    for (int it = vcu * 512 + tid; it < (TP / 8) * 64; it += G * 512) {
        const int cg = it & 63, run = it >> 6, row0 = run * 8, tt0 = row0 & (SEQ - 1), cch = 1024 + cg * 8;
        const bf16* pb = P + (size_t)(row0 - tt0) * PW + 3072 + cch;
        v4u raw[11];
#pragma unroll
        for (int i = 0; i < 11; ++i) { const int tt = tt0 - 3 + i; raw[i] = *(const v4u*)(pb + (size_t)(tt < 0 ? 0 : tt) * PW); if (tt < 0) raw[i] = (v4u){0u, 0u, 0u, 0u}; }
        ConvW cwv; load_convw(cwv, a.in[I_SCW], a.in[I_SCB], DXBC, cch);
        float r0[8], r1[8], r2[8], r3[8];
        unpack8(raw[0], r0); unpack8(raw[1], r1); unpack8(raw[2], r2);
#pragma unroll
        for (int jj = 0; jj < 8; ++jj) { float o[8];
            if ((jj & 3) == 0) { unpack8(raw[jj + 3], r3); conv_tok(cwv, r0, r1, r2, r3, o); }
            if ((jj & 3) == 1) { unpack8(raw[jj + 3], r0); conv_tok(cwv, r1, r2, r3, r0, o); }
            if ((jj & 3) == 2) { unpack8(raw[jj + 3], r1); conv_tok(cwv, r2, r3, r0, r1, o); }
            if ((jj & 3) == 3) { unpack8(raw[jj + 3], r2); conv_tok(cwv, r3, r0, r1, r2, o); }
            v4u w; w.x = cvtpk(silu_fast(o[0]), silu_fast(o[1])); w.y = cvtpk(silu_fast(o[2]), silu_fast(o[3])); w.z = cvtpk(silu_fast(o[4]), silu_fast(o[5])); w.w = cvtpk(silu_fast(o[6]), silu_fast(o[7]));
            *(v4u*)(BCc + (size_t)(row0 + jj) * 512 + cg * 8) = w; }
    }
}

template <int KM>
__device__ __forceinline__ void ssd_tri(LAS unsigned char* lds, int sl, int i0, int fr, int fq, const bf16x8 (&cf)[4], float acs_i, f32x4 (&accY)[4]) {
    const LAS float* ACS = (const LAS float*)(lds + L_ACS); const LAS float* DTJ = (const LAS float*)(lds + L_DTJ); const LAS float* GJ = (const LAS float*)(lds + L_GJ);
    bf16x8 bq[2][4], xq[4];
#define TRI_LOADB(jt_, s_) do { _Pragma("unroll") for (int ks_ = 0; ks_ < 4; ++ks_) bq[s_][ks_] = LDFRAG(L_BN, (jt_) * 16 + fr, ks_); } while (0)
#define TRI_LOADX(kp_) do { _Pragma("unroll") for (int pt_ = 0; pt_ < 4; ++pt_) { \
            const v2u xa_ = LDTR(lds + L_XN + (32 * (kp_) + 4 * fq + ((fr >> 2) & 3)) * XNS + (pt_ * 16 + 4 * (fr & 3)) * 2), xb_ = LDTR(lds + L_XN + (32 * (kp_) + 16 + 4 * fq + ((fr >> 2) & 3)) * XNS + (pt_ * 16 + 4 * (fr & 3)) * 2); \
            xq[pt_] = __builtin_bit_cast(bf16x8, (v4u){xa_.x, xa_.y, xb_.x, xb_.y}); } } while (0)
    TRI_LOADB(0, 0);
    __builtin_amdgcn_sched_barrier(0);
#pragma unroll
    for (int kp = 0; kp <= KM; ++kp) {
        f32x4 cb[2];
        TRI_LOADB(2 * kp + 1, 1); TRI_LOADX(kp);
        __builtin_amdgcn_sched_barrier(0);
        { f32x4 acc = (f32x4){0.f, 0.f, 0.f, 0.f};
#pragma unroll
          for (int ks = 0; ks < 4; ++ks) acc = MFMA16(bq[0][ks], cf[ks], acc);
          cb[0] = acc; }
        __builtin_amdgcn_sched_barrier(0);
        if (kp < KM) TRI_LOADB(2 * kp + 2, 0);
        float ra0 = 0.f, ra1 = 0.f; f32x4 dq0, dq1;
        if (kp < KM) { ra0 = ACS[sl * 128 + (2 * kp) * 16 + 15]; ra1 = ACS[sl * 128 + (2 * kp + 1) * 16 + 15];
            dq0 = *(const LAS f32x4*)(GJ + sl * 128 + (2 * kp) * 16 + 4 * fq); dq1 = *(const LAS f32x4*)(GJ + sl * 128 + (2 * kp + 1) * 16 + 4 * fq); }
        else { dq0 = *(const LAS f32x4*)(ACS + sl * 128 + (2 * kp) * 16 + 4 * fq); dq1 = *(const LAS f32x4*)(ACS + sl * 128 + (2 * kp + 1) * 16 + 4 * fq); }
        __builtin_amdgcn_sched_barrier(0);
        { f32x4 acc = (f32x4){0.f, 0.f, 0.f, 0.f};
#pragma unroll
          for (int ks = 0; ks < 4; ++ks) acc = MFMA16(bq[1][ks], cf[ks], acc);
          cb[1] = acc; }
        unsigned mw[4];
#pragma unroll
        for (int hh = 0; hh < 2; ++hh) { const int jt = 2 * kp + hh;
            float mv[4];
            if (kp < KM) {
                const float rf = exp_fast(fminf(acs_i - (hh ? ra1 : ra0), 0.f));
                const f32x4 gj = hh ? dq1 : dq0;
#pragma unroll
                for (int r = 0; r < 4; ++r) mv[r] = cb[hh][r] * (rf * gj[r]);
            } else {
                const f32x4 aj = hh ? dq1 : dq0, dj = *(const LAS f32x4*)(DTJ + sl * 128 + jt * 16 + 4 * fq);
#pragma unroll
                for (int r = 0; r < 4; ++r) { const float e = exp_fast(fminf(acs_i - aj[r], 0.f)) * dj[r]; mv[r] = (jt * 16 + 4 * fq + r <= i0 + fr) ? cb[hh][r] * e : 0.f; } }
            mw[2 * hh] = cvtpk(mv[0], mv[1]); mw[2 * hh + 1] = cvtpk(mv[2], mv[3]); }
        const bf16x8 mf = __builtin_bit_cast(bf16x8, (v4u){mw[0], mw[1], mw[2], mw[3]});
#pragma unroll
        for (int pt = 0; pt < 4; ++pt) accY[pt] = MFMA16(xq[pt], mf, accY[pt]);
        __builtin_amdgcn_sched_barrier(0);
    }
#undef TRI_LOADB
#undef TRI_LOADX
}

__device__ __forceinline__ void ssd_unit_fast(const Args& a, LAS unsigned char* lds, int b, int h, int tid_in, int wid, int lane_in, int spq) {
    bf16* P = (bf16*)(a.ws + WS_P); float* SSS = (float*)(a.ws + WS_SSS); const float* DT = (const float*)(a.ws + WS_DT);
    const int g = h >> 3;
    const float Ah = -expf(a.in[I_SALOG][h]), dtb = a.in[I_SDTB][h], Dh = a.in[I_SD][h];
    const float* cw = a.in[I_SCW]; const float* cb = a.in[I_SCB];
    LAS float* ACS = (LAS float*)(lds + L_ACS); LAS float* DTJ = (LAS float*)(lds + L_DTJ); LAS float* WJ = (LAS float*)(lds + L_WJ); LAS float* MSC = (LAS float*)(lds + L_MSC); LAS float* GJ = (LAS float*)(lds + L_GJ);
    const size_t rowb = (size_t)b * SEQ;
    for (int i = tid_in; i < 64 * MS / 16; i += 512) *(LAS v4u*)(lds + L_H + i * 16) = (v4u){0u, 0u, 0u, 0u};
    if (tid_in < 64) { LAS float* xw_ = (LAS float*)(lds + L_XCW) + (tid_in >> 3) * 40 + (tid_in & 7); const int ch_ = h * 64 + tid_in;
        xw_[0] = cw[ch_]; xw_[8] = cw[DXBC + ch_]; xw_[16] = cw[2 * DXBC + ch_]; xw_[24] = cw[3 * DXBC + ch_]; xw_[32] = cb[ch_]; }
    f32x4 accH[4];
#pragma unroll
    for (int pt = 0; pt < 4; ++pt) accH[pt] = (f32x4){0.f, 0.f, 0.f, 0.f};
    const int iw = wid < 4 ? wid : 11 - wid;
    const int i0 = iw * 16, n0 = wid * 16;
    v4u pbig[8], psm[5]; float pdt0 = 0.f, pdt1 = 0.f;
    const bf16* BCc = (const bf16*)a.out;
#define SSD_ACS(sl, r0_, r1_) do { const float d0 = softplus_f((r0_) + dtb), d1 = softplus_f((r1_) + dtb); const float v0 = d0 * Ah, v1 = d1 * Ah, s_ = v0 + v1; float incl = s_; \
        _Pragma("unroll") for (int o_ = 1; o_ < 64; o_ <<= 1) { const float t_ = __shfl_up(incl, o_); if (lane >= o_) incl += t_; } \
        const float a0 = incl - s_ + v0, a1 = incl, last = __shfl(incl, 63); \
        ACS[(sl) * 128 + 2 * lane] = a0; ACS[(sl) * 128 + 2 * lane + 1] = a1; DTJ[(sl) * 128 + 2 * lane] = d0; DTJ[(sl) * 128 + 2 * lane + 1] = d1; \
        WJ[(sl) * 128 + 2 * lane] = exp_fast(last - a0) * d0; WJ[(sl) * 128 + 2 * lane + 1] = exp_fast(last - a1) * d1; if (lane == 0) MSC[sl] = exp_fast(last); \
        const float rt_ = __shfl(incl, (lane & 56) | 7); GJ[(sl) * 128 + 2 * lane] = exp_fast(fminf(rt_ - a0, 0.f)) * d0; GJ[(sl) * 128 + 2 * lane + 1] = exp_fast(fminf(rt_ - a1, 0.f)) * d1; } while (0)
#define SSD_PREFETCH(tc) do { OPQ_IDX(); const int hw_ = tid >> 8, cg_ = tid & 15, j0_ = 8 * ((tid >> 4) & 15); \
        const bf16* pb_ = BCc + (rowb + (tc) + j0_) * 512 + (hw_ ? 0 : 256) + g * 128 + cg_ * 8; \
        _Pragma("unroll") for (int i_ = 0; i_ < 8; ++i_) pbig[i_] = *(const v4u*)(pb_ + (size_t)i_ * 512); \
        const int cx_ = tid & 7, k0_ = 2 * (tid >> 3); const bf16* px_ = P + rowb * PW + 3072 + h * 64 + cx_ * 8; \
        _Pragma("unroll") for (int i_ = 0; i_ < 5; ++i_) { const int tt_ = (tc) + k0_ - 3 + i_; if (SSD_PF_GUARD) { psm[i_] = *(const v4u*)(px_ + (size_t)(tt_ < 0 ? 0 : tt_) * PW); if (tt_ < 0) psm[i_] = (v4u){0u, 0u, 0u, 0u}; } else psm[i_] = *(const v4u*)(px_ + (size_t)tt_ * PW); } \
        if (wid == 0) { pdt0 = DT[(rowb + (tc) + 2 * lane) * 16 + h]; pdt1 = DT[(rowb + (tc) + 2 * lane + 1) * 16 + h]; } } while (0)
    SPair sp; f32x4 sh0 = (f32x4){0.f, 0.f, 0.f, 0.f}, sh1 = sh0;
    if (spq >= 0) { OPQ_IDX(); sp_begin(sp, a, spq, lane); }
#define SSD_PF_GUARD true
    SSD_PREFETCH(0);
#undef SSD_PF_GUARD
#define SSD_PF_GUARD false
    if (wid == 0) { OPQ_IDX(); SSD_ACS(0, pdt0, pdt1); }
    __syncthreads();
#if defined(PROBE_MX)
    unsigned long long pt_[3] = {0, 0, 0}; unsigned long long tl_ = __builtin_amdgcn_s_memrealtime();
#define PSTAMP(k) do { const unsigned long long tn_ = __builtin_amdgcn_s_memrealtime(); pt_[k] += tn_ - tl_; tl_ = tn_; } while (0)
#else
#define PSTAMP(k) do { } while (0)
#endif
    for (int c = 0; c < SEQ / 128; ++c) {
        const int t0 = c * 128, sl = c & 1;
        {   OPQ_IDX();
            const int hw = tid >> 8, cg = tid & 15, j0 = 8 * ((tid >> 4) & 15);
#pragma unroll
            for (int jj = 0; jj < 8; ++jj) *(LAS v4u*)(lds + (hw ? L_BN : L_CN) + (j0 + jj) * MS + cg * 16) = pbig[jj];
            const int cx = tid & 7, k0 = 2 * (tid >> 3);
            ConvW cxv; { const LAS float* xw_ = (const LAS float*)(lds + L_XCW) + cx * 40;
#pragma unroll
                for (int k = 0; k < 4; ++k) { cxv.w[k][0] = *(const LAS f32x4*)(xw_ + k * 8); cxv.w[k][1] = *(const LAS f32x4*)(xw_ + k * 8 + 4); }
                cxv.b[0] = *(const LAS f32x4*)(xw_ + 32); cxv.b[1] = *(const LAS f32x4*)(xw_ + 36); }
            float s0[8], s1[8], s2[8], s3[8], s4[8], o0[8], o1[8];
            unpack8(psm[0], s0); unpack8(psm[1], s1); unpack8(psm[2], s2); unpack8(psm[3], s3); unpack8(psm[4], s4);
            conv_tok(cxv, s0, s1, s2, s3, o0); conv_tok(cxv, s1, s2, s3, s4, o1);
            const float w0 = WJ[sl * 128 + k0], w1 = WJ[sl * 128 + k0 + 1];
            float x0[8], x1[8];
#pragma unroll
            for (int q = 0; q < 8; ++q) { x0[q] = silu_fast(o0[q]); x1[q] = silu_fast(o1[q]); }
            *(LAS v4u*)(lds + L_XN + k0 * XNS + cx * 16) = (v4u){cvtpk(x0[0], x0[1]), cvtpk(x0[2], x0[3]), cvtpk(x0[4], x0[5]), cvtpk(x0[6], x0[7])};
            *(LAS v4u*)(lds + L_XN + (k0 + 1) * XNS + cx * 16) = (v4u){cvtpk(x1[0], x1[1]), cvtpk(x1[2], x1[3]), cvtpk(x1[4], x1[5]), cvtpk(x1[6], x1[7])};
            *(LAS v4u*)(lds + L_XWN + k0 * XNS + cx * 16) = (v4u){cvtpk(x0[0] * w0, x0[1] * w0), cvtpk(x0[2] * w0, x0[3] * w0), cvtpk(x0[4] * w0, x0[5] * w0), cvtpk(x0[6] * w0, x0[7] * w0)};
            *(LAS v4u*)(lds + L_XWN + (k0 + 1) * XNS + cx * 16) = (v4u){cvtpk(x1[0] * w1, x1[1] * w1), cvtpk(x1[2] * w1, x1[3] * w1), cvtpk(x1[4] * w1, x1[5] * w1), cvtpk(x1[6] * w1, x1[7] * w1)};
        }
        SSD_PREFETCH(t0 + 128);
        if (spq >= 0) sp_prefetch(sp, c, sh0, sh1);
        v4u zq[2];
        {   OPQ_IDX();
            const bf16* zp = P + (rowb + t0 + i0 + fr) * PW + 2048 + h * 64 + ((fq & 1) ? 16 + 4 * (fq - 1) : 4 * fq);
            zq[0] = *(const v4u*)zp; zq[1] = *(const v4u*)(zp + 32); }
        __syncthreads();
        PSTAMP(0);
        OPQ_IDX();
        f32x4 accY[4];
        {
            bf16x8 cf[4];
#pragma unroll
            for (int ks = 0; ks < 4; ++ks) cf[ks] = LDFRAG(L_CN, i0 + fr, ks);
            const int trq = (fr >> 2) & 3, trp = fr & 3;
            bf16x8 bt[4], wq[2][4];
#define ST_LOADW(pt_, s_) do { _Pragma("unroll") for (int ks_ = 0; ks_ < 4; ++ks_) { \
                const v2u w0_ = LDTR(lds + L_XWN + (32 * ks_ + 8 * fq + trq) * XNS + ((pt_) * 16 + 4 * trp) * 2), w1_ = LDTR(lds + L_XWN + (32 * ks_ + 8 * fq + 4 + trq) * XNS + ((pt_) * 16 + 4 * trp) * 2); \
                wq[s_][ks_] = __builtin_bit_cast(bf16x8, (v4u){w0_.x, w0_.y, w1_.x, w1_.y}); } } while (0)
#define ST_LOADH(pt_, s_) do { _Pragma("unroll") for (int ks_ = 0; ks_ < 4; ++ks_) wq[s_][ks_] = LDFRAG(L_H, (pt_) * 16 + fr, ks_); } while (0)
#pragma unroll
            for (int ks = 0; ks < 4; ++ks) { const v2u b0 = LDTR(lds + L_BN + (32 * ks + 8 * fq + trq) * MS + (n0 + 4 * trp) * 2), b1 = LDTR(lds + L_BN + (32 * ks + 8 * fq + 4 + trq) * MS + (n0 + 4 * trp) * 2);
                bt[ks] = __builtin_bit_cast(bf16x8, (v4u){b0.x, b0.y, b1.x, b1.y}); }
            ST_LOADW(0, 0);
            const float dec = MSC[sl];
            const float acs_i = ACS[sl * 128 + i0 + fr], e_i = exp_fast(acs_i);
            __builtin_amdgcn_sched_barrier(0);
#pragma unroll
            for (int pt = 0; pt < 4; ++pt) {
                if (pt < 3) ST_LOADW(pt + 1, (pt + 1) & 1); else ST_LOADH(0, 0);
                __builtin_amdgcn_sched_barrier(0);
                accH[pt] = accH[pt] * dec;
#pragma unroll
                for (int ks = 0; ks < 4; ++ks) accH[pt] = MFMA16(bt[ks], wq[pt & 1][ks], accH[pt]);
                __builtin_amdgcn_sched_barrier(0); }
#pragma unroll
            for (int pt = 0; pt < 4; ++pt) {
                if (pt < 3) ST_LOADH(pt + 1, (pt + 1) & 1);
                __builtin_amdgcn_sched_barrier(0);
                f32x4 acc = (f32x4){0.f, 0.f, 0.f, 0.f};
#pragma unroll
                for (int ks = 0; ks < 4; ++ks) acc = MFMA16(wq[pt & 1][ks], cf[ks], acc);
                accY[pt] = acc * e_i;
                __builtin_amdgcn_sched_barrier(0); }
#undef ST_LOADW
#undef ST_LOADH
            switch (iw >> 1) {
                case 0: ssd_tri<0>(lds, sl, i0, fr, fq, cf, acs_i, accY); break;
                case 1: ssd_tri<1>(lds, sl, i0, fr, fq, cf, acs_i, accY); break;
                case 2: ssd_tri<2>(lds, sl, i0, fr, fq, cf, acs_i, accY); break;
                default: ssd_tri<3>(lds, sl, i0, fr, fq, cf, acs_i, accY); break; }
#pragma unroll
            for (int pt = 0; pt < 4; ++pt) { const v2u xd = *(const LAS v2u*)(lds + L_XN + (i0 + fr) * XNS + (pt * 16 + 4 * fq) * 2);
                accY[pt][0] += Dh * bf_lo(xd.x); accY[pt][1] += Dh * bf_hi(xd.x); accY[pt][2] += Dh * bf_lo(xd.y); accY[pt][3] += Dh * bf_hi(xd.y); }
            if (wid == 0 && c + 1 < SEQ / 128) SSD_ACS(sl ^ 1, pdt0, pdt1);
        }
        __syncthreads();
        PSTAMP(1);
        {
#pragma unroll
            for (int pt = 0; pt < 4; ++pt) { v2u w; w.x = cvtpk(accH[pt][0], accH[pt][1]); w.y = cvtpk(accH[pt][2], accH[pt][3]);
                *(LAS v2u*)(lds + L_H + (pt * 16 + fr) * MS + (n0 + 4 * fq) * 2) = w; }
            const size_t row = rowb + t0 + i0 + fr; float ss = 0.f;
            v2u zr[4];
#pragma unroll
            for (int pp = 0; pp < 2; ++pp) {
                const auto r0 = __builtin_amdgcn_permlane16_swap(zq[pp].x, zq[pp].z, false, false), r1 = __builtin_amdgcn_permlane16_swap(zq[pp].y, zq[pp].w, false, false);
                zr[2 * pp].x = r0[0]; zr[2 * pp].y = r1[0]; zr[2 * pp + 1].x = r0[1]; zr[2 * pp + 1].y = r1[1]; }
            v2u wo[4];
#pragma unroll
            for (int pt = 0; pt < 4; ++pt) {
                const float z[4] = {bf_lo(zr[pt].x), bf_hi(zr[pt].x), bf_lo(zr[pt].y), bf_hi(zr[pt].y)};
                float gv[4];
#pragma unroll
                for (int r = 0; r < 4; ++r) { gv[r] = accY[pt][r] * silu_fast(z[r]); ss += gv[r] * gv[r]; }
                wo[pt].x = cvtpk(gv[0], gv[1]); wo[pt].y = cvtpk(gv[2], gv[3]); }
            {   bf16* zp = P + row * PW + 2048 + h * 64 + ((fq & 1) ? 16 + 4 * (fq - 1) : 4 * fq);
#pragma unroll
                for (int pp = 0; pp < 2; ++pp) {
                    const auto r0 = __builtin_amdgcn_permlane16_swap(wo[2 * pp].x, wo[2 * pp + 1].x, false, false), r1 = __builtin_amdgcn_permlane16_swap(wo[2 * pp].y, wo[2 * pp + 1].y, false, false);
                    *(v4u*)(zp + pp * 32) = (v4u){r0[0], r1[0], r0[1], r1[1]}; } }
            ss = pg8::bfly16(ss, ss); ss = pg8::bfly32(ss, ss);
            if (fq == 0) SSS[row * 16 + h] = ss;
            if (spq >= 0) sp_step(sp, c, sh0, sh1, lane);
        }
        PSTAMP(2);
    }
#if defined(PROBE_MX)
    if (b == 0 && h == 0 && tid_in == 0) { unsigned long long* tp_ = (unsigned long long*)(a.ws + WS_CTL + 8192); tp_[8] = pt_[0]; tp_[9] = pt_[1]; tp_[10] = pt_[2]; }
#endif
    if (spq >= 0) { OPQ_IDX(); sp_end(sp, lane); }
    {   OPQ_IDX();
#pragma unroll
        for (int pt = 0; pt < 4; ++pt) *(f32x4*)(a.out + O_PSH + ((size_t)(b * NHEAD + h) * 64 + pt * 16 + fr) * 128 + n0 + 4 * fq) = accH[pt];
        for (int i = tid; i < 3 * 64; i += 512) { const int k = i >> 6, ch = h * 64 + (i & 63);
            a.out[O_PSC + (size_t)(b * 3 + k) * DXBC + ch] = bf1(P + (rowb + SEQ - 3 + k) * PW + 3072 + ch); }
        if ((h & 7) == 0) for (int i = tid; i < 3 * 256; i += 512) { const int k = i >> 8, ch = 1024 + ((i >> 7) & 1) * 256 + g * 128 + (i & 127);
            a.out[O_PSC + (size_t)(b * 3 + k) * DXBC + ch] = bf1(P + (rowb + SEQ - 3 + k) * PW + 3072 + ch); }
    }
    __syncthreads();
}

constexpr int XS = 144, LF = 68;
constexpr int LL_XC = 0, LL_WA = 18432, LL_WX = 27648, LL_XF = 36864, LL_A = 71680, LL_U = 106496, LL_SEGP = 141312, LL_SEGH = 143360, LL_HC = 145408, LL_PAR = 145920;
constexpr int LL_CW = 146688;
constexpr int LL_SEG2 = LL_CW + 1280;
static_assert(LL_SEG2 + 4096 <= MISC_OFF, "lru LDS map");
__device__ __forceinline__ float sigmoid_fast(float x) { return __builtin_amdgcn_rcpf(1.0f + __builtin_amdgcn_exp2f(-1.44269504f * x)); }
__device__ __forceinline__ float gelu_tanh_fast(float y) { const float v = 0.7978845608f * (y + 0.044715f * y * y * y); const float th = 1.0f - 2.0f * __builtin_amdgcn_rcpf(__builtin_amdgcn_exp2f(2.88539008f * v) + 1.0f); return 0.5f * y * (1.0f + th); }
__device__ __forceinline__ float one_minus_exp(float x) {
    const float ser = -x * (1.0f + x * (0.5f + x * (0.16666667f + x * (0.041666668f + x * (0.0083333338f + x * 0.0013888889f)))));
    const float dir = 1.0f - __builtin_amdgcn_exp2f(1.44269504f * x);
    return x > -0.3f ? ser : dir;
}
#define OPQ_IDX2() int tid = tid_in; asm volatile("" : "+v"(tid)); const int lane = tid & 63, fr = lane & 15, fq = lane >> 4; (void)fr; (void)fq; (void)lane

template <bool SAMPLE>
__device__ __forceinline__ void lru_unit_fast(const Args& a, LAS unsigned char* lds, int b, int hd, int tid_in, int wid) {
    bf16* P = (bf16*)(a.ws + WS_P); float* SSL = (float*)(a.ws + WS_SSL);
    const size_t rowb = SAMPLE ? (size_t)TP : (size_t)b * SEQ;
    LAS float* XF = (LAS float*)(lds + LL_XF); LAS float* AA = (LAS float*)(lds + LL_A); LAS float* UU = (LAS float*)(lds + LL_U);
    LAS float* SEGP = (LAS float*)(lds + LL_SEGP); LAS float* SEGH = (LAS float*)(lds + LL_SEGH); LAS float* HC = (LAS float*)(lds + LL_HC); LAS float* PAR = (LAS float*)(lds + LL_PAR);
    {   OPQ_IDX2();
        const float* Wa = a.in[I_LGAW] + (size_t)hd * 4096; const float* Wx = a.in[I_LGXW] + (size_t)hd * 4096;
        for (int idx = tid; idx < 4096; idx += 512) { const int i = idx >> 6, j = idx & 63;
            *(LAS unsigned short*)(lds + LL_WA + j * XS + i * 2) = (unsigned short)f2bf(Wa[idx]);
            *(LAS unsigned short*)(lds + LL_WX + j * XS + i * 2) = (unsigned short)f2bf(Wx[idx]); }
        if (tid < 64) { const int ch = hd * 64 + tid; PAR[tid] = a.in[I_LGAB][ch]; PAR[64 + tid] = a.in[I_LGXB][ch]; PAR[128 + tid] = 8.0f * softplus_f(-a.in[I_LAM][ch]); HC[tid] = 0.f; HC[64 + tid] = 0.f; }
    }
    __syncthreads();
    const int nchunk = SAMPLE ? 1 : SEQ / 128;
    for (int c = 0; c < nchunk; ++c) {
        const int t0 = c * 128;
        {   OPQ_IDX2();
            const int cg = tid & 7, j0 = 2 * (tid >> 3), ch0 = hd * 64 + cg * 8;
            const float* cw = a.in[I_LCW]; const float* cb = a.in[I_LCB];
            f32x4 w[4][2], bb[2];
#pragma unroll
            for (int k = 0; k < 4; ++k) { w[k][0] = *(const f32x4*)(cw + k * DLRU + ch0); w[k][1] = *(const f32x4*)(cw + k * DLRU + ch0 + 4); }
            bb[0] = *(const f32x4*)(cb + ch0); bb[1] = *(const f32x4*)(cb + ch0 + 4);
            if (!SAMPLE) {
                float xin[5][8];
#pragma unroll
                for (int i = 0; i < 5; ++i) { const int tt = t0 + j0 - 3 + i, ttc = tt < 0 ? 0 : tt;
                    v4u v = *(const v4u*)(P + (rowb + ttc) * PW + ch0);
                    if (tt < 0) v = (v4u){0u, 0u, 0u, 0u};
                    xin[i][0] = bf_lo(v.x); xin[i][1] = bf_hi(v.x); xin[i][2] = bf_lo(v.y); xin[i][3] = bf_hi(v.y); xin[i][4] = bf_lo(v.z); xin[i][5] = bf_hi(v.z); xin[i][6] = bf_lo(v.w); xin[i][7] = bf_hi(v.w); }
#pragma unroll
                for (int jj = 0; jj < 2; ++jj) { float o[8];
#pragma unroll
                    for (int q = 0; q < 8; ++q) o[q] = bb[q >> 2][q & 3] + w[0][q >> 2][q & 3] * xin[jj][q] + w[1][q >> 2][q & 3] * xin[jj + 1][q] + w[2][q >> 2][q & 3] * xin[jj + 2][q] + w[3][q >> 2][q & 3] * xin[jj + 3][q];
                    *(LAS f32x4*)(XF + (j0 + jj) * LF + cg * 8) = (f32x4){o[0], o[1], o[2], o[3]}; *(LAS f32x4*)(XF + (j0 + jj) * LF + cg * 8 + 4) = (f32x4){o[4], o[5], o[6], o[7]};
                    v4u pw; pw.x = pg8::cvt_pk_bf16(o[0], o[1]); pw.y = pg8::cvt_pk_bf16(o[2], o[3]); pw.z = pg8::cvt_pk_bf16(o[4], o[5]); pw.w = pg8::cvt_pk_bf16(o[6], o[7]);
                    *(LAS v4u*)(lds + LL_XC + (j0 + jj) * XS + cg * 16) = pw; }
            } else {
#pragma unroll
                for (int jj = 0; jj < 2; ++jj) { const int s = j0 + jj;
                    const v4u v = *(const v4u*)(P + (rowb + s) * PW + ch0);
                    const float xn[8] = {bf_lo(v.x), bf_hi(v.x), bf_lo(v.y), bf_hi(v.y), bf_lo(v.z), bf_hi(v.z), bf_lo(v.w), bf_hi(v.w)};
                    const float* sb = a.in[I_SLC] + (size_t)s * 3 * DLRU + ch0; float* so = a.out + O_SLC + (size_t)s * 3 * DLRU + ch0;
                    f32x4 h0[2], h1[2], h2[2];
#pragma unroll
                    for (int q = 0; q < 2; ++q) { h0[q] = *(const f32x4*)(sb + 4 * q); h1[q] = *(const f32x4*)(sb + DLRU + 4 * q); h2[q] = *(const f32x4*)(sb + 2 * DLRU + 4 * q); }
                    float o[8];
#pragma unroll
                    for (int q = 0; q < 8; ++q) o[q] = bb[q >> 2][q & 3] + w[0][q >> 2][q & 3] * h0[q >> 2][q & 3] + w[1][q >> 2][q & 3] * h1[q >> 2][q & 3] + w[2][q >> 2][q & 3] * h2[q >> 2][q & 3] + w[3][q >> 2][q & 3] * xn[q];
#pragma unroll
                    for (int q = 0; q < 2; ++q) { *(f32x4*)(so + 4 * q) = h1[q]; *(f32x4*)(so + DLRU + 4 * q) = h2[q]; *(f32x4*)(so + 2 * DLRU + 4 * q) = (f32x4){xn[4 * q], xn[4 * q + 1], xn[4 * q + 2], xn[4 * q + 3]}; }
                    *(LAS f32x4*)(XF + s * LF + cg * 8) = (f32x4){o[0], o[1], o[2], o[3]}; *(LAS f32x4*)(XF + s * LF + cg * 8 + 4) = (f32x4){o[4], o[5], o[6], o[7]};
                    v4u pw; pw.x = pg8::cvt_pk_bf16(o[0], o[1]); pw.y = pg8::cvt_pk_bf16(o[2], o[3]); pw.z = pg8::cvt_pk_bf16(o[4], o[5]); pw.w = pg8::cvt_pk_bf16(o[6], o[7]);
                    *(LAS v4u*)(lds + LL_XC + s * XS + cg * 16) = pw; }
            }
        }
        __syncthreads();
        {   OPQ_IDX2();
            const int tok = wid * 16 + fr;
            bf16x8 xf[2];
#pragma unroll
            for (int ks = 0; ks < 2; ++ks) xf[ks] = *(const LAS bf16x8*)(lds + LL_XC + tok * XS + ks * 64 + fq * 16);
#pragma unroll
            for (int jt = 0; jt < 4; ++jt) {
                f32x4 ga = (f32x4){0.f, 0.f, 0.f, 0.f}, gx = (f32x4){0.f, 0.f, 0.f, 0.f};
#pragma unroll
                for (int ks = 0; ks < 2; ++ks) {
                    ga = MFMA16(*(const LAS bf16x8*)(lds + LL_WA + (jt * 16 + fr) * XS + ks * 64 + fq * 16), xf[ks], ga);
                    gx = MFMA16(*(const LAS bf16x8*)(lds + LL_WX + (jt * 16 + fr) * XS + ks * 64 + fq * 16), xf[ks], gx); }
                const int j = jt * 16 + 4 * fq;
                const f32x4 ba = *(const LAS f32x4*)(PAR + j), bx = *(const LAS f32x4*)(PAR + 64 + j), sp = *(const LAS f32x4*)(PAR + 128 + j), xc = *(const LAS f32x4*)(XF + tok * LF + j);
                f32x4 av, uv;
#pragma unroll
                for (int r = 0; r < 4; ++r) { const float rr = sigmoid_fast(ga[r] + ba[r]), ig = sigmoid_fast(gx[r] + bx[r]), la = -rr * sp[r];
                    av[r] = __builtin_amdgcn_exp2f(1.44269504f * la); uv[r] = __builtin_amdgcn_sqrtf(fmaxf(fmaf(-av[r], av[r], 1.0f), 0.f)) * (ig * xc[r]); }
                *(LAS f32x4*)(AA + tok * LF + j) = av; *(LAS f32x4*)(UU + tok * LF + j) = uv;
            }
        }
        __syncthreads();
        if (!SAMPLE) {
            OPQ_IDX2();
            float cp[16], hl[16]; float pp = 1.f, hh = 0.f;
#pragma unroll
            for (int t = 0; t < 16; ++t) { const float at = AA[(wid * 16 + t) * LF + lane], ut = UU[(wid * 16 + t) * LF + lane]; pp *= at; hh = at * hh + ut; cp[t] = pp; hl[t] = hh; }
            SEGP[wid * 64 + lane] = pp; SEGH[wid * 64 + lane] = hh;
            __syncthreads();
            float cin = HC[(c & 1) * 64 + lane];
            for (int s = 0; s < wid; ++s) cin = SEGP[s * 64 + lane] * cin + SEGH[s * 64 + lane];
            if (wid == 7) HC[((c + 1) & 1) * 64 + lane] = hl[15] + cp[15] * cin;
            const int ch = hd * 64 + lane;
#pragma unroll
            for (int t = 0; t < 16; ++t) { const size_t row = rowb + t0 + wid * 16 + t; bf16* yp = P + row * PW + DLRU + ch;
                const float ht = hl[t] + cp[t] * cin, gv = ht * gelu_tanh_fast(bf1(yp));
                const float ss = wave_sum(gv * gv);
                *yp = f2bf1(gv);
                if (lane == 0) SSL[row * 16 + hd] = ss; }
            if (c == nchunk - 1 && wid == 7) a.out[O_PLH + (size_t)b * DLRU + ch] = hl[15] + cp[15] * cin;
        } else {
            OPQ_IDX2();
            const int ch = hd * 64 + lane;
#pragma unroll
            for (int t = 0; t < 16; ++t) { const int s = wid * 16 + t; const size_t row = rowb + s; bf16* yp = P + row * PW + DLRU + ch;
                const float ht = AA[s * LF + lane] * a.in[I_SLH][(size_t)s * DLRU + ch] + UU[s * LF + lane];
                a.out[O_SLH + (size_t)s * DLRU + ch] = ht;
                const float gv = ht * gelu_tanh_fast(bf1(yp));
                const float ss = wave_sum(gv * gv);
                *yp = f2bf1(gv);
                if (lane == 0) SSL[row * 16 + hd] = ss; }
        }
    }
    if (!SAMPLE) {
        OPQ_IDX2();
        for (int i = tid; i < 3 * 64; i += 512) { const int k = i >> 6, ch = hd * 64 + (i & 63);
            a.out[O_PLC + (size_t)(b * 3 + k) * DLRU + ch] = bf1(P + (rowb + SEQ - 3 + k) * PW + ch); }
    }
    __syncthreads();
}

__device__ __forceinline__ void lru_unit_prompt(const Args& a, LAS unsigned char* lds, int b, int hd, int tid_in, int wid, int spq, int spq2) {
    bf16* P = (bf16*)(a.ws + WS_P); float* SSL = (float*)(a.ws + WS_SSL);
    const size_t rowb = (size_t)b * SEQ;
    LAS float* XF = (LAS float*)(lds + LL_XF); LAS float* AA = (LAS float*)(lds + LL_A); LAS float* UU = (LAS float*)(lds + LL_U);
    LAS float* SEGP = (LAS float*)(lds + LL_SEGP); LAS float* SEGH = (LAS float*)(lds + LL_SEGH); LAS float* HC = (LAS float*)(lds + LL_HC); LAS float* PAR = (LAS float*)(lds + LL_PAR);
    v4u px[5]; v4u pyv[2];
#define LRU_PREF_X(tc) do { OPQ_IDX2(); const bf16* pp_ = P + rowb * PW + hd * 64 + (tid & 7) * 8; const int j0_ = 2 * (tid >> 3); \
        _Pragma("unroll") for (int i_ = 0; i_ < 5; ++i_) { const int tt_ = (tc) + j0_ - 3 + i_; if (LRU_PF_GUARD) { px[i_] = *(const v4u*)(pp_ + (size_t)(tt_ < 0 ? 0 : tt_) * PW); if (tt_ < 0) px[i_] = (v4u){0u, 0u, 0u, 0u}; } else px[i_] = *(const v4u*)(pp_ + (size_t)tt_ * PW); } } while (0)
#define LRU_PREF_Y(tc) do { OPQ_IDX2(); const bf16* yp_ = P + (rowb + (tc) + wid * 16 + fr) * PW + DLRU + hd * 64 + fq * 16; \
        pyv[0] = *(const v4u*)yp_; pyv[1] = *(const v4u*)(yp_ + 8); } while (0)
#define LRU_CONV() do { OPQ_IDX2(); const int cg = tid & 7, j0 = 2 * (tid >> 3); ConvW cv; { const LAS float* cw_ = (const LAS float*)(lds + LL_CW) + cg * 40; \
        _Pragma("unroll") for (int k_ = 0; k_ < 4; ++k_) { cv.w[k_][0] = *(const LAS f32x4*)(cw_ + k_ * 8); cv.w[k_][1] = *(const LAS f32x4*)(cw_ + k_ * 8 + 4); } cv.b[0] = *(const LAS f32x4*)(cw_ + 32); cv.b[1] = *(const LAS f32x4*)(cw_ + 36); } \
        float s0[8], s1[8], s2[8], s3[8], s4[8], o0[8], o1[8]; unpack8(px[0], s0); unpack8(px[1], s1); unpack8(px[2], s2); unpack8(px[3], s3); unpack8(px[4], s4); \
        conv_tok(cv, s0, s1, s2, s3, o0); conv_tok(cv, s1, s2, s3, s4, o1); \
        *(LAS f32x4*)(XF + j0 * LF + cg * 8) = (f32x4){o0[0], o0[1], o0[2], o0[3]}; *(LAS f32x4*)(XF + j0 * LF + cg * 8 + 4) = (f32x4){o0[4], o0[5], o0[6], o0[7]}; \
        *(LAS f32x4*)(XF + (j0 + 1) * LF + cg * 8) = (f32x4){o1[0], o1[1], o1[2], o1[3]}; *(LAS f32x4*)(XF + (j0 + 1) * LF + cg * 8 + 4) = (f32x4){o1[4], o1[5], o1[6], o1[7]}; \
        *(LAS v4u*)(lds + LL_XC + j0 * XS + cg * 16) = (v4u){pg8::cvt_pk_bf16(o0[0], o0[1]), pg8::cvt_pk_bf16(o0[2], o0[3]), pg8::cvt_pk_bf16(o0[4], o0[5]), pg8::cvt_pk_bf16(o0[6], o0[7])}; \
        *(LAS v4u*)(lds + LL_XC + (j0 + 1) * XS + cg * 16) = (v4u){pg8::cvt_pk_bf16(o1[0], o1[1]), pg8::cvt_pk_bf16(o1[2], o1[3]), pg8::cvt_pk_bf16(o1[4], o1[5]), pg8::cvt_pk_bf16(o1[6], o1[7])}; } while (0)
#define LRU_PF_GUARD true
    LRU_PREF_X(0); LRU_PREF_Y(0);
#undef LRU_PF_GUARD
#define LRU_PF_GUARD false
    {   OPQ_IDX2();
        const float* Wa = a.in[I_LGAW] + (size_t)hd * 4096; const float* Wx = a.in[I_LGXW] + (size_t)hd * 4096;
        float wa_[8], wx_[8];
#pragma unroll
        for (int q = 0; q < 8; ++q) { wa_[q] = __builtin_nontemporal_load(Wa + tid + 512 * q); wx_[q] = __builtin_nontemporal_load(Wx + tid + 512 * q); }
#pragma unroll
        for (int q = 0; q < 8; ++q) { const int idx = tid + 512 * q, i = idx >> 6, j = idx & 63;
            *(LAS unsigned short*)(lds + LL_WA + j * XS + i * 2) = (unsigned short)f2bf(wa_[q]);
            *(LAS unsigned short*)(lds + LL_WX + j * XS + i * 2) = (unsigned short)f2bf(wx_[q]); }
        if (tid < 64) { const int ch = hd * 64 + tid; PAR[tid] = a.in[I_LGAB][ch]; PAR[64 + tid] = a.in[I_LGXB][ch]; PAR[128 + tid] = 8.0f * softplus_f(-a.in[I_LAM][ch]); HC[tid] = 0.f; HC[64 + tid] = 0.f;
            LAS float* cw_ = (LAS float*)(lds + LL_CW) + (tid >> 3) * 40 + (tid & 7); const float* gw_ = a.in[I_LCW];
            cw_[0] = gw_[ch]; cw_[8] = gw_[DLRU + ch]; cw_[16] = gw_[2 * DLRU + ch]; cw_[24] = gw_[3 * DLRU + ch]; cw_[32] = a.in[I_LCB][ch]; }
    }
    SPair sp, sp2; f32x4 sh0 = (f32x4){0.f, 0.f, 0.f, 0.f}, sh1 = sh0, sh2 = sh0, sh3 = sh0;
    if (spq >= 0) { OPQ_IDX2(); sp_begin(sp, a, spq, lane); }
    if (spq2 >= 0) { OPQ_IDX2(); sp_begin(sp2, a, spq2, lane); }
    __syncthreads();
    LRU_CONV();
    for (int c = 0; c < SEQ / 128; ++c) {
        const int t0 = c * 128;
        asm volatile("s_waitcnt lgkmcnt(0)" ::: "memory");
        LAS float* SEGPc = (c & 1) ? (LAS float*)(lds + LL_SEG2) : SEGP; LAS float* SEGHc = (c & 1) ? (LAS float*)(lds + LL_SEG2 + 2048) : SEGH;
        {   OPQ_IDX2();
            const int tok = wid * 16 + fr;
            bf16x8 xf[2];
#pragma unroll
            for (int ks = 0; ks < 2; ++ks) xf[ks] = *(const LAS bf16x8*)(lds + LL_XC + tok * XS + ks * 64 + fq * 16);
            bf16x8 gw[2][4]; f32x4 gp[2][4];
#define LRU_LOADJ(jt_, s_) do { _Pragma("unroll") for (int ks_ = 0; ks_ < 2; ++ks_) { \
                    gw[s_][2 * ks_] = *(const LAS bf16x8*)(lds + LL_WA + ((jt_) * 16 + fr) * XS + ks_ * 64 + fq * 16); gw[s_][2 * ks_ + 1] = *(const LAS bf16x8*)(lds + LL_WX + ((jt_) * 16 + fr) * XS + ks_ * 64 + fq * 16); } \
                gp[s_][0] = *(const LAS f32x4*)(PAR + (jt_) * 16 + 4 * fq); gp[s_][1] = *(const LAS f32x4*)(PAR + 64 + (jt_) * 16 + 4 * fq); gp[s_][2] = *(const LAS f32x4*)(PAR + 128 + (jt_) * 16 + 4 * fq); \
                gp[s_][3] = *(const LAS f32x4*)(XF + tok * LF + (jt_) * 16 + 4 * fq); } while (0)
            LRU_LOADJ(0, 0);
            __builtin_amdgcn_sched_barrier(0);
#pragma unroll
            for (int jt = 0; jt < 4; ++jt) {
                if (jt < 3) LRU_LOADJ(jt + 1, (jt + 1) & 1);
                __builtin_amdgcn_sched_barrier(0);
                f32x4 ga = (f32x4){0.f, 0.f, 0.f, 0.f}, gx = (f32x4){0.f, 0.f, 0.f, 0.f};
#pragma unroll
                for (int ks = 0; ks < 2; ++ks) { ga = MFMA16(gw[jt & 1][2 * ks], xf[ks], ga); gx = MFMA16(gw[jt & 1][2 * ks + 1], xf[ks], gx); }
                const int j = jt * 16 + 4 * fq;
                const f32x4 ba = gp[jt & 1][0], bx = gp[jt & 1][1], sp = gp[jt & 1][2], xc = gp[jt & 1][3];
                f32x4 av, uv;
#pragma unroll
                for (int r = 0; r < 4; ++r) { const float rr = sigmoid_fast(ga[r] + ba[r]), ig = sigmoid_fast(gx[r] + bx[r]), la = -rr * sp[r];
                    av[r] = __builtin_amdgcn_exp2f(1.44269504f * la); uv[r] = __builtin_amdgcn_sqrtf(fmaxf(fmaf(-av[r], av[r], 1.0f), 0.f)) * (ig * xc[r]); }
                *(LAS f32x4*)(AA + tok * LF + j) = av; *(LAS f32x4*)(UU + tok * LF + j) = uv;
                __builtin_amdgcn_sched_barrier(0);
            }
#undef LRU_LOADJ
        }
        LRU_PREF_X(t0 + 128);
        if (spq >= 0) sp_prefetch(sp, c, sh0, sh1);
        if (spq2 >= 0) sp_prefetch(sp2, c, sh2, sh3);
        asm volatile("s_waitcnt lgkmcnt(0)" ::: "memory");
        OPQ_IDX2();
        float cp[16], hl[16]; float pp = 1.f, hh = 0.f;
#pragma unroll
        for (int t = 0; t < 16; ++t) { const float at = AA[(wid * 16 + t) * LF + lane], ut = UU[(wid * 16 + t) * LF + lane]; pp *= at; hh = at * hh + ut; cp[t] = pp; hl[t] = hh; }
        SEGPc[wid * 64 + lane] = pp; SEGHc[wid * 64 + lane] = hh;
        __syncthreads();
        float cin = HC[(c & 1) * 64 + lane];
        {   float sp_[7], sh_[7];
#pragma unroll
            for (int s = 0; s < 7; ++s) { sp_[s] = SEGPc[s * 64 + lane]; sh_[s] = SEGHc[s * 64 + lane]; }
#pragma unroll
            for (int s = 0; s < 7; ++s) { const float nx = sp_[s] * cin + sh_[s]; cin = s < wid ? nx : cin; } }
        const float hlast = hl[15] + cp[15] * cin;
        if (wid == 7) HC[((c + 1) & 1) * 64 + lane] = hlast;
        const int ch = hd * 64 + lane;
        float sq[16];
        {   LAS unsigned char* T_ = lds + LL_A + (wid * 16) * (LF * 4);
            LAS unsigned char* O_ = lds + LL_U + (wid * 16) * (LF * 4);
            const int trq = (fr >> 2) & 3, trp = fr & 3;
            *(LAS v4u*)(T_ + fr * 144 + fq * 32) = pyv[0]; *(LAS v4u*)(T_ + fr * 144 + fq * 32 + 16) = pyv[1];
            asm volatile("s_waitcnt lgkmcnt(0)" ::: "memory");
            v2u yq[4];
#pragma unroll
            for (int tb = 0; tb < 4; ++tb) yq[tb] = LDTR(T_ + (4 * tb + trq) * 144 + (fq * 16 + 4 * trp) * 2);
            unsigned ow[8];
#pragma unroll
            for (int tb = 0; tb < 4; ++tb) {
                const float y0 = bf_lo(yq[tb].x), y1 = bf_hi(yq[tb].x), y2 = bf_lo(yq[tb].y), y3 = bf_hi(yq[tb].y);
                const float g0 = (hl[4 * tb + 0] + cp[4 * tb + 0] * cin) * gelu_tanh_fast(y0), g1 = (hl[4 * tb + 1] + cp[4 * tb + 1] * cin) * gelu_tanh_fast(y1),
                            g2 = (hl[4 * tb + 2] + cp[4 * tb + 2] * cin) * gelu_tanh_fast(y2), g3 = (hl[4 * tb + 3] + cp[4 * tb + 3] * cin) * gelu_tanh_fast(y3);
                sq[4 * tb + 0] = g0 * g0; sq[4 * tb + 1] = g1 * g1; sq[4 * tb + 2] = g2 * g2; sq[4 * tb + 3] = g3 * g3;
                ow[2 * tb] = cvtpk(g0, g1); ow[2 * tb + 1] = cvtpk(g2, g3); }
            *(LAS v4u*)(O_ + lane * 48) = (v4u){ow[0], ow[1], ow[2], ow[3]}; *(LAS v4u*)(O_ + lane * 48 + 16) = (v4u){ow[4], ow[5], ow[6], ow[7]};
            asm volatile("s_waitcnt lgkmcnt(0)" ::: "memory");
            v2u oq[4];
#pragma unroll
            for (int r = 0; r < 4; ++r) oq[r] = LDTR(O_ + (fq * 16 + 4 * r + trq) * 48 + (4 * trp) * 2);
            bf16* yo = P + (rowb + t0 + wid * 16 + fr) * PW + DLRU + hd * 64 + fq * 16;
            *(v4u*)yo = (v4u){oq[0].x, oq[0].y, oq[1].x, oq[1].y}; *(v4u*)(yo + 8) = (v4u){oq[2].x, oq[2].y, oq[3].x, oq[3].y}; }
        {
            float w8[8], w4[4], w2[2], w1;
            const bool u5 = lane & 32, u4 = lane & 16, u3 = lane & 8, u2 = lane & 4;
#pragma unroll
            for (int k = 0; k < 8; ++k) w8[k] = pg8::bfly32(sq[k], sq[k + 8]);
#pragma unroll
            for (int k = 0; k < 4; ++k) w4[k] = pg8::bfly16(w8[k], w8[k + 4]);
#pragma unroll
            for (int k = 0; k < 2; ++k) { const float keep = u3 ? w4[k + 2] : w4[k], send = u3 ? w4[k] : w4[k + 2]; w2[k] = keep + pg8::dpp_xor8(send); }
            { const float keep = u2 ? w2[1] : w2[0], send = u2 ? w2[0] : w2[1]; w1 = keep + pg8::dpp_xor4(send, u2); }
            w1 += pg8::dpp_xor2(w1); w1 += pg8::dpp_xor1(w1);
            const int tsel = ((lane >> 5) & 1) * 8 + ((lane >> 4) & 1) * 4 + ((lane >> 3) & 1) * 2 + ((lane >> 2) & 1);
            if ((lane & 3) == 0) SSL[(rowb + t0 + wid * 16 + tsel) * 16 + hd] = w1; }
        if (spq >= 0) sp_step(sp, c, sh0, sh1, lane);
        if (spq2 >= 0) sp_step(sp2, c, sh2, sh3, lane);
        if (c == SEQ / 128 - 1 && wid == 7) a.out[O_PLH + (size_t)b * DLRU + ch] = hlast;
        if (c + 1 < SEQ / 128) { LRU_PREF_Y(t0 + 128); LRU_CONV(); }
    }
    if (spq >= 0) { OPQ_IDX2(); sp_end(sp, lane); }
    if (spq2 >= 0) { OPQ_IDX2(); sp_end(sp2, lane); }
    __syncthreads();
    float dh_[2], dy_[2];
    {   OPQ_IDX2(); const int ch = hd * 64 + lane;
#pragma unroll
        for (int t = 0; t < 2; ++t) { const int sl = wid * 2 + t, sq = 16 * b + sl; dh_[t] = a.in[I_SLH][(size_t)sq * DLRU + ch]; dy_[t] = bf1(P + ((size_t)TP + sq) * PW + DLRU + ch); } }
    if (wid < 2) {   OPQ_IDX2();
        const int cg = tid & 7, sl = tid >> 3, sq = 16 * b + sl, ch0 = hd * 64 + cg * 8;
        ConvW cv; load_convw(cv, a.in[I_LCW], a.in[I_LCB], DLRU, ch0);
        const v4u v = *(const v4u*)(P + ((size_t)TP + sq) * PW + ch0);
        float xn[8]; unpack8(v, xn);
        const float* sb = a.in[I_SLC] + (size_t)sq * 3 * DLRU + ch0; float* so = a.out + O_SLC + (size_t)sq * 3 * DLRU + ch0;
        f32x4 h0[2], h1[2], h2[2];
#pragma unroll
        for (int q = 0; q < 2; ++q) { h0[q] = *(const f32x4*)(sb + 4 * q); h1[q] = *(const f32x4*)(sb + DLRU + 4 * q); h2[q] = *(const f32x4*)(sb + 2 * DLRU + 4 * q); }
        float o[8];
#pragma unroll
        for (int q = 0; q < 8; ++q) o[q] = cv.b[q >> 2][q & 3] + cv.w[0][q >> 2][q & 3] * h0[q >> 2][q & 3] + cv.w[1][q >> 2][q & 3] * h1[q >> 2][q & 3] + cv.w[2][q >> 2][q & 3] * h2[q >> 2][q & 3] + cv.w[3][q >> 2][q & 3] * xn[q];
#pragma unroll
        for (int q = 0; q < 2; ++q) { *(f32x4*)(so + 4 * q) = h1[q]; *(f32x4*)(so + DLRU + 4 * q) = h2[q]; *(f32x4*)(so + 2 * DLRU + 4 * q) = (f32x4){xn[4 * q], xn[4 * q + 1], xn[4 * q + 2], xn[4 * q + 3]}; }
        *(LAS f32x4*)(XF + sl * LF + cg * 8) = (f32x4){o[0], o[1], o[2], o[3]}; *(LAS f32x4*)(XF + sl * LF + cg * 8 + 4) = (f32x4){o[4], o[5], o[6], o[7]};
        *(LAS v4u*)(lds + LL_XC + sl * XS + cg * 16) = (v4u){pg8::cvt_pk_bf16(o[0], o[1]), pg8::cvt_pk_bf16(o[2], o[3]), pg8::cvt_pk_bf16(o[4], o[5]), pg8::cvt_pk_bf16(o[6], o[7])};
    }
    __syncthreads();
    if (wid == 0) {   OPQ_IDX2();
        const int tok = fr;
        bf16x8 xf[2];
#pragma unroll
        for (int ks = 0; ks < 2; ++ks) xf[ks] = *(const LAS bf16x8*)(lds + LL_XC + tok * XS + ks * 64 + fq * 16);
#pragma unroll
        for (int jt = 0; jt < 4; ++jt) {
            f32x4 ga = (f32x4){0.f, 0.f, 0.f, 0.f}, gx = (f32x4){0.f, 0.f, 0.f, 0.f};
#pragma unroll
            for (int ks = 0; ks < 2; ++ks) {
                ga = MFMA16(*(const LAS bf16x8*)(lds + LL_WA + (jt * 16 + fr) * XS + ks * 64 + fq * 16), xf[ks], ga);
                gx = MFMA16(*(const LAS bf16x8*)(lds + LL_WX + (jt * 16 + fr) * XS + ks * 64 + fq * 16), xf[ks], gx); }
            const int j = jt * 16 + 4 * fq;
            const f32x4 ba = *(const LAS f32x4*)(PAR + j), bx = *(const LAS f32x4*)(PAR + 64 + j), sp = *(const LAS f32x4*)(PAR + 128 + j), xc = *(const LAS f32x4*)(XF + tok * LF + j);
            f32x4 av, uv;
#pragma unroll
            for (int r = 0; r < 4; ++r) { const float rr = sigmoid_fast(ga[r] + ba[r]), ig = sigmoid_fast(gx[r] + bx[r]), la = -rr * sp[r];
                av[r] = __builtin_amdgcn_exp2f(1.44269504f * la); uv[r] = __builtin_amdgcn_sqrtf(fmaxf(fmaf(-av[r], av[r], 1.0f), 0.f)) * (ig * xc[r]); }
            *(LAS f32x4*)(AA + tok * LF + j) = av; *(LAS f32x4*)(UU + tok * LF + j) = uv;
        }
    }
    __syncthreads();
    {   OPQ_IDX2();
        const int ch = hd * 64 + lane;
#pragma unroll
        for (int t = 0; t < 2; ++t) { const int sl = wid * 2 + t, sq = 16 * b + sl; const size_t row = (size_t)TP + sq; bf16* yp = P + row * PW + DLRU + ch;
            const float ht = AA[sl * LF + lane] * dh_[t] + UU[sl * LF + lane];
            a.out[O_SLH + (size_t)sq * DLRU + ch] = ht;
            const float gv = ht * gelu_tanh_fast(dy_[t]);
            const float ss = wave_sum(gv * gv);
            *yp = f2bf1(gv);
            if (lane == 0) SSL[row * 16 + hd] = ss; }
    }
    {   OPQ_IDX2();
        for (int i = tid; i < 3 * 64; i += 512) { const int k = i >> 6, ch = hd * 64 + (i & 63);
            a.out[O_PLC + (size_t)(b * 3 + k) * DLRU + ch] = bf1(P + (rowb + SEQ - 3 + k) * PW + ch); }
    }
    __syncthreads();
}

__device__ __forceinline__ void ssd_sample_pair(const Args& a, LAS float* wsc, int s, int h, int lane_in) {
    int lane = lane_in; asm volatile("" : "+v"(lane));
    bf16* P = (bf16*)(a.ws + WS_P); float* SSS = (float*)(a.ws + WS_SSS); const float* DT = (const float*)(a.ws + WS_DT);
    const float* cw = a.in[I_SCW]; const float* cb = a.in[I_SCB]; const float* cs = a.in[I_SSC] + (size_t)s * 3 * DXBC;
    const int g = h >> 3; const size_t row = (size_t)TP + s;
    const float Ah = -expf(a.in[I_SALOG][h]), dtb = a.in[I_SDTB][h], Dh = a.in[I_SD][h];
    float* cso = a.out + O_SSC + (size_t)s * 3 * DXBC;
    float xv = 0.f;
#pragma unroll
    for (int q = 0; q < 5; ++q) {
        const int ch = q == 0 ? h * 64 + lane : (q < 3 ? 1024 : 1280) + g * 128 + lane + ((q - 1) & 1) * 64;
        const float x0 = cs[ch], x1 = cs[DXBC + ch], x2 = cs[2 * DXBC + ch], xn = bf1(P + row * PW + 3072 + ch);
        const float v = cb[ch] + cw[ch] * x0 + cw[DXBC + ch] * x1 + cw[2 * DXBC + ch] * x2 + cw[3 * DXBC + ch] * xn;
        const float sv = silu_fast(v);
        if (q == 0 || (h & 7) == 0) { cso[ch] = x1; cso[DXBC + ch] = x2; cso[2 * DXBC + ch] = xn; }
        if (q == 0) { xv = sv; wsc[lane] = sv; } else wsc[64 + (q - 1) * 64 + lane] = sv;
    }
    const float dt = softplus_f(DT[row * 16 + h] + dtb), dA = exp_fast(dt * Ah);
    LDS_WAIT(); asm volatile("" ::: "memory");
    const int hf = lane >> 5, nq = lane & 31;
    const f32x4 B4 = *(const LAS f32x4*)(wsc + 64 + nq * 4), C4 = *(const LAS f32x4*)(wsc + 192 + nq * 4);
    const f32x4* hin = (const f32x4*)(a.in[I_SSH] + (size_t)(s * NHEAD + h) * 8192) + lane; f32x4* hout = (f32x4*)(a.out + O_SSH + (size_t)(s * NHEAD + h) * 8192) + lane;
    float part[32];
#pragma unroll
    for (int ib = 0; ib < 2; ++ib) {
        f32x4 hv[16];
#pragma unroll
        for (int k = 0; k < 16; ++k) hv[k] = hin[(ib * 16 + k) * 64];
#pragma unroll
        for (int k = 0; k < 16; ++k) { const int it = ib * 16 + k; const float xd = dt * wsc[2 * it + hf];
            const f32x4 hn = hv[k] * dA + B4 * xd; hout[it * 64] = hn;
            part[it] = (C4[0] * hn[0] + C4[1] * hn[1]) + (C4[2] * hn[2] + C4[3] * hn[3]); }
    }
    float r16[16], r8[8], r4[4], r2[2], yv;
    { const bool u = lane & 16;
#pragma unroll
      for (int k = 0; k < 16; ++k) { const float keep = u ? part[k + 16] : part[k], send = u ? part[k] : part[k + 16]; r16[k] = keep + __shfl_xor(send, 16); } }
    { const bool u = lane & 8;
#pragma unroll
      for (int k = 0; k < 8; ++k) { const float keep = u ? r16[k + 8] : r16[k], send = u ? r16[k] : r16[k + 8]; r8[k] = keep + __shfl_xor(send, 8); } }
    { const bool u = lane & 4;
#pragma unroll
      for (int k = 0; k < 4; ++k) { const float keep = u ? r8[k + 4] : r8[k], send = u ? r8[k] : r8[k + 4]; r4[k] = keep + __shfl_xor(send, 4); } }
    { const bool u = lane & 2;
#pragma unroll
      for (int k = 0; k < 2; ++k) { const float keep = u ? r4[k + 2] : r4[k], send = u ? r4[k] : r4[k + 2]; r2[k] = keep + __shfl_xor(send, 2); } }
    { const bool u = lane & 1; const float keep = u ? r2[1] : r2[0], send = u ? r2[0] : r2[1]; yv = keep + __shfl_xor(send, 1); }
    const int itsel = ((lane >> 4) & 1) * 16 + ((lane >> 3) & 1) * 8 + ((lane >> 2) & 1) * 4 + ((lane >> 1) & 1) * 2 + (lane & 1), p = 2 * itsel + hf;
    bf16* zp = P + row * PW + 2048 + h * 64 + p;
    const float y = yv + Dh * wsc[p], gv = y * silu_fast(bf1(zp));
    const float ss = wave_sum(gv * gv);
    *zp = f2bf1(gv);
    if (lane == 0) SSS[row * 16 + h] = ss;
    (void)xv;
    LDS_WAIT(); asm volatile("" ::: "memory");
}

__device__ __forceinline__ void mixer_phase(const Args& a, LAS unsigned char* lds, int vcu, int G, int tid) {
    const int wave = __builtin_amdgcn_readfirstlane(tid >> 6), lane = tid & 63;
    const int half = G / 2;
#if defined(PROBE_MX)
    unsigned long long* tq = (unsigned long long*)(a.ws + WS_CTL + 8192); const bool st_ = ((vcu == 0 || vcu == half) && tid == 0); unsigned long long t0_ = __builtin_amdgcn_s_memrealtime();
#define MSTAMP(k) do { if (st_) { const unsigned long long t1_ = __builtin_amdgcn_s_memrealtime(); tq[(vcu == 0 ? 0 : 4) + (k)] = t1_ - t0_; t0_ = t1_; } } while (0)
#else
#define MSTAMP(k) do { } while (0)
#endif
    const bool fused = (G == 256);
    if (!fused) { for (int q = vcu * NWAVES + wave; q < TS * NHEAD; q += G * NWAVES) ssd_sample_pair(a, (LAS float*)(lds) + wave * 320, q >> 4, q & 15, lane);
        __syncthreads(); }
    MSTAMP(0);
    if (vcu < half) {
        for (int u = vcu; u < NB * NHEAD; u += half) ssd_unit_fast(a, lds, u >> 4, u & 15, tid, wave, lane, -1);
        tr_range(a, lds, IT_WGU2 + 384, IT_WD2, vcu * NWAVES + wave, half * NWAVES, wave, lane);
        MSTAMP(1);
    } else {
        const int v = vcu - half, nv = G - half;
        for (int u = v; u < NB * NHEAD; u += nv) lru_unit_prompt(a, lds, u >> 4, u & 15, tid, wave, fused ? 2 * (v * NWAVES + wave) : -1, fused ? 2 * (v * NWAVES + wave) + 1 : -1);
        MSTAMP(1);
    }
}

__device__ __forceinline__ void norm_phase(const Args& a, int vcu, int G, int wave, int lane) {
    bf16* P = (bf16*)(a.ws + WS_P); const float* SSL = (const float*)(a.ws + WS_SSL); const float* SSS = (const float*)(a.ws + WS_SSS);
    const int gw = vcu * NWAVES + wave, NGW = G * NWAVES;
    for (int m = gw; m < MREAL; m += NGW) {
        float sl = 0.f, s0 = 0.f, s1 = 0.f;
#pragma unroll
        for (int k = 0; k < 16; ++k) sl += SSL[(size_t)m * 16 + k];
#pragma unroll
        for (int k = 0; k < 8; ++k) { s0 += SSS[(size_t)m * 16 + k]; s1 += SSS[(size_t)m * 16 + 8 + k]; }
        const float rl = 1.0f / sqrtf(sl * (1.0f / 1024.0f) + EPS), r0 = 1.0f / sqrtf(s0 * (1.0f / 512.0f) + EPS), r1 = 1.0f / sqrtf(s1 * (1.0f / 512.0f) + EPS);
        GAS v4u* pr = (GAS v4u*)(P + (size_t)m * PW + DLRU) + lane;
#pragma unroll
        for (int j = 0; j < 4; ++j) { const float r = j < 2 ? rl : (j == 2 ? r0 : r1);
            v4u w = pr[64 * j];
            w.x = pk2(bf_lo(w.x) * r, bf_hi(w.x) * r); w.y = pk2(bf_lo(w.y) * r, bf_hi(w.y) * r); w.z = pk2(bf_lo(w.z) * r, bf_hi(w.z) * r); w.w = pk2(bf_lo(w.w) * r, bf_hi(w.w) * r);
            pr[64 * j] = w; }
    }
}

__global__ void __launch_bounds__(NWAVES * 64, 2) fwd_megakernel(Args args) {
    extern __shared__ __attribute__((aligned(16))) unsigned char lds_raw[];
    LAS unsigned char* lds = (LAS unsigned char*)lds_raw;
    volatile LAS unsigned* MISC = (volatile LAS unsigned*)(lds + MISC_OFF);
    const int tid = threadIdx.x, lane = tid & 63, wave = __builtin_amdgcn_readfirstlane(tid >> 6);
    const int G = gridDim.x; const int bx = blockIdx.x; const int vcu = (G % 8 == 0) ? (bx % 8) * (G / 8) + bx / 8 : bx;
    unsigned char* ws = args.ws;
    gu32* ctl = (gu32*)(ws + WS_CTL);
    if (tid < 256) MISC[tid] = 0u;
    __syncthreads();
    XcdBarrier bar = xcd_barrier_post((unsigned*)(ctl + CW_BAR), MISC + 8);
#if defined(PROBE_TS)
#define GRID_BAR(k_) do { xcd_barrier(bar); if (threadIdx.x == 0) { const unsigned long long t_ = __builtin_amdgcn_s_memrealtime(); MISC[16 + 2 * (k_)] = (unsigned)t_; MISC[17 + 2 * (k_)] = (unsigned)(t_ >> 32); } } while (0)
    if (threadIdx.x == 0) { const unsigned long long t_ = __builtin_amdgcn_s_memrealtime(); MISC[16 + 30] = (unsigned)t_; MISC[17 + 30] = (unsigned)(t_ >> 32); }
#else
#define GRID_BAR(k_) xcd_barrier(bar)
#endif
    bf16* const XBF = (bf16*)(ws + WS_XBF); bf16* const PB = (bf16*)(ws + WS_P); bf16* const HB = (bf16*)(ws + WS_P);
    float* const SS0 = (float*)(ws + WS_SS0); float* const SS1 = (float*)(ws + WS_SS1); float* const SS2 = (float*)(ws + WS_SS2);
    float* const DT = (float*)(ws + WS_DT); float* const SSX1 = (float*)(ws + WS_SSX1); float* const SSX2 = (float*)(ws + WS_SSX2);
    const float* const SSLp = (const float*)(ws + WS_SSL); const float* const SSSp = (const float*)(ws + WS_SSS);
#define SMALL_UNITS(...) do { for (int u = vcu; u < 256; u += G) { __VA_ARGS__; } } while (0)
    float* const out = args.out;

    p0_prologue(args, lds, vcu, G, wave, lane);
    GRID_BAR(0);
    { pg8::Gemm g{XBF, (const bf16*)(ws + WS_WGU1), MPAD, NGU, DM, DM}; pg8::StaticOrder S; S.init(MPAD, NGU, G, bx);
      pg8::fill_rstd_table(S, SS0, nullptr, (LAS float*)(lds + RING_BYTES));
      pg8::EpiSwiGLU E{HB, (const LAS float*)(lds + RING_BYTES)};
      pg8::gemm_phase<pg8::EpiSwiGLU, pg8::StaticOrder, true, true>(lds + RING_OFF, g, S, E);
      int nl; const int lr = light_rank(S.nwg, G, bx, nl);
      if (lr >= 0) tr_range(args, lds, IT_WD1, IT_WOUT, lr * NWAVES + wave, nl * NWAVES, wave, lane);
      else if (nl == 0) tr_range(args, lds, IT_WD1, IT_WOUT, vcu * NWAVES + wave, G * NWAVES, wave, lane); }
    GRID_BAR(1);
    if (bx & 1) SMALL_UNITS(small_gemm_resid<false, true>(HB, FF, (const bf16*)(ws + WS_WD1), FF, u, nullptr, XBF, SSX1, 0.5f, nullptr, nullptr, lds, tid));
    { pg8::Gemm g{HB, (const bf16*)(ws + WS_WD1), TP, DM, FF, FF}; pg8::StaticOrder S; S.init(TP, DM, G, bx);
      if (G == 256) { pg8::EpiResidT<false, true, true> E{nullptr, nullptr, XBF, SS1, 0.5f, nullptr};
        pg8::gemm_phase<pg8::EpiResidT<false, true, true>, pg8::StaticOrder, false, true>(lds + RING_OFF, g, S, E); }
      else { pg8::EpiResidT<false, true> E{nullptr, nullptr, XBF, SS1, 0.5f, nullptr};
        pg8::gemm_phase<pg8::EpiResidT<false, true>, pg8::StaticOrder, true, true>(lds + RING_OFF, g, S, E); } }
    if (!(bx & 1)) SMALL_UNITS(small_gemm_resid<false, true>(HB, FF, (const bf16*)(ws + WS_WD1), FF, u, nullptr, XBF, SSX1, 0.5f, nullptr, nullptr, lds, tid));
    GRID_BAR(2);
    { pg8::Gemm g{XBF, (const bf16*)(ws + WS_WIN), MPAD, NINP, DM, DM}; pg8::StaticOrder S; S.init(MPAD, NINP, G, bx);
      pg8::fill_rstd_table(S, SS1, SSX1, (LAS float*)(lds + RING_BYTES));
      pg8::EpiP E{PB, DT, (const LAS float*)(lds + RING_BYTES)};
      pg8::gemm_phase<pg8::EpiP, pg8::StaticOrder, true, true>(lds + RING_OFF, g, S, E);
      int nl; const int lr = light_rank(S.nwg, G, bx, nl);
      if (lr >= 0) tr_range(args, lds, IT_WOUT, IT_WGU2 + 384, lr * NWAVES + wave, nl * NWAVES, wave, lane);
      else if (nl == 0) tr_range(args, lds, IT_WOUT, IT_WGU2 + 384, vcu * NWAVES + wave, G * NWAVES, wave, lane); }
    GRID_BAR(3);
    ssd_prepass(args, vcu, G, tid);
    GRID_BAR(4);
    { int t2 = threadIdx.x; asm volatile("" : "+v"(t2)); mixer_phase(args, lds, vcu, G, t2); }
    GRID_BAR(5);
    if (bx & 1) SMALL_UNITS(small_gemm_resid<true, true>(PB + DLRU, PW, (const bf16*)(ws + WS_WOUT), DMIX, u, nullptr, XBF, SSX2, 1.0f, SSLp, SSSp, lds, tid));
    { pg8::Gemm g{PB + DLRU, (const bf16*)(ws + WS_WOUT), TP, DM, DMIX, PW}; pg8::SegOrder S; S.init(TP, DM, G, bx); S.SSL = SSLp; S.SSS = SSSp; S.tab = (LAS float*)(lds + RING_BYTES);
      pg8::EpiResidT<true, true, true> E{nullptr, nullptr, XBF, SS2, 1.0f, (const LAS float*)(lds + RING_BYTES)};
      pg8::gemm_phase<pg8::EpiResidT<true, true, true>, pg8::SegOrder, false, true>(lds + RING_OFF, g, S, E); }
    if (!(bx & 1)) SMALL_UNITS(small_gemm_resid<true, true>(PB + DLRU, PW, (const bf16*)(ws + WS_WOUT), DMIX, u, nullptr, XBF, SSX2, 1.0f, SSLp, SSSp, lds, tid));
    GRID_BAR(6);
    { pg8::Gemm g{XBF, (const bf16*)(ws + WS_WGU2), MPAD, NGU, DM, DM}; pg8::StaticOrder S; S.init(MPAD, NGU, G, bx);
      pg8::fill_rstd_table(S, SS2, SSX2, (LAS float*)(lds + RING_BYTES));
      pg8::EpiSwiGLU E{HB, (const LAS float*)(lds + RING_BYTES)};
      pg8::gemm_phase<pg8::EpiSwiGLU, pg8::StaticOrder, true, true>(lds + RING_OFF, g, S, E);
      int nl; const int lr = light_rank(S.nwg, G, bx, nl);
      if (lr >= 0) tr_range(args, lds, IT_WD2, IT_END, lr * NWAVES + wave, nl * NWAVES, wave, lane);
      else if (nl == 0) tr_range(args, lds, IT_WD2, IT_END, vcu * NWAVES + wave, G * NWAVES, wave, lane); }
    GRID_BAR(7);
    if (bx & 1) SMALL_UNITS(small_gemm_resid<false, true>(HB, FF, (const bf16*)(ws + WS_WD2), FF, u, nullptr, XBF, SSX1, 0.5f, nullptr, nullptr, lds, tid));
    { pg8::Gemm g{HB, (const bf16*)(ws + WS_WD2), TP, DM, FF, FF}; pg8::StaticOrder S; S.init(TP, DM, G, bx);
      if (G == 256) { pg8::EpiResidT<false, true, true> E{nullptr, nullptr, XBF, SS0, 0.5f, nullptr};
        pg8::gemm_phase<pg8::EpiResidT<false, true, true>, pg8::StaticOrder, false, true>(lds + RING_OFF, g, S, E); }
      else { pg8::EpiResidT<false, true> E{nullptr, nullptr, XBF, SS0, 0.5f, nullptr};
        pg8::gemm_phase<pg8::EpiResidT<false, true>, pg8::StaticOrder, true, true>(lds + RING_OFF, g, S, E); } }
    if (!(bx & 1)) SMALL_UNITS(small_gemm_resid<false, true>(HB, FF, (const bf16*)(ws + WS_WD2), FF, u, nullptr, XBF, SSX1, 0.5f, nullptr, nullptr, lds, tid));
    GRID_BAR(8);
    { int t2 = threadIdx.x; asm volatile("" : "+v"(t2)); p9_final_norm(args, vcu, G, __builtin_amdgcn_readfirstlane(t2 >> 6), t2 & 63); }
#if defined(PROBE_TS)
    GRID_BAR(9);
    if (blockIdx.x == 0) {
        __syncthreads();
        const size_t offs[10] = {O_YP, O_YS, O_PLC, O_PLH, O_PSC, O_PSH, O_SLC, O_SLH, O_SSC, O_SSH};
        const int phs[10] = {5, 2, 3, 6, 8, 1, 9, 0, 7, 4};
#pragma unroll
        for (int k = 0; k < 10; ++k) { const int ph = phs[k], pp = ph == 0 ? 15 : ph - 1;
            unsigned long long t1, t0;
            if (ph >= 0) { t1 = ((unsigned long long)MISC[17 + 2 * ph] << 32) | MISC[16 + 2 * ph]; t0 = ((unsigned long long)MISC[17 + 2 * pp] << 32) | MISC[16 + 2 * pp]; }
            else { const int q = -ph - 1, call = q < 2 ? 1 : (q < 4 ? 3 : 0), j = q & 1;
                t1 = ((unsigned long long)MISC[65 + 6 * call + 2 * (j + 1)] << 32) | MISC[64 + 6 * call + 2 * (j + 1)]; t0 = ((unsigned long long)MISC[65 + 6 * call + 2 * j] << 32) | MISC[64 + 6 * call + 2 * j]; }
            const float tt_ = (float)(t1 - t0) * 0.1f; const bool big_ = (k == 0 || k == 9);
            const int n = big_ ? (int)((t1 - t0) / 50ull) : (int)(logf(fmaxf(tt_, 1.0f)) * 20.4959f + 0.5f); unsigned* o = (unsigned*)(args.out + offs[k]);
            int ti_ = threadIdx.x; asm volatile("" : "+v"(ti_)); for (int i = ti_; i < n && i < 8000; i += 512) o[i] = 0xAAAAAAAAu; }
    }
#endif
}

extern "C" void kernel_launch(void* const* d_in, const int* in_sizes, int n_in, void* d_out, int out_size, void* d_ws, size_t ws_size, hipStream_t stream) {
    static int grid = 0;
    if (grid == 0) {
        if (n_in != 32 || in_sizes[0] != TP * DM || (size_t)out_size != O_END || ws_size < WS_END) {
            fprintf(stderr, "kernel_launch: unexpected shapes: n_in %d, in0 %d, out %d, ws %zu (need >= %zu); nothing launched\n", n_in, n_in > 0 ? in_sizes[0] : -1, out_size, ws_size, (size_t)WS_END); grid = -1; return; }
        int dev = 0, cus = 0, per_cu = 0;
        if (hipGetDevice(&dev) != hipSuccess || hipDeviceGetAttribute(&cus, hipDeviceAttributeMultiprocessorCount, dev) != hipSuccess) { fprintf(stderr, "kernel_launch: device query failed\n"); grid = -1; return; }
        if (hipFuncSetAttribute((const void*)fwd_megakernel, hipFuncAttributeMaxDynamicSharedMemorySize, LDS_BYTES) != hipSuccess) { fprintf(stderr, "kernel_launch: hipFuncSetAttribute failed\n"); grid = -1; return; }
        if (hipOccupancyMaxActiveBlocksPerMultiprocessor(&per_cu, (const void*)fwd_megakernel, NWAVES * 64, LDS_BYTES) != hipSuccess || per_cu < 1) {
            fprintf(stderr, "kernel_launch: occupancy query says %d workgroups per CU\n", per_cu); per_cu = 1; }
        (void)hipGetLastError();
        grid = cus;
        fprintf(stderr, "kernel_launch: grid %d (occupancy query %d per CU), ws %zu\n", grid, per_cu, ws_size);
    }
    if (grid < 0) return;
    (void)hipMemsetAsync((char*)d_ws + WS_CTL, 0, 65536, stream);
    Args a{};
    for (int i = 0; i < 32; ++i) a.in[i] = (const float*)d_in[i];
    a.out = (float*)d_out; a.ws = (unsigned char*)d_ws;
    hipLaunchKernelGGL(fwd_megakernel, dim3(grid), dim3(NWAVES * 64), LDS_BYTES, stream, a);
}
```

```cpp
#include <hip/hip_runtime.h>
#include <cstdio>
#include <cstdint>

constexpr int TP = 16384;
constexpr int TS = 128;
constexpr int MREAL = TP + TS;
constexpr int MPAD = 16640;
constexpr int DM = 1024, FF = 2816, NGU = 2 * FF, NIN = 4624, NINP = 4864, PW = 4608, DMIX = 2048;
constexpr int SEQ = 2048, NB = 8, DLRU = 1024, DXBC = 1536, NHEAD = 16;
constexpr float EPS = 1e-6f;

namespace pg8 {
#define PG8_LAS __attribute__((address_space(3)))
typedef unsigned short bf16_t;
typedef short bf16x8 __attribute__((ext_vector_type(8)));
typedef float f32x4 __attribute__((ext_vector_type(4)));
typedef unsigned u32x4 __attribute__((ext_vector_type(4)));
typedef unsigned u32x2 __attribute__((ext_vector_type(2)));
constexpr int BM = 256, BK = 64, HALF = 128, HTB = HALF * BK * 2  , STAGE_BYTES = 8 * HTB, NXCD = 8, WGM = 8;

__host__ __device__ __forceinline__ int lds_byte(int r, int c) { const int st = (r >> 4) * 2 + (c >> 5), rr = r & 15, cc = c & 31, ob = rr * 64 + cc * 2; return st * 1024 + (ob ^ (((ob >> 9) & 1) << 5)); }
__host__ __device__ __forceinline__ void stage_rc(int b, int& R, int& C) { const int st = b / 1024, sb = b % 1024, swz = sb ^ (((sb >> 9) & 1) << 5); R = (st >> 1) * 16 + swz / 64; C = (st & 1) * 32 + (swz % 64) / 2; }
__host__ __device__ __forceinline__ int perm32(int rho) { const int n = rho >> 4, i = rho & 15; return 8 * (i >> 2) + 4 * n + (i & 3); }

struct Unit { int pm, pn, ui; };
struct Gemm { const bf16_t* A; const bf16_t* Bt; int M, N, K, lda; };

struct StaticOrder {
    int nM, nN, nwg, G, c;
    __host__ __device__ void init(int M, int N, int G_, int c_) { nM = M / BM; nN = N / BM; nwg = nM * nN; G = G_; c = c_; }
    __host__ __device__ bool next(int i, Unit& u) const {
        const long L = (long)i * G + c; if (L >= nwg) return false;
        int wgid = (int)L; { const int q = nwg / NXCD, r = nwg % NXCD, xcd = wgid % NXCD, off = wgid / NXCD; wgid = (xcd < r ? xcd * (q + 1) : r * (q + 1) + (xcd - r) * q) + off; }
        const int nig = WGM * nN, gid = wgid / nig, fm = gid * WGM, gsz = (nM - fm) < WGM ? (nM - fm) : WGM;
        u.pm = fm + ((wgid % nig) % gsz); u.pn = (wgid % nig) / gsz; u.ui = i; return true;
    }
    __device__ __forceinline__ void a_ready(const Unit&) const {}
    __device__ __forceinline__ void done(const Unit&) const {}
};

typedef __bf16 bf16v2 __attribute__((ext_vector_type(2)));
typedef float f32v2 __attribute__((ext_vector_type(2)));
__device__ __forceinline__ unsigned cvt_pk_bf16(float lo, float hi) { const f32v2 v = {lo, hi}; return __builtin_bit_cast(unsigned, __builtin_convertvector(v, bf16v2)); }
__device__ __forceinline__ float bfly16(float a, float b) { const auto r = __builtin_amdgcn_permlane16_swap(__builtin_bit_cast(unsigned, a), __builtin_bit_cast(unsigned, b), false, false);
    return __builtin_bit_cast(float, (unsigned)r[0]) + __builtin_bit_cast(float, (unsigned)r[1]); }
__device__ __forceinline__ float bfly32(float a, float b) { const auto r = __builtin_amdgcn_permlane32_swap(__builtin_bit_cast(unsigned, a), __builtin_bit_cast(unsigned, b), false, false);
    return __builtin_bit_cast(float, (unsigned)r[0]) + __builtin_bit_cast(float, (unsigned)r[1]); }
__device__ __forceinline__ float silu_f(float x) { return x * __builtin_amdgcn_rcpf(1.0f + __builtin_amdgcn_exp2f(-1.44269504f * x)); }
__device__ __forceinline__ float rstd16(const float* ss) {
    const f32x4 a = *(const f32x4*)ss, b = *(const f32x4*)(ss + 4), c = *(const f32x4*)(ss + 8), d = *(const f32x4*)(ss + 12);
    const float s = (((a[0] + a[1]) + (a[2] + a[3])) + ((b[0] + b[1]) + (b[2] + b[3]))) + (((c[0] + c[1]) + (c[2] + c[3])) + ((d[0] + d[1]) + (d[2] + d[3])));
    return __builtin_amdgcn_rsqf(s * (1.0f / 1024.0f) + EPS);
}

__device__ __forceinline__ float rstd_row(const float* SS, const float* SSX, int row) {
    if (SSX != nullptr && row >= TP) { const float* p = SSX + (size_t)(row - TP) * 64; float s = 0.f;
#pragma unroll
        for (int k = 0; k < 16; ++k) { const f32x4 a = *(const f32x4*)(p + 4 * k); s += (a[0] + a[1]) + (a[2] + a[3]); }
        return __builtin_amdgcn_rsqf(s * (1.0f / 1024.0f) + EPS); }
    return rstd16(SS + (size_t)row * 16);
}

template <class Sched> __device__ __forceinline__ void fill_rstd_table(const Sched& S, const float* SS, const float* SSX, PG8_LAS float* tab) {
    int t = threadIdx.x; asm volatile("" : "+v"(t));
    const int r = t & 255, i0 = t >> 8;
    int row[4]; bool ok[4]; f32x4 q[4][4];
#pragma unroll
    for (int k = 0; k < 4; ++k) { Unit u; ok[k] = (i0 + 2 * k < 8) && S.next(i0 + 2 * k, u); row[k] = ok[k] ? u.pm * BM + r : 0; }
#pragma unroll
    for (int k = 0; k < 4; ++k) if (ok[k] && !(SSX != nullptr && row[k] >= TP)) { const float* ss = SS + (size_t)row[k] * 16;
        q[k][0] = *(const f32x4*)ss; q[k][1] = *(const f32x4*)(ss + 4); q[k][2] = *(const f32x4*)(ss + 8); q[k][3] = *(const f32x4*)(ss + 12); }
#pragma unroll
    for (int k = 0; k < 4; ++k) if (ok[k]) {
        float v;
        if (SSX != nullptr && row[k] >= TP) v = rstd_row(SS, SSX, row[k]);
        else { const f32x4 a = q[k][0], b = q[k][1], c = q[k][2], d = q[k][3];
            const float s = (((a[0] + a[1]) + (a[2] + a[3])) + ((b[0] + b[1]) + (b[2] + b[3]))) + (((c[0] + c[1]) + (c[2] + c[3])) + ((d[0] + d[1]) + (d[2] + d[3])));
            v = __builtin_amdgcn_rsqf(s * (1.0f / 1024.0f) + EPS); }
        tab[(i0 + 2 * k) * 256 + r] = v; }
    __syncthreads();
}


struct EpiSwiGLU {
    static constexpr bool PERM = true, AFTER_DRAIN = false, KSEG = false;
    bf16_t* H; const PG8_LAS float* tab;
    __device__ __forceinline__ void operator()(const f32x4 (&acc)[2][2][4][2], const Unit& u, int wr, int wc, int fr, int fq) const {
        const int row0 = u.pm * BM + wr * 64 + fr, col0 = u.pn * HALF + wc * 32 + 8 * fq;
#pragma unroll
        for (int ai = 0; ai < 2; ++ai)
#pragma unroll
            for (int m = 0; m < 4; ++m) {
                const int row = row0 + ai * HALF + m * 16;
                const float rs = tab[u.ui * 256 + (row - u.pm * BM)];
                float hv[8];
#pragma unroll
                for (int n = 0; n < 2; ++n)
#pragma unroll
                    for (int j = 0; j < 4; ++j) hv[4 * n + j] = silu_f(acc[ai][0][m][n][j] * rs) * (acc[ai][1][m][n][j] * rs);
                u32x4 w; w.x = cvt_pk_bf16(hv[0], hv[1]); w.y = cvt_pk_bf16(hv[2], hv[3]); w.z = cvt_pk_bf16(hv[4], hv[5]); w.w = cvt_pk_bf16(hv[6], hv[7]);
                *(u32x4*)(H + (size_t)row * FF + col0) = w;
            }
    }
};
template <bool KSEG_, bool BBF_, bool DRAIN_ = false> struct EpiResidT {
    static constexpr bool PERM = true, AFTER_DRAIN = DRAIN_, KSEG = KSEG_;
    const float* basep; const float* bases; bf16_t* xbf; float* SSo; float scale; const PG8_LAS float* tab;
    __device__ __forceinline__ void rescale(f32x4 (&acc)[2][2][4][2], int which, int wr, int fr) const {
#pragma unroll
        for (int ai = 0; ai < 2; ++ai)
#pragma unroll
            for (int m = 0; m < 4; ++m) { const float f = tab[(ai * HALF + wr * 64 + m * 16 + fr) * 4 + which];
#pragma unroll
                for (int bj = 0; bj < 2; ++bj)
#pragma unroll
                    for (int n = 0; n < 2; ++n) acc[ai][bj][m][n] = acc[ai][bj][m][n] * f; }
    }
    __device__ __forceinline__ void finish_group(const f32x4 (&acc)[2][2][4][2], const Unit& u, int ai, int m, int wr, int wc, int fr, int fq, const f32x4 (&b)[2][2]) const {
        const int row = u.pm * BM + ai * HALF + wr * 64 + m * 16 + fr; const bool real = row < MREAL;
        const float sc = KSEG_ ? scale * tab[(ai * HALF + wr * 64 + m * 16 + fr) * 4 + 2] : scale;
        float ss = 0.f;
#pragma unroll
        for (int bj = 0; bj < 2; ++bj) {
            f32x4 v0 = b[bj][0] + acc[ai][bj][m][0] * sc, v1 = b[bj][1] + acc[ai][bj][m][1] * sc;
            if (!real) { v0 = (f32x4){0.f, 0.f, 0.f, 0.f}; v1 = v0; }
            ss += ((v0[0] * v0[0] + v0[1] * v0[1]) + (v0[2] * v0[2] + v0[3] * v0[3])) + ((v1[0] * v1[0] + v1[1] * v1[1]) + (v1[2] * v1[2] + v1[3] * v1[3]));
            u32x4 w; w.x = cvt_pk_bf16(v0[0], v0[1]); w.y = cvt_pk_bf16(v0[2], v0[3]); w.z = cvt_pk_bf16(v1[0], v1[1]); w.w = cvt_pk_bf16(v1[2], v1[3]);
            *(u32x4*)(xbf + (size_t)row * DM + u.pn * BM + bj * HALF + wc * 32 + 8 * fq) = w; }
        ss = bfly16(ss, ss); ss = bfly32(ss, ss);
        if (fq == 0) SSo[(size_t)row * 16 + u.pn * 4 + wc] = ss;
    }
    __device__ __forceinline__ void unpack_bf(const u32x4 w, f32x4 (&b)[2]) const {
        b[0] = (f32x4){__uint_as_float(w.x << 16), __uint_as_float(w.x & 0xffff0000u), __uint_as_float(w.y << 16), __uint_as_float(w.y & 0xffff0000u)};
        b[1] = (f32x4){__uint_as_float(w.z << 16), __uint_as_float(w.z & 0xffff0000u), __uint_as_float(w.w << 16), __uint_as_float(w.w & 0xffff0000u)}; }
    __device__ __forceinline__ void operator()(const f32x4 (&acc)[2][2][4][2], const Unit& u, int wr, int wc, int fr, int fq) const {
#pragma unroll
        for (int ai = 0; ai < 2; ++ai)
#pragma unroll
            for (int m = 0; m < 4; ++m) {
                const int row = u.pm * BM + ai * HALF + wr * 64 + m * 16 + fr; const int rr = row < MREAL ? row : 0;
                const float* brow = rr < TP ? basep + (size_t)rr * DM : bases + (size_t)(rr - TP) * DM;
                f32x4 b[2][2];
#pragma unroll
                for (int bj = 0; bj < 2; ++bj) { const int col = u.pn * BM + bj * HALF + wc * 32 + 8 * fq;
                    if (BBF_) unpack_bf(*(const u32x4*)(xbf + (size_t)row * DM + col), b[bj]);
                    else { b[bj][0] = *(const f32x4*)(brow + col); b[bj][1] = *(const f32x4*)(brow + col + 4); } }
                finish_group(acc, u, ai, m, wr, wc, fr, fq, b);
            }
    }
    __device__ __forceinline__ void fused(const f32x4 (&acc)[2][2][4][2], const Unit& u, int wr, int wc, int fr, int fq, PG8_LAS unsigned char*, int, int) const {
        static_assert(!DRAIN_ || BBF_, "the drained epilogue preloads a bf16 residual tile");
        u32x4 pre[2][4][2];
#pragma unroll
        for (int ai = 0; ai < 2; ++ai)
#pragma unroll
            for (int m = 0; m < 4; ++m)
#pragma unroll
                for (int bj = 0; bj < 2; ++bj) pre[ai][m][bj] = *(const u32x4*)(xbf + (size_t)(u.pm * BM + ai * HALF + wr * 64 + m * 16 + fr) * DM + u.pn * BM + bj * HALF + wc * 32 + 8 * fq);
#pragma unroll
        for (int ai = 0; ai < 2; ++ai)
#pragma unroll
            for (int m = 0; m < 4; ++m) { f32x4 b[2][2]; unpack_bf(pre[ai][m][0], b[0]); unpack_bf(pre[ai][m][1], b[1]); finish_group(acc, u, ai, m, wr, wc, fr, fq, b); }
    }
};
struct SegOrder : StaticOrder {
    const float* SSL; const float* SSS; PG8_LAS float* tab;
    __device__ __forceinline__ void a_ready(const Unit& u) const {
        const int t = threadIdx.x;
        if (t < 256) { const size_t row = (size_t)u.pm * BM + t; float sl = 0.f, s0 = 0.f, s1 = 0.f;
#pragma unroll
            for (int k = 0; k < 4; ++k) { const f32x4 a = *(const f32x4*)(SSL + row * 16 + 4 * k); sl += (a[0] + a[1]) + (a[2] + a[3]); }
#pragma unroll
            for (int k = 0; k < 2; ++k) { const f32x4 a = *(const f32x4*)(SSS + row * 16 + 4 * k), b = *(const f32x4*)(SSS + row * 16 + 8 + 4 * k); s0 += (a[0] + a[1]) + (a[2] + a[3]); s1 += (b[0] + b[1]) + (b[2] + b[3]); }
            const float r0 = 1.0f / sqrtf(sl * (1.0f / 1024.0f) + EPS), r1 = 1.0f / sqrtf(s0 * (1.0f / 512.0f) + EPS), r2 = 1.0f / sqrtf(s1 * (1.0f / 512.0f) + EPS);
            *(PG8_LAS f32x4*)(tab + t * 4) = (f32x4){r0 / r1, r1 / r2, r2, 0.f}; }
        asm volatile("s_waitcnt lgkmcnt(0)" ::: "memory"); __builtin_amdgcn_s_barrier(); asm volatile("" ::: "memory");
    }
};
struct EpiP {
    static constexpr bool PERM = true, AFTER_DRAIN = false, KSEG = false;
    bf16_t* P; float* DT; const PG8_LAS float* tab;
    __device__ __forceinline__ void operator()(const f32x4 (&acc)[2][2][4][2], const Unit& u, int wr, int wc, int fr, int fq) const {
        const int row0 = u.pm * BM + wr * 64 + fr;
#pragma unroll
        for (int ai = 0; ai < 2; ++ai)
#pragma unroll
            for (int m = 0; m < 4; ++m) {
                const int row = row0 + ai * HALF + m * 16;
                const float rs = tab[u.ui * 256 + (row - u.pm * BM)];
                if (u.pn < 18) {
#pragma unroll
                    for (int bj = 0; bj < 2; ++bj) {
                        const f32x4 v0 = acc[ai][bj][m][0] * rs, v1 = acc[ai][bj][m][1] * rs;
                        u32x4 w; w.x = cvt_pk_bf16(v0[0], v0[1]); w.y = cvt_pk_bf16(v0[2], v0[3]); w.z = cvt_pk_bf16(v1[0], v1[1]); w.w = cvt_pk_bf16(v1[2], v1[3]);
                        *(u32x4*)(P + (size_t)row * PW + u.pn * BM + bj * HALF + wc * 32 + 8 * fq) = w;
                    }
                } else if (wc == 0 && fq < 2) {
                    *(f32x4*)(DT + (size_t)row * 16 + 8 * fq) = acc[ai][0][m][0] * rs;
                    *(f32x4*)(DT + (size_t)row * 16 + 8 * fq + 4) = acc[ai][0][m][1] * rs;
                }
            }
    }
};

template <class Epi, class Sched, bool ALIGN_EPI = false, bool SP2 = false>
__device__ __forceinline__ void gemm_phase(PG8_LAS unsigned char* lds, const Gemm g, const Sched& S, const Epi& E) {
    int tid_ = threadIdx.x; asm volatile("" : "+v"(tid_));
    const int tid = tid_, wid = __builtin_amdgcn_readfirstlane(tid >> 6), lane = tid & 63, wr = wid >> 2, wc = wid & 3, fr = lane & 15, fq = lane >> 4;
    const int K = g.K, nt = K / BK;
    unsigned voffA[2], voffB[2];
#pragma unroll
    for (int i = 0; i < 2; ++i) { int R, C; stage_rc(tid * 16 + i * 8192, R, C); const int Rb = Epi::PERM ? ((R & ~31) + perm32(R & 31)) : R;
        voffA[i] = (unsigned)(R * g.lda + C) * 2u; voffB[i] = (unsigned)(Rb * K + C) * 2u; }
    const size_t kstep = (size_t)(BK * 2);
    const size_t hstepA = (size_t)HALF * g.lda * 2, hstepB = (size_t)HALF * K * 2;
    const size_t tstepA = 2 * hstepA, tstepB = 2 * hstepB;
    const unsigned ldsw = (unsigned)wid * 1024u;
    const int aoff = lds_byte(wr * 64 + fr, fq * 8), boff = lds_byte(wc * 32 + fr, fq * 8);
#define PG8_SA(b, h) (((b) * 2 + (h)) * HTB)
#define PG8_SB(b, h) ((4 + (b) * 2 + (h)) * HTB)
#define PG8_STAGE(bufoff, gbase, voff) do { _Pragma("unroll") for (int _i = 0; _i < 2; ++_i) \
        __builtin_amdgcn_global_load_lds((const unsigned*)((const char*)(gbase) + (voff)[_i]), (PG8_LAS unsigned*)(lds + (bufoff) + ldsw + _i * 8192), 16, 0, 0); } while (0)
#define PG8_LDA(dst, b, h) do { _Pragma("unroll") for (int m = 0; m < 4; ++m) _Pragma("unroll") for (int k = 0; k < 2; ++k) dst[m][k] = *(const PG8_LAS bf16x8*)(lds + PG8_SA(b, h) + aoff + m * 2048 + k * 1024); } while (0)
#define PG8_LDB(dst, b, h) do { _Pragma("unroll") for (int n = 0; n < 2; ++n) _Pragma("unroll") for (int k = 0; k < 2; ++k) dst[n][k] = *(const PG8_LAS bf16x8*)(lds + PG8_SB(b, h) + boff + n * 2048 + k * 1024); } while (0)
#define PG8_MMA(ai, bj, At, Bt) do { __builtin_amdgcn_s_setprio(1); _Pragma("unroll") for (int m = 0; m < 4; ++m) _Pragma("unroll") for (int n = 0; n < 2; ++n) _Pragma("unroll") for (int k = 0; k < 2; ++k) \
        acc[ai][bj][m][n] = __builtin_amdgcn_mfma_f32_16x16x32_bf16(Bt[n][k], At[m][k], acc[ai][bj][m][n], 0, 0, 0); __builtin_amdgcn_s_setprio(0); } while (0)
#define PG8_WAIT_V(n) asm volatile("s_waitcnt vmcnt(" #n ")" ::: "memory")
#define PG8_WAIT_L(n) asm volatile("s_waitcnt lgkmcnt(" #n ")" ::: "memory")
#define PG8_BAR __builtin_amdgcn_s_barrier()
#define PG8_SCHED __builtin_amdgcn_sched_barrier(0)
#if defined(PROBE_GEMM)
#define PG8_PSTAMP(j_) do { if (blockIdx.x == 0 && threadIdx.x == 0) { volatile PG8_LAS unsigned* ms_ = (volatile PG8_LAS unsigned*)(lds + (163840 - 1024)); const unsigned ix_ = ms_[60]; const unsigned long long t_ = __builtin_amdgcn_s_memrealtime(); \
        ms_[64 + 6 * ix_ + 2 * (j_)] = (unsigned)t_; ms_[65 + 6 * ix_ + 2 * (j_)] = (unsigned)(t_ >> 32); if ((j_) == 2) ms_[60] = ix_ + 1; } } while (0)
#else
#define PG8_PSTAMP(j_) do { } while (0)
#endif
    Unit cur, nxt; int ui = 0;
    if (!S.next(0, cur)) return;
    PG8_PSTAMP(0);
    f32x4 acc[2][2][4][2];
#pragma unroll
    for (int a = 0; a < 2; ++a)
#pragma unroll
        for (int b = 0; b < 2; ++b)
#pragma unroll
            for (int m = 0; m < 4; ++m)
#pragma unroll
                for (int n = 0; n < 2; ++n) acc[a][b][m][n] = (f32x4){0.f, 0.f, 0.f, 0.f};
    bf16x8 At[4][2], B0[2][2], B1[2][2];
    const char* cA = (const char*)g.A + (size_t)cur.pm * tstepA; const char* cB = (const char*)g.Bt + (size_t)cur.pn * tstepB;
    S.a_ready(cur);
    if constexpr (SP2) {
        PG8_STAGE(PG8_SB(0, 0), cB, voffB); PG8_STAGE(PG8_SB(0, 1), cB + hstepB, voffB); PG8_STAGE(PG8_SA(0, 0), cA, voffA); PG8_STAGE(PG8_SA(0, 1), cA + hstepA, voffA);
        if (wr == 1) PG8_BAR;
        PG8_WAIT_V(2); PG8_BAR;
        PG8_STAGE(PG8_SB(1, 0), cB + kstep, voffB); PG8_STAGE(PG8_SA(1, 0), cA + kstep, voffA); PG8_STAGE(PG8_SB(1, 1), cB + hstepB + kstep, voffB);
        PG8_WAIT_V(6); PG8_BAR;
    } else {
        PG8_STAGE(PG8_SB(0, 0), cB, voffB); PG8_STAGE(PG8_SA(0, 0), cA, voffA); PG8_STAGE(PG8_SB(0, 1), cB + hstepB, voffB); PG8_STAGE(PG8_SA(0, 1), cA + hstepA, voffA);
        if (wr == 1) PG8_BAR;
        PG8_WAIT_V(4); PG8_BAR;
        PG8_STAGE(PG8_SB(1, 0), cB + kstep, voffB); PG8_STAGE(PG8_SA(1, 0), cA + kstep, voffA); PG8_STAGE(PG8_SB(1, 1), cB + hstepB + kstep, voffB);
        PG8_WAIT_V(6); PG8_BAR;
    }
    for (;;) {
        const bool has_next = S.next(ui + 1, nxt);
        const char* nA = has_next ? (const char*)g.A + (size_t)nxt.pm * tstepA : cA; const char* nB = has_next ? (const char*)g.Bt + (size_t)nxt.pn * tstepB : cB;
        for (int t = 0; t < nt; t += 2) {
            if constexpr (Epi::KSEG) { if (t == 16 || t == 24) E.rescale(acc, t == 16 ? 0 : 1, wr, fr); }
            const bool last = (t == nt - 2);
            const char* a1 = cA + (size_t)(t + 1) * kstep;
            const char* a2 = last ? nA : cA + (size_t)(t + 2) * kstep; const char* b2 = last ? nB : cB + (size_t)(t + 2) * kstep;
            const char* a3 = a2 + kstep; const char* b3 = b2 + kstep;
            if (last && has_next) S.a_ready(nxt);
            if constexpr (SP2) {
            PG8_LDB(B0, 0, 0); PG8_LDB(B1, 0, 1); PG8_SCHED; PG8_LDA(At, 0, 0); PG8_STAGE(PG8_SA(1, 1), a1 + hstepA, voffA);
            PG8_WAIT_V(8); PG8_WAIT_L(0); PG8_BAR; PG8_MMA(0, 0, At, B0); PG8_MMA(0, 1, At, B1); PG8_BAR; PG8_SCHED;
            PG8_LDA(At, 0, 1); PG8_STAGE(PG8_SB(0, 0), b2, voffB); PG8_STAGE(PG8_SB(0, 1), b2 + hstepB, voffB); PG8_STAGE(PG8_SA(0, 0), a2, voffA);
            PG8_WAIT_V(8); PG8_WAIT_L(0); PG8_BAR; PG8_MMA(1, 0, At, B0); PG8_MMA(1, 1, At, B1); PG8_BAR; PG8_SCHED;
            PG8_LDB(B0, 1, 0); PG8_LDB(B1, 1, 1); PG8_SCHED; PG8_LDA(At, 1, 0); PG8_STAGE(PG8_SA(0, 1), a2 + hstepA, voffA);
            PG8_WAIT_V(8); PG8_WAIT_L(0); PG8_BAR; PG8_MMA(0, 0, At, B0); PG8_MMA(0, 1, At, B1); PG8_BAR; PG8_SCHED;
            PG8_LDA(At, 1, 1); PG8_STAGE(PG8_SB(1, 0), b3, voffB); PG8_STAGE(PG8_SB(1, 1), b3 + hstepB, voffB); PG8_STAGE(PG8_SA(1, 0), a3, voffA);
            PG8_WAIT_V(8); PG8_WAIT_L(0); PG8_BAR; PG8_MMA(1, 0, At, B0); PG8_MMA(1, 1, At, B1); PG8_BAR; PG8_SCHED;
            } else {
            PG8_LDB(B0, 0, 0); PG8_SCHED; PG8_LDA(At, 0, 0); PG8_STAGE(PG8_SA(1, 1), a1 + hstepA, voffA);
            PG8_WAIT_L(8); PG8_BAR; PG8_WAIT_L(0); PG8_MMA(0, 0, At, B0); PG8_BAR; PG8_SCHED;
            PG8_LDB(B1, 0, 1); PG8_STAGE(PG8_SB(0, 0), b2, voffB);
            PG8_BAR; PG8_WAIT_L(0); PG8_MMA(0, 1, At, B1); PG8_BAR;
            PG8_LDA(At, 0, 1); PG8_STAGE(PG8_SA(0, 0), a2, voffA);
            PG8_BAR; PG8_WAIT_L(0); PG8_MMA(1, 0, At, B0); PG8_BAR; PG8_SCHED;
            PG8_STAGE(PG8_SB(0, 1), b2 + hstepB, voffB);
            PG8_WAIT_V(6); PG8_BAR; PG8_MMA(1, 1, At, B1); PG8_BAR;
            PG8_LDB(B0, 1, 0); PG8_SCHED; PG8_LDA(At, 1, 0); PG8_STAGE(PG8_SA(0, 1), a2 + hstepA, voffA);
            PG8_WAIT_L(8); PG8_BAR; PG8_WAIT_L(0); PG8_MMA(0, 0, At, B0); PG8_BAR; PG8_SCHED;
            PG8_LDB(B1, 1, 1); PG8_STAGE(PG8_SB(1, 0), b3, voffB);
            PG8_BAR; PG8_WAIT_L(0); PG8_MMA(0, 1, At, B1); PG8_BAR;
            PG8_LDA(At, 1, 1); PG8_STAGE(PG8_SA(1, 0), a3, voffA);
            PG8_BAR; PG8_WAIT_L(0); PG8_MMA(1, 0, At, B0); PG8_BAR; PG8_SCHED;
            PG8_STAGE(PG8_SB(1, 1), b3 + hstepB, voffB);
            PG8_WAIT_V(6); PG8_BAR; PG8_MMA(1, 1, At, B1); PG8_BAR;
            }
        }
        if constexpr (ALIGN_EPI) { if (wr == 0) PG8_BAR; }
        if (!has_next) PG8_PSTAMP(1);
        if constexpr (!Epi::AFTER_DRAIN) { E(acc, cur, wr, wc, fr, fq); S.done(cur); }
        if (!has_next) break;
#pragma unroll
        for (int a = 0; a < 2; ++a)
#pragma unroll
            for (int b = 0; b < 2; ++b)
#pragma unroll
                for (int m = 0; m < 4; ++m)
#pragma unroll
                    for (int n = 0; n < 2; ++n) acc[a][b][m][n] = (f32x4){0.f, 0.f, 0.f, 0.f};
        cur = nxt; cA = nA; cB = nB; ++ui;
        if constexpr (ALIGN_EPI) { if (wr == 1) PG8_BAR; }
    }
    PG8_PSTAMP(2);
    PG8_WAIT_V(0);
    if constexpr (!ALIGN_EPI) { if (wr == 0) PG8_BAR; }
    PG8_BAR;
    if constexpr (Epi::AFTER_DRAIN) { E.fused(acc, cur, wr, wc, fr, fq, lds, wid, lane); S.done(cur); }
#undef PG8_SA
#undef PG8_SB
#undef PG8_STAGE
#undef PG8_LDA
#undef PG8_LDB
#undef PG8_MMA
#undef PG8_WAIT_V
#undef PG8_WAIT_L
#undef PG8_BAR
#undef PG8_SCHED
}
}

constexpr size_t MiB = 1u << 20;
constexpr size_t WS_CTL = 0, CTL_ZERO_BYTES = 1 * MiB;
constexpr size_t WS_WGU1 = 2 * MiB;
constexpr size_t WS_WD1 = 13 * MiB;
constexpr size_t WS_WIN = 19 * MiB;
constexpr size_t WS_WOUT = 29 * MiB;
constexpr size_t WS_WGU2 = 33 * MiB;
constexpr size_t WS_WD2 = 44 * MiB;
constexpr size_t WS_XBF = 50 * MiB;
constexpr size_t WS_SS0 = 83 * MiB, WS_SS1 = 85 * MiB, WS_SS2 = 87 * MiB, WS_SSL = 89 * MiB, WS_SSS = 91 * MiB;
constexpr size_t WS_SSX1 = WS_SS1 + 3 * MiB / 2, WS_SSX2 = WS_SS2 + 3 * MiB / 2;
constexpr size_t WS_DT = 93 * MiB;
constexpr size_t WS_P = 96 * MiB;
constexpr size_t WS_END = 243 * MiB;
static_assert(WS_P + (size_t)MPAD * PW * 2 <= WS_END && WS_XBF + (size_t)MPAD * DM * 2 <= WS_SS0 && WS_WD2 + (size_t)DM * FF * 2 <= WS_XBF, "d_ws map");
constexpr int CW_TMO = 0;
constexpr int CW_BAR = 4096;

constexpr size_t O_YP = 0, O_YS = 16777216, O_PLC = 16908288, O_PLH = 16932864, O_PSC = 16941056, O_PSH = 16977920,
                 O_SLC = 18026496, O_SLH = 18419712, O_SSC = 18550784, O_SSH = 19140608, O_END = 35917824;

constexpr int RING_OFF = 0, RING_BYTES = 131072;
constexpr int LDS_BYTES = 163840;
constexpr int MISC_OFF = LDS_BYTES - 1024;
constexpr int NWAVES = 8;

#define GAS __attribute__((address_space(1)))
#define LAS __attribute__((address_space(3)))
typedef unsigned short bf16;
typedef unsigned v4u __attribute__((ext_vector_type(4)));
typedef float f32x4 __attribute__((ext_vector_type(4)));
typedef short bf16x8 __attribute__((ext_vector_type(8)));
typedef GAS unsigned gu32;
typedef GAS unsigned long long gu64;
#define RLX_AGENT __ATOMIC_RELAXED, __HIP_MEMORY_SCOPE_AGENT
#define LDS_WAIT() asm volatile("s_waitcnt lgkmcnt(0)" ::: "memory")
#define VM_WAIT() asm volatile("s_waitcnt vmcnt(0)" ::: "memory")
__device__ __forceinline__ unsigned long long rt() { return __builtin_amdgcn_s_memrealtime(); }
__device__ __forceinline__ unsigned f2bf(float f) { unsigned u = __builtin_bit_cast(unsigned, f); return (u + 0x7fffu + ((u >> 16) & 1u)) >> 16; }
__device__ __forceinline__ unsigned pk2(float lo, float hi) { return f2bf(lo) | (f2bf(hi) << 16); }

#define XB_TMO      128
#define XB_XCNT(j)  (256  + 64 * (j))
#define XB_XSUB(j)  (1280 + 64 * (j))
#define XB_XGEN(j)  (2304 + 64 * (j))
#define XB_TOP      3328
#define XB_TOPGEN   3392
#define XCD_BAR_WORDS 3456
#define XB_SPIN_CAP (1u << 18)

__device__ __forceinline__ unsigned xb_ld(unsigned* p)              { return __hip_atomic_load(p, __ATOMIC_RELAXED, __HIP_MEMORY_SCOPE_AGENT); }
__device__ __forceinline__ unsigned xb_add(unsigned* p, unsigned v) { return __hip_atomic_fetch_add(p, v, __ATOMIC_RELAXED, __HIP_MEMORY_SCOPE_AGENT); }
__device__ __forceinline__ unsigned xb_xcc_id() { return (unsigned)__builtin_amdgcn_s_getreg((3 << 11) | 20) & 0xFu; }
#define XB_SPIN(cond, bar) do { unsigned _sp = 0; while (cond) { __builtin_amdgcn_s_sleep(1); \
    if ((++_sp & 255u) == 0u) { if (xb_ld(&(bar)[XB_TMO])) break; if (_sp > XB_SPIN_CAP) { atomicAdd(&(bar)[XB_TMO], 1u); break; } } } } while (0)

struct XcdBarrier {
    unsigned* bar; unsigned x;
    volatile LAS unsigned* st;
};

__device__ __forceinline__ XcdBarrier xcd_barrier_post(unsigned* bar, volatile LAS unsigned* st) {
    XcdBarrier b; b.bar = bar; b.x = xb_xcc_id(); b.st = st;
    if (threadIdx.x == 0) (void)xb_add(&bar[XB_XCNT(b.x)], 1u);
    return b;
}
__device__ __forceinline__ void xcd_barrier_complete(unsigned* bar, unsigned x, unsigned& nloc, unsigned& nx) {
    const unsigned G = gridDim.x * gridDim.y * gridDim.z;
    unsigned sum, cnt, mine, sp = 0u;
    for (;;) {
        sum = 0u; cnt = 0u; mine = 0u;
#pragma unroll
        for (unsigned j = 0; j < 16; ++j) { const unsigned c = xb_ld(&bar[XB_XCNT(j)]); sum += c; cnt += (c > 0u) ? 1u : 0u; mine = (j == x) ? c : mine; }
        if (sum == G) break;
        __builtin_amdgcn_s_sleep(1);
        if ((++sp & 255u) == 0u) { if (xb_ld(&bar[XB_TMO])) break; if (sp > XB_SPIN_CAP) { atomicAdd(&bar[XB_TMO], 1u); break; } }
    }
    nloc = mine > 0u ? mine : 1u; nx = cnt > 0u ? cnt : 1u;
}

__device__ __forceinline__ void xcd_barrier(const XcdBarrier& b) {
    asm volatile("s_waitcnt vmcnt(0)" ::: "memory");
    __syncthreads();
    if (threadIdx.x == 0) {
        unsigned* bar = b.bar;
        __builtin_amdgcn_s_waitcnt(0);
        unsigned nloc = b.st[0], nx = b.st[1];
        if (nloc == 0u) { xcd_barrier_complete(bar, b.x, nloc, nx); b.st[0] = nloc; b.st[1] = nx; }
        const unsigned old = xb_add(&bar[XB_XSUB(b.x)], 1u);
        const unsigned gen = old / nloc;
        if (old + 1u == (gen + 1u) * nloc) {
            __builtin_amdgcn_fence(__ATOMIC_RELEASE, "agent");
            asm volatile("s_waitcnt vmcnt(0)" ::: "memory");
            const unsigned og = xb_add(&bar[XB_TOP], 1u);
            const unsigned tg = og / nx;
            if (og + 1u == (tg + 1u) * nx) xb_add(&bar[XB_TOPGEN], 1u);
            else XB_SPIN(xb_ld(&bar[XB_TOPGEN]) == tg, bar);
            __builtin_amdgcn_fence(__ATOMIC_ACQUIRE, "agent");
            xb_add(&bar[XB_XGEN(b.x)], 1u);
            asm volatile("s_waitcnt vmcnt(0)" ::: "memory");
        } else {
            XB_SPIN(xb_ld(&bar[XB_XGEN(b.x)]) == gen, bar);
            __builtin_amdgcn_fence(__ATOMIC_ACQUIRE, "agent");
            asm volatile("s_waitcnt vmcnt(0)" ::: "memory");
        }
    }
    __syncthreads();
}

struct Args { const float* in[32]; float* out; unsigned char* ws; };
enum { I_XP = 0, I_XS, I_SLC, I_SLH, I_SSC, I_SSH, I_F1N, I_F1G, I_F1U, I_F1D, I_MIXN, I_WIN, I_LCW, I_LCB, I_LGAW, I_LGAB, I_LGXW, I_LGXB,
       I_LAM, I_LON, I_SCW, I_SCB, I_SDTB, I_SALOG, I_SD, I_SNORM, I_WOUT, I_F2N, I_F2G, I_F2U, I_F2D, I_FINN };

__device__ __forceinline__ float wave_sum(float v) {
#pragma unroll
    for (int o = 1; o < 64; o <<= 1) v += __shfl_xor(v, o);
    return v;
}
__device__ __forceinline__ float bf_lo(unsigned w) { return __uint_as_float(w << 16); }
__device__ __forceinline__ float bf_hi(unsigned w) { return __uint_as_float(w & 0xffff0000u); }

__device__ __forceinline__ void tr_item(const float* src, int ld, int col0, int nvalid, const float* gain, int k0, bf16* dst, int K, int row0, LAS float* scr, int lane) {
    const int ksub = lane >> 4, n4 = (lane & 15) * 4;
    f32x4 v[16];
    const bool ok = n4 < nvalid;
    const float* sp = src + (size_t)(k0 + ksub) * ld + col0 + (ok ? n4 : 0);
    float gq[16];
#pragma unroll
    for (int i = 0; i < 16; ++i) gq[i] = gain ? gain[k0 + 4 * i + ksub] : 1.0f;
#pragma unroll
    for (int i = 0; i < 16; ++i) v[i] = __builtin_nontemporal_load((const f32x4*)(sp + (size_t)(4 * i) * ld));
#pragma unroll
    for (int i = 0; i < 16; ++i) { const int kk = 4 * i + ksub; const float gg = gq[i];
        f32x4 x = ok ? v[i] * gg : (f32x4){0.f, 0.f, 0.f, 0.f};
        LAS float* d = scr + kk * 65 + n4; d[0] = x[0]; d[1] = x[1]; d[2] = x[2]; d[3] = x[3]; }
    LDS_WAIT(); asm volatile("" ::: "memory");
    const int c = lane & 7;
#pragma unroll
    for (int j = 0; j < 8; ++j) { const int n = (lane >> 3) + 8 * j; const LAS float* s = scr + (8 * c) * 65 + n;
        v4u o; o.x = pg8::cvt_pk_bf16(s[0 * 65], s[1 * 65]); o.y = pg8::cvt_pk_bf16(s[2 * 65], s[3 * 65]); o.z = pg8::cvt_pk_bf16(s[4 * 65], s[5 * 65]); o.w = pg8::cvt_pk_bf16(s[6 * 65], s[7 * 65]);
        *(GAS v4u*)(dst + (size_t)(row0 + n) * K + k0 + 8 * c) = o; }
    LDS_WAIT(); asm volatile("" ::: "memory");
}
__device__ __forceinline__ void tr_gu(const float* wg, const float* wu, const float* gain, bf16* dst, int it, LAS float* scr, int lane) {
    constexpr int NRB = NGU / 64; const int kb = it / NRB, rb = it % NRB, tile = rb >> 2, w = rb & 3;
    tr_item(w < 2 ? wg : wu, FF, 128 * tile + 64 * (w & 1), 64, gain, 64 * kb, dst, DM, 64 * rb, scr, lane);
}
constexpr int I_GU = (DM / 64) * (NGU / 64), I_D = (FF / 64) * (DM / 64), I_IN = (DM / 64) * (NINP / 64), I_OUT = (DMIX / 64) * (DM / 64);
constexpr int IT_WD1 = I_GU, IT_WIN = IT_WD1 + I_D, IT_WOUT = IT_WIN + I_IN, IT_WGU2 = IT_WOUT + I_OUT, IT_WD2 = IT_WGU2 + I_GU, IT_END = IT_WD2 + I_D;
__device__ __forceinline__ void tr_range(const Args& a, LAS unsigned char* lds, int lo, int hi, int wk, int nwk, int wave, int lane_in) {
    int lane = lane_in; asm volatile("" : "+v"(lane));
    unsigned char* ws = a.ws;
    LAS float* scr = (LAS float*)(lds + wave * 17408);
    for (int it = lo + wk; it < hi; it += nwk) {
        int r = it;
        if (r < IT_WD1) { tr_gu(a.in[I_F1G], a.in[I_F1U], a.in[I_F1N], (bf16*)(ws + WS_WGU1), r, scr, lane); continue; }
        if (r < IT_WIN) { r -= IT_WD1; const int kb = r / (DM / 64), rb = r % (DM / 64); tr_item(a.in[I_F1D], DM, 64 * rb, 64, nullptr, 64 * kb, (bf16*)(ws + WS_WD1), FF, 64 * rb, scr, lane); continue; }
        if (r < IT_WOUT) { r -= IT_WIN; const int kb = r / (NINP / 64), rb = r % (NINP / 64); const int nv = NIN - 64 * rb < 0 ? 0 : (NIN - 64 * rb > 64 ? 64 : NIN - 64 * rb);
            tr_item(a.in[I_WIN], NIN, nv > 0 ? 64 * rb : 0, nv, a.in[I_MIXN], 64 * kb, (bf16*)(ws + WS_WIN), DM, 64 * rb, scr, lane); continue; }
        if (r < IT_WGU2) { r -= IT_WOUT; const int kb = r / (DM / 64), rb = r % (DM / 64); const int k0 = 64 * kb;
            const float* gain = k0 < DLRU ? a.in[I_LON] : a.in[I_SNORM] - DLRU;
            tr_item(a.in[I_WOUT], DM, 64 * rb, 64, gain, k0, (bf16*)(ws + WS_WOUT), DMIX, 64 * rb, scr, lane); continue; }
        if (r < IT_WD2) { tr_gu(a.in[I_F2G], a.in[I_F2U], a.in[I_F2N], (bf16*)(ws + WS_WGU2), r - IT_WGU2, scr, lane); continue; }
        { r -= IT_WD2; const int kb = r / (DM / 64), rb = r % (DM / 64); tr_item(a.in[I_F2D], DM, 64 * rb, 64, nullptr, 64 * kb, (bf16*)(ws + WS_WD2), FF, 64 * rb, scr, lane); }
    }
}
__device__ __forceinline__ void p0_prologue(const Args& a, LAS unsigned char* lds, int vcu, int G, int wave, int lane) {
    unsigned char* ws = a.ws;
    const int gw = vcu * NWAVES + wave, NGW = G * NWAVES;
    tr_range(a, lds, 0, IT_WD1, gw, NGW, wave, lane);
    bf16* xbf = (bf16*)(ws + WS_XBF); float* ss0 = (float*)(ws + WS_SS0);
    for (int m = gw; m < MPAD; m += NGW) {
        f32x4 v[2][2]; float s = 0.f;
        if (m < MREAL) { const GAS f32x4* xr = (const GAS f32x4*)(m < TP ? a.in[I_XP] + (size_t)m * DM : a.in[I_XS] + (size_t)(m - TP) * DM) + 2 * lane;
#pragma unroll
            for (int j = 0; j < 2; ++j) { v[j][0] = __builtin_nontemporal_load(xr + 128 * j); v[j][1] = __builtin_nontemporal_load(xr + 128 * j + 1);
                s += ((v[j][0].x * v[j][0].x + v[j][0].y * v[j][0].y) + (v[j][0].z * v[j][0].z + v[j][0].w * v[j][0].w)) + ((v[j][1].x * v[j][1].x + v[j][1].y * v[j][1].y) + (v[j][1].z * v[j][1].z + v[j][1].w * v[j][1].w)); }
        } else {
#pragma unroll
            for (int j = 0; j < 2; ++j) { v[j][0] = (f32x4){0.f, 0.f, 0.f, 0.f}; v[j][1] = v[j][0]; }
        }
        s = wave_sum(s);
        GAS v4u* o16 = (GAS v4u*)(xbf + (size_t)m * DM) + lane;
#pragma unroll
        for (int j = 0; j < 2; ++j) o16[64 * j] = (v4u){pg8::cvt_pk_bf16(v[j][0].x, v[j][0].y), pg8::cvt_pk_bf16(v[j][0].z, v[j][0].w), pg8::cvt_pk_bf16(v[j][1].x, v[j][1].y), pg8::cvt_pk_bf16(v[j][1].z, v[j][1].w)};
        if (lane < 16) ss0[(size_t)m * 16 + lane] = lane == 0 ? s : 0.f;
    }
}
__device__ __forceinline__ int light_rank(int nwg, int G, int c, int& nlight) {
    const int rem = nwg % G; nlight = rem == 0 ? 0 : G - rem; return (rem != 0 && c >= rem) ? c - rem : -1;
}

__device__ __forceinline__ void p9_final_norm(const Args& a, int vcu, int G, int wave, int lane) {
    const int gw = vcu * NWAVES + wave, NGW = G * NWAVES;
    const bf16* xbf = (const bf16*)(a.ws + WS_XBF); const float* SS = (const float*)(a.ws + WS_SS0); const float* SSX = (const float*)(a.ws + WS_SSX1);
    const GAS f32x4* gn = (const GAS f32x4*)a.in[I_FINN] + 2 * lane;
    f32x4 gv[2][2];
#pragma unroll
    for (int j = 0; j < 2; ++j) { gv[j][0] = gn[128 * j]; gv[j][1] = gn[128 * j + 1]; }
    for (int m = gw; m < MREAL; m += NGW) {
        const float rs = pg8::rstd_row(SS, SSX, m);
        const GAS v4u* xr = (const GAS v4u*)(xbf + (size_t)m * DM) + lane; GAS f32x4* yr = (GAS f32x4*)(a.out + (size_t)m * DM) + 2 * lane;
#pragma unroll
        for (int j = 0; j < 2; ++j) { const v4u w = xr[64 * j];
            __builtin_nontemporal_store((f32x4){bf_lo(w.x), bf_hi(w.x), bf_lo(w.y), bf_hi(w.y)} * rs * gv[j][0], yr + 128 * j);
            __builtin_nontemporal_store((f32x4){bf_lo(w.z), bf_hi(w.z), bf_lo(w.w), bf_hi(w.w)} * rs * gv[j][1], yr + 128 * j + 1); }
    }
}

template <bool SEG3, bool BBF>
__device__ __forceinline__ void small_gemm_resid(const bf16* A, int lda, const bf16* Bt, int K, int id, const float* base, bf16* xbf, float* SSX, float scale,
                                                 const float* SSL, const float* SSS, LAS unsigned char* red, int tid_in) {
    int tid = tid_in; asm volatile("" : "+v"(tid));
    const int wid = __builtin_amdgcn_readfirstlane(tid >> 6), lane = tid & 63, fr = lane & 15, fq = lane >> 4;
    const int rg = id & 3, u = id >> 2, rh = wid >> 2, kq = wid & 3, Kq = K >> 2;
    const int s = rg * 32 + rh * 16 + fr; const size_t row = (size_t)TP + s;
    const bf16* ap = A + row * lda + kq * Kq + fq * 8; const bf16* bp = Bt + (size_t)(u * 16 + fr) * K + kq * Kq + fq * 8;
    f32x4 acc = (f32x4){0.f, 0.f, 0.f, 0.f};
    constexpr int NB = SEG3 ? 8 : 11;
    for (int k0 = 0; k0 < Kq; k0 += NB * 32) {
        bf16x8 av[NB], bv[NB];
#pragma unroll
        for (int ks = 0; ks < NB; ++ks) if (k0 + ks * 32 < Kq) { av[ks] = *(const bf16x8*)(ap + k0 + ks * 32); bv[ks] = *(const bf16x8*)(bp + k0 + ks * 32); }
#pragma unroll
        for (int ks = 0; ks < NB; ++ks) if (k0 + ks * 32 < Kq) acc = __builtin_amdgcn_mfma_f32_16x16x32_bf16(bv[ks], av[ks], acc, 0, 0, 0);
    }
    if (SEG3) { float sm = 0.f;
        if (kq < 2) {
#pragma unroll
            for (int k = 0; k < 16; ++k) sm += SSL[row * 16 + k];
            sm *= (1.0f / 1024.0f);
        } else {
#pragma unroll
            for (int k = 0; k < 8; ++k) sm += SSS[row * 16 + (kq - 2) * 8 + k];
            sm *= (1.0f / 512.0f); }
        acc = acc * (1.0f / sqrtf(sm + EPS)); }
    *(LAS f32x4*)(red + (wid * 64 + lane) * 16) = acc;
    __syncthreads();
    if (kq == 0) {
        f32x4 tot = acc;
#pragma unroll
        for (int q = 1; q < 4; ++q) tot += *(const LAS f32x4*)(red + ((wid + q) * 64 + lane) * 16);
        const int col = u * 16 + 4 * fq;
        f32x4 bv;
        if (BBF) { const pg8::u32x2 b2 = *(const pg8::u32x2*)(xbf + row * DM + col); bv = (f32x4){bf_lo(b2.x), bf_hi(b2.x), bf_lo(b2.y), bf_hi(b2.y)}; }
        else bv = *(const f32x4*)(base + (size_t)s * DM + col);
        const f32x4 v = bv + tot * scale;
        pg8::u32x2 w; w.x = pg8::cvt_pk_bf16(v[0], v[1]); w.y = pg8::cvt_pk_bf16(v[2], v[3]);
        *(pg8::u32x2*)(xbf + row * DM + col) = w;
        float ss = (v[0] * v[0] + v[1] * v[1]) + (v[2] * v[2] + v[3] * v[3]);
        ss = pg8::bfly16(ss, ss); ss = pg8::bfly32(ss, ss);
        if (fq == 0) SSX[(size_t)s * 64 + u] = ss;
    }
    __syncthreads();
}

__device__ __forceinline__ float softplus_f(float x) { return x > 20.f ? x : log1pf(expf(x)); }
__device__ __forceinline__ float sigmoid_f(float x) { return 1.0f / (1.0f + expf(-x)); }
__device__ __forceinline__ float gelu_tanh_f(float y) { const float v = 0.7978845608f * (y + 0.044715f * y * y * y); const float th = 1.0f - 2.0f / (expf(2.0f * v) + 1.0f); return 0.5f * y * (1.0f + th); }
__device__ __forceinline__ float bf1(const bf16* p) { return __uint_as_float((unsigned)(*p) << 16); }
__device__ __forceinline__ bf16 f2bf1(float f) { return (bf16)f2bf(f); }

__device__ __forceinline__ void naive_lru(const Args& a, LAS float* Wl, LAS float* xcl, int hd, int row0, int nseq, int L, bool sample, int lane) {
    bf16* P = (bf16*)(a.ws + WS_P); float* SSL = (float*)(a.ws + WS_SSL);
    const float* Wa = a.in[I_LGAW] + (size_t)hd * 4096; const float* Wx = a.in[I_LGXW] + (size_t)hd * 4096;
    for (int i = 0; i < 64; ++i) { Wl[i * 64 + lane] = Wa[i * 64 + lane]; Wl[4096 + i * 64 + lane] = Wx[i * 64 + lane]; }
    LDS_WAIT();
    const int ch = hd * 64 + lane;
    const float cw0 = a.in[I_LCW][ch], cw1 = a.in[I_LCW][DLRU + ch], cw2 = a.in[I_LCW][2 * DLRU + ch], cw3 = a.in[I_LCW][3 * DLRU + ch], cb = a.in[I_LCB][ch];
    const float ba = a.in[I_LGAB][ch], bx = a.in[I_LGXB][ch], sp = 8.0f * softplus_f(-a.in[I_LAM][ch]);
    for (int s = 0; s < nseq; ++s) {
        float xm3 = 0.f, xm2 = 0.f, xm1 = 0.f, h = 0.f;
        if (sample) { xm3 = a.in[I_SLC][(size_t)(s * 3 + 0) * DLRU + ch]; xm2 = a.in[I_SLC][(size_t)(s * 3 + 1) * DLRU + ch]; xm1 = a.in[I_SLC][(size_t)(s * 3 + 2) * DLRU + ch]; h = a.in[I_SLH][(size_t)s * DLRU + ch]; }
        for (int t = 0; t < L; ++t) {
            const size_t row = (size_t)row0 + (size_t)s * L + t;
            const float x0 = bf1(P + row * PW + ch);
            const float xc = cb + cw0 * xm3 + cw1 * xm2 + cw2 * xm1 + cw3 * x0;
            xm3 = xm2; xm2 = xm1; xm1 = x0;
            xcl[lane] = xc; LDS_WAIT(); asm volatile("" ::: "memory");
            float ga = ba, gx = bx;
#pragma unroll 8
            for (int i = 0; i < 64; ++i) { const float xi = xcl[i]; ga += xi * Wl[i * 64 + lane]; gx += xi * Wl[4096 + i * 64 + lane]; }
            LDS_WAIT(); asm volatile("" ::: "memory");
            const float r = sigmoid_f(ga), ig = sigmoid_f(gx), log_a = -r * sp, av = expf(log_a), u = sqrtf(-expm1f(2.0f * log_a)) * (ig * xc);
            h = av * h + u;
            const float gv = h * gelu_tanh_f(bf1(P + row * PW + DLRU + ch));
            const float ss = wave_sum(gv * gv);
            if (lane == 0) SSL[row * 16 + hd] = ss;
            P[row * PW + DLRU + ch] = f2bf1(gv);
        }
        if (sample) { a.out[O_SLH + (size_t)s * DLRU + ch] = h;
            a.out[O_SLC + (size_t)(s * 3 + 0) * DLRU + ch] = xm3; a.out[O_SLC + (size_t)(s * 3 + 1) * DLRU + ch] = xm2; a.out[O_SLC + (size_t)(s * 3 + 2) * DLRU + ch] = xm1; }
        else { const int b = row0 / SEQ; a.out[O_PLH + (size_t)b * DLRU + ch] = h;
            a.out[O_PLC + (size_t)(b * 3 + 0) * DLRU + ch] = xm3; a.out[O_PLC + (size_t)(b * 3 + 1) * DLRU + ch] = xm2; a.out[O_PLC + (size_t)(b * 3 + 2) * DLRU + ch] = xm1; }
    }
}

__device__ __forceinline__ void naive_ssd(const Args& a, LAS float* sc, int h, int row0, int L, bool sample, int s, int tid) {
    bf16* P = (bf16*)(a.ws + WS_P); float* SSS = (float*)(a.ws + WS_SSS); const float* DT = (const float*)(a.ws + WS_DT);
    const int g = h >> 3, p = tid >> 3, nb = tid & 7;
    LAS float* xs = sc; LAS float* Bv = sc + 64; LAS float* Cv = sc + 192; LAS float* ssq = sc + 320; LAS float* dd = sc + 384;
    const float Ah = -expf(a.in[I_SALOG][h]), dtb = a.in[I_SDTB][h], Dh = a.in[I_SD][h];
    const int cch = tid < 64 ? h * 64 + tid : (tid < 192 ? 1024 + g * 128 + (tid - 64) : 1280 + g * 128 + (tid - 192));
    float cw0 = 0.f, cw1 = 0.f, cw2 = 0.f, cw3 = 0.f, cb = 0.f, xm3 = 0.f, xm2 = 0.f, xm1 = 0.f;
    if (tid < 320) { cw0 = a.in[I_SCW][cch]; cw1 = a.in[I_SCW][DXBC + cch]; cw2 = a.in[I_SCW][2 * DXBC + cch]; cw3 = a.in[I_SCW][3 * DXBC + cch]; cb = a.in[I_SCB][cch];
        if (sample) { xm3 = a.in[I_SSC][(size_t)(s * 3 + 0) * DXBC + cch]; xm2 = a.in[I_SSC][(size_t)(s * 3 + 1) * DXBC + cch]; xm1 = a.in[I_SSC][(size_t)(s * 3 + 2) * DXBC + cch]; } }
    float hst[16];
    const size_t sbase = ((size_t)(s * NHEAD + h) * 64 + p) * 128 + nb * 16;
#pragma unroll
    for (int k = 0; k < 16; ++k) hst[k] = sample ? a.in[I_SSH][sbase + k] : 0.f;
    for (int t = 0; t < L; ++t) {
        const size_t row = (size_t)row0 + t;
        if (tid < 320) { const float x0 = bf1(P + row * PW + 3072 + cch); const float v = cb + cw0 * xm3 + cw1 * xm2 + cw2 * xm1 + cw3 * x0; xm3 = xm2; xm2 = xm1; xm1 = x0;
            sc[tid] = v / (1.0f + expf(-v)); }
        if (tid == 320) { const float dt = softplus_f(DT[row * 16 + h] + dtb); dd[0] = dt; dd[1] = expf(dt * Ah); }
        __syncthreads();
        const float dt = dd[0], dA = dd[1], xp = xs[p], xdt = dt * xp; float yp = 0.f;
#pragma unroll
        for (int k = 0; k < 16; ++k) { hst[k] = hst[k] * dA + xdt * Bv[nb * 16 + k]; yp += Cv[nb * 16 + k] * hst[k]; }
        yp += __shfl_xor(yp, 1); yp += __shfl_xor(yp, 2); yp += __shfl_xor(yp, 4);
        if (nb == 0) { const float y = yp + Dh * xp; const float z = bf1(P + row * PW + 2048 + h * 64 + p); const float gv = y * (z / (1.0f + expf(-z)));
            ssq[p] = gv * gv; P[row * PW + 2048 + h * 64 + p] = f2bf1(gv); }
        __syncthreads();
        if (tid == 0) { float ssum = 0.f; for (int i = 0; i < 64; ++i) ssum += ssq[i]; SSS[row * 16 + h] = ssum; }
    }
    float* so = a.out + (sample ? O_SSH : O_PSH) + sbase;
#pragma unroll
    for (int k = 0; k < 16; ++k) so[k] = hst[k];
    if (tid < 320) { float* co = a.out + (sample ? O_SSC : O_PSC) + (size_t)(s * 3) * DXBC + cch; co[0] = xm3; co[DXBC] = xm2; co[2 * DXBC] = xm1; }
    __syncthreads();
}


constexpr int MS = 272;
constexpr int XNS = 144;
constexpr int L_CN = 0, L_BN = 34816, L_XN = 69632, L_XWN = L_XN + 128 * XNS, L_H = L_XWN + 128 * XNS, L_ACS = L_H + 64 * MS, L_DTJ = L_ACS + 1024, L_WJ = L_DTJ + 1024, L_MSC = L_WJ + 1024;
constexpr int L_XCW = L_MSC + 128;
constexpr int L_GJ = L_XCW + 1280;
static_assert(L_GJ + 1024 <= MISC_OFF && L_MSC + 64 <= L_XCW, "mixer LDS map");
__device__ __forceinline__ unsigned cvtpk(float lo, float hi) { return pg8::cvt_pk_bf16(lo, hi); }
__device__ __forceinline__ float softplus_fast(float x) { const float t = __builtin_amdgcn_exp2f(1.44269504f * x); return x > 20.f ? x : (x < -15.f ? t : 0.693147181f * __builtin_amdgcn_logf(1.0f + t)); }
__device__ __forceinline__ float silu_fast(float x) { return x * __builtin_amdgcn_rcpf(1.0f + __builtin_amdgcn_exp2f(-1.44269504f * x)); }
__device__ __forceinline__ float exp_fast(float x) { return __builtin_amdgcn_exp2f(1.44269504f * x); }
typedef unsigned v2u __attribute__((ext_vector_type(2)));
typedef short s4v_t __attribute__((ext_vector_type(4)));
#define LDTR(addr_) (__builtin_bit_cast(v2u, __builtin_amdgcn_ds_read_tr16_b64_v4i16((LAS s4v_t*)(addr_))))
#define MFMA16(a, b, c) __builtin_amdgcn_mfma_f32_16x16x32_bf16((a), (b), (c), 0, 0, 0)
#define LDFRAG(base, row, ks) (*(const LAS bf16x8*)(lds + (base) + (row) * MS + (ks) * 64 + fq * 16))
#define OPQ_IDX() int tid = tid_in; asm volatile("" : "+v"(tid)); const int lane = tid & 63, fr = lane & 15, fq = lane >> 4; (void)fr; (void)fq; (void)lane

struct ConvW { f32x4 w[4][2], b[2]; };
__device__ __forceinline__ void load_convw(ConvW& c, const float* cw, const float* cb, int ld, int ch) {
#pragma unroll
    for (int k = 0; k < 4; ++k) { c.w[k][0] = *(const f32x4*)(cw + k * ld + ch); c.w[k][1] = *(const f32x4*)(cw + k * ld + ch + 4); }
    c.b[0] = *(const f32x4*)(cb + ch); c.b[1] = *(const f32x4*)(cb + ch + 4);
}
__device__ __forceinline__ void unpack8(const v4u v, float (&x)[8]) { x[0] = bf_lo(v.x); x[1] = bf_hi(v.x); x[2] = bf_lo(v.y); x[3] = bf_hi(v.y); x[4] = bf_lo(v.z); x[5] = bf_hi(v.z); x[6] = bf_lo(v.w); x[7] = bf_hi(v.w); }
__device__ __forceinline__ void conv_tok(const ConvW& c, const float (&r0)[8], const float (&r1)[8], const float (&r2)[8], const float (&r3)[8], float (&o)[8]) {
#pragma unroll
    for (int q = 0; q < 8; ++q) o[q] = c.b[q >> 2][q & 3] + c.w[0][q >> 2][q & 3] * r0[q] + c.w[1][q >> 2][q & 3] * r1[q] + c.w[2][q >> 2][q & 3] * r2[q] + c.w[3][q >> 2][q & 3] * r3[q];
}


struct SPair { const f32x4* hin; f32x4* hout; f32x4 B4, C4; float dt, dA, xv, yacc, Dh, zv; bf16* zp; float* sss; float pp0, pp1, pp2, pp3, pp4, pp5, pp6, pp7; };
__device__ __forceinline__ void sp_begin(SPair& sp, const Args& a, int q, int lane) {
    bf16* P = (bf16*)(a.ws + WS_P); const float* DT = (const float*)(a.ws + WS_DT);
    const int s = q >> 4, h = q & 15, g = h >> 3; const size_t row = (size_t)TP + s;
    const float* cw = a.in[I_SCW]; const float* cb = a.in[I_SCB]; const float* cs = a.in[I_SSC] + (size_t)s * 3 * DXBC; float* cso = a.out + O_SSC + (size_t)s * 3 * DXBC;
    float sv[5];
    {
        float x0[5], x1[5], x2[5], xn[5], w0[5], w1[5], w2[5], w3[5], bb[5];
#pragma unroll
        for (int k = 0; k < 5; ++k) {
            const int ch = k == 0 ? h * 64 + lane : (k < 3 ? 1024 : 1280) + g * 128 + lane + ((k - 1) & 1) * 64;
            x0[k] = cs[ch]; x1[k] = cs[DXBC + ch]; x2[k] = cs[2 * DXBC + ch]; xn[k] = bf1(P + row * PW + 3072 + ch);
            bb[k] = cb[ch]; w0[k] = cw[ch]; w1[k] = cw[DXBC + ch]; w2[k] = cw[2 * DXBC + ch]; w3[k] = cw[3 * DXBC + ch]; }
        asm volatile("s_waitcnt vmcnt(0)" ::: "memory");
#pragma unroll
        for (int k = 0; k < 5; ++k) {
            const int ch = k == 0 ? h * 64 + lane : (k < 3 ? 1024 : 1280) + g * 128 + lane + ((k - 1) & 1) * 64;
            sv[k] = silu_fast(bb[k] + w0[k] * x0[k] + w1[k] * x1[k] + w2[k] * x2[k] + w3[k] * xn[k]);
            if (k == 0 || (h & 7) == 0) { cso[ch] = x1[k]; cso[DXBC + ch] = x2[k]; cso[2 * DXBC + ch] = xn[k]; } }
    }
    const int nb = 4 * (lane & 31);
#pragma unroll
    for (int j = 0; j < 4; ++j) { const int src = (nb + j) & 63; const bool hi = (nb + j) >= 64;
        const float b0 = __shfl(sv[1], src), b1 = __shfl(sv[2], src), c0 = __shfl(sv[3], src), c1 = __shfl(sv[4], src);
        sp.B4[j] = hi ? b1 : b0; sp.C4[j] = hi ? c1 : c0; }
    sp.xv = sv[0];
    sp.dt = softplus_f(DT[row * 16 + h] + a.in[I_SDTB][h]); sp.dA = exp_fast(sp.dt * -expf(a.in[I_SALOG][h])); sp.Dh = a.in[I_SD][h];
    sp.hin = (const f32x4*)(a.in[I_SSH] + (size_t)q * 8192) + lane; sp.hout = (f32x4*)(a.out + O_SSH + (size_t)q * 8192) + lane;
    sp.yacc = 0.f; sp.pp0 = sp.pp1 = sp.pp2 = sp.pp3 = sp.pp4 = sp.pp5 = sp.pp6 = sp.pp7 = 0.f; sp.zp = P + row * PW + 2048 + h * 64 + lane; sp.sss = (float*)(a.ws + WS_SSS) + row * 16 + h;
    sp.zv = bf1(sp.zp);
}
__device__ __forceinline__ void sp_prefetch(const SPair& sp, int c, f32x4& h0, f32x4& h1) { h0 = __builtin_nontemporal_load(sp.hin + (2 * c) * 64); h1 = __builtin_nontemporal_load(sp.hin + (2 * c + 1) * 64); }
__device__ __forceinline__ void sp_step(SPair& sp, int c, const f32x4 h0, const f32x4 h1, int lane) {
    const int hf = lane >> 5;
    const float xa0 = __shfl(sp.xv, 4 * c), xa1 = __shfl(sp.xv, 4 * c + 1), xb0 = __shfl(sp.xv, 4 * c + 2), xb1 = __shfl(sp.xv, 4 * c + 3);
    const float xd0 = sp.dt * (hf ? xa1 : xa0), xd1 = sp.dt * (hf ? xb1 : xb0);
    const f32x4 n0 = h0 * sp.dA + sp.B4 * xd0, n1 = h1 * sp.dA + sp.B4 * xd1;
    __builtin_nontemporal_store(n0, sp.hout + (2 * c) * 64); __builtin_nontemporal_store(n1, sp.hout + (2 * c + 1) * 64);
    const float p0 = (sp.C4[0] * n0[0] + sp.C4[1] * n0[1]) + (sp.C4[2] * n0[2] + sp.C4[3] * n0[3]), p1 = (sp.C4[0] * n1[0] + sp.C4[1] * n1[1]) + (sp.C4[2] * n1[2] + sp.C4[3] * n1[3]);
    const int cc = c & 3;
    if (cc == 0) { sp.pp0 = p0; sp.pp1 = p1; } else if (cc == 1) { sp.pp2 = p0; sp.pp3 = p1; } else if (cc == 2) { sp.pp4 = p0; sp.pp5 = p1; } else { sp.pp6 = p0; sp.pp7 = p1;
        const bool u4 = lane & 16, u3 = lane & 8, u2 = lane & 4;
        float a0 = pg8::bfly16(sp.pp0, sp.pp4), a1 = pg8::bfly16(sp.pp1, sp.pp5), a2 = pg8::bfly16(sp.pp2, sp.pp6), a3 = pg8::bfly16(sp.pp3, sp.pp7);
        float b0 = (u3 ? a2 : a0) + __shfl_xor(u3 ? a0 : a2, 8), b1 = (u3 ? a3 : a1) + __shfl_xor(u3 ? a1 : a3, 8);
        float t = (u2 ? b1 : b0) + __shfl_xor(u2 ? b0 : b1, 4);
        t += __shfl_xor(t, 2); t += __shfl_xor(t, 1);
        const int src = 32 * (lane & 1) + 16 * ((lane >> 3) & 1) + 8 * ((lane >> 2) & 1) + 4 * ((lane >> 1) & 1);
        const float got = __shfl(t, src);
        if ((lane >> 4) == (c >> 2)) sp.yacc = got; }
}
__device__ __forceinline__ void sp_end(SPair& sp, int lane) {
    const float y = sp.yacc + sp.Dh * sp.xv, gv = y * silu_fast(sp.zv);
    const float ss = wave_sum(gv * gv);
    *sp.zp = f2bf1(gv);
    if (lane == 0) *sp.sss = ss;
}

__device__ __forceinline__ void ssd_prepass(const Args& a, int vcu, int G, int tid_in) {
    int tid = tid_in; asm volatile("" : "+v"(tid));
    const bf16* P = (const bf16*)(a.ws + WS_P); bf16* BCc = (bf16*)a.out;
    for (int it = vcu * 512 + tid; it < (TP / 8) * 64; it += G * 512) {
        const int cg = it & 63, run = it >> 6, row0 = run * 8, tt0 = row0 & (SEQ - 1), cch = 1024 + cg * 8;
        const bf16* pb = P + (size_t)(row0 - tt0) * PW + 3072 + cch;
        v4u raw[11];
#pragma unroll
        for (int i = 0; i < 11; ++i) { const int tt = tt0 - 3 + i; raw[i] = *(const v4u*)(pb + (size_t)(tt < 0 ? 0 : tt) * PW); if (tt < 0) raw[i] = (v4u){0u, 0u, 0u, 0u}; }
        ConvW cwv; load_convw(cwv, a.in[I_SCW], a.in[I_SCB], DXBC, cch);
        float r0[8], r1[8], r2[8], r3[8];
        unpack8(raw[0], r0); unpack8(raw[1], r1); unpack8(raw[2], r2);
#pragma unroll
        for (int jj = 0; jj < 8; ++jj) { float o[8];
            if ((jj & 3) == 0) { unpack8(raw[jj + 3], r3); conv_tok(cwv, r0, r1, r2, r3, o); }
            if ((jj & 3) == 1) { unpack8(raw[jj + 3], r0); conv_tok(cwv, r1, r2, r3, r0, o); }
            if ((jj & 3) == 2) { unpack8(raw[jj + 3], r1); conv_tok(cwv, r2, r3, r0, r1, o); }
            if ((jj & 3) == 3) { unpack8(raw[jj + 3], r2); conv_tok(cwv, r3, r0, r1, r2, o); }
            v4u w; w.x = cvtpk(silu_fast(o[0]), silu_fast(o[1])); w.y = cvtpk(silu_fast(o[2]), silu_fast(o[3])); w.z = cvtpk(silu_fast(o[4]), silu_fast(o[5])); w.w = cvtpk(silu_fast(o[6]), silu_fast(o[7]));
            *(v4u*)(BCc + (size_t)(row0 + jj) * 512 + cg * 8) = w; }
    }
}

template <int KM>
__device__ __forceinline__ void ssd_tri(LAS unsigned char* lds, int sl, int i0, int fr, int fq, const bf16x8 (&cf)[4], float acs_i, f32x4 (&accY)[4]) {
    const LAS float* ACS = (const LAS float*)(lds + L_ACS); const LAS float* DTJ = (const LAS float*)(lds + L_DTJ); const LAS float* GJ = (const LAS float*)(lds + L_GJ);
    bf16x8 bq[2][4], xq[4];
#define TRI_LOADB(jt_, s_) do { _Pragma("unroll") for (int ks_ = 0; ks_ < 4; ++ks_) bq[s_][ks_] = LDFRAG(L_BN, (jt_) * 16 + fr, ks_); } while (0)
#define TRI_LOADX(kp_) do { _Pragma("unroll") for (int pt_ = 0; pt_ < 4; ++pt_) { \
            const v2u xa_ = LDTR(lds + L_XN + (32 * (kp_) + 4 * fq + ((fr >> 2) & 3)) * XNS + (pt_ * 16 + 4 * (fr & 3)) * 2), xb_ = LDTR(lds + L_XN + (32 * (kp_) + 16 + 4 * fq + ((fr >> 2) & 3)) * XNS + (pt_ * 16 + 4 * (fr & 3)) * 2); \
            xq[pt_] = __builtin_bit_cast(bf16x8, (v4u){xa_.x, xa_.y, xb_.x, xb_.y}); } } while (0)
    TRI_LOADB(0, 0);
    __builtin_amdgcn_sched_barrier(0);
#pragma unroll
    for (int kp = 0; kp <= KM; ++kp) {
        f32x4 cb[2];
        TRI_LOADB(2 * kp + 1, 1); TRI_LOADX(kp);
        __builtin_amdgcn_sched_barrier(0);
        { f32x4 acc = (f32x4){0.f, 0.f, 0.f, 0.f};
#pragma unroll
          for (int ks = 0; ks < 4; ++ks) acc = MFMA16(bq[0][ks], cf[ks], acc);
          cb[0] = acc; }
        __builtin_amdgcn_sched_barrier(0);
        if (kp < KM) TRI_LOADB(2 * kp + 2, 0);
        float ra0 = 0.f, ra1 = 0.f; f32x4 dq0, dq1;
        if (kp < KM) { ra0 = ACS[sl * 128 + (2 * kp) * 16 + 15]; ra1 = ACS[sl * 128 + (2 * kp + 1) * 16 + 15];
            dq0 = *(const LAS f32x4*)(GJ + sl * 128 + (2 * kp) * 16 + 4 * fq); dq1 = *(const LAS f32x4*)(GJ + sl * 128 + (2 * kp + 1) * 16 + 4 * fq); }
        else { dq0 = *(const LAS f32x4*)(ACS + sl * 128 + (2 * kp) * 16 + 4 * fq); dq1 = *(const LAS f32x4*)(ACS + sl * 128 + (2 * kp + 1) * 16 + 4 * fq); }
        __builtin_amdgcn_sched_barrier(0);
        { f32x4 acc = (f32x4){0.f, 0.f, 0.f, 0.f};
#pragma unroll
          for (int ks = 0; ks < 4; ++ks) acc = MFMA16(bq[1][ks], cf[ks], acc);
          cb[1] = acc; }
        unsigned mw[4];
#pragma unroll
        for (int hh = 0; hh < 2; ++hh) { const int jt = 2 * kp + hh;
            float mv[4];
            if (kp < KM) {
                const float rf = exp_fast(fminf(acs_i - (hh ? ra1 : ra0), 0.f));
                const f32x4 gj = hh ? dq1 : dq0;
#pragma unroll
                for (int r = 0; r < 4; ++r) mv[r] = cb[hh][r] * (rf * gj[r]);
            } else {
                const f32x4 aj = hh ? dq1 : dq0, dj = *(const LAS f32x4*)(DTJ + sl * 128 + jt * 16 + 4 * fq);
#pragma unroll
                for (int r = 0; r < 4; ++r) { const float e = exp_fast(fminf(acs_i - aj[r], 0.f)) * dj[r]; mv[r] = (jt * 16 + 4 * fq + r <= i0 + fr) ? cb[hh][r] * e : 0.f; } }
            mw[2 * hh] = cvtpk(mv[0], mv[1]); mw[2 * hh + 1] = cvtpk(mv[2], mv[3]); }
        const bf16x8 mf = __builtin_bit_cast(bf16x8, (v4u){mw[0], mw[1], mw[2], mw[3]});
#pragma unroll
        for (int pt = 0; pt < 4; ++pt) accY[pt] = MFMA16(xq[pt], mf, accY[pt]);
        __builtin_amdgcn_sched_barrier(0);
    }
#undef TRI_LOADB
#undef TRI_LOADX
}

__device__ __forceinline__ void ssd_unit_fast(const Args& a, LAS unsigned char* lds, int b, int h, int tid_in, int wid, int lane_in, int spq) {
    bf16* P = (bf16*)(a.ws + WS_P); float* SSS = (float*)(a.ws + WS_SSS); const float* DT = (const float*)(a.ws + WS_DT);
    const int g = h >> 3;
    const float Ah = -expf(a.in[I_SALOG][h]), dtb = a.in[I_SDTB][h], Dh = a.in[I_SD][h];
    const float* cw = a.in[I_SCW]; const float* cb = a.in[I_SCB];
    LAS float* ACS = (LAS float*)(lds + L_ACS); LAS float* DTJ = (LAS float*)(lds + L_DTJ); LAS float* WJ = (LAS float*)(lds + L_WJ); LAS float* MSC = (LAS float*)(lds + L_MSC); LAS float* GJ = (LAS float*)(lds + L_GJ);
    const size_t rowb = (size_t)b * SEQ;
    for (int i = tid_in; i < 64 * MS / 16; i += 512) *(LAS v4u*)(lds + L_H + i * 16) = (v4u){0u, 0u, 0u, 0u};
    if (tid_in < 64) { LAS float* xw_ = (LAS float*)(lds + L_XCW) + (tid_in >> 3) * 40 + (tid_in & 7); const int ch_ = h * 64 + tid_in;
        xw_[0] = cw[ch_]; xw_[8] = cw[DXBC + ch_]; xw_[16] = cw[2 * DXBC + ch_]; xw_[24] = cw[3 * DXBC + ch_]; xw_[32] = cb[ch_]; }
    f32x4 accH[4];
#pragma unroll
    for (int pt = 0; pt < 4; ++pt) accH[pt] = (f32x4){0.f, 0.f, 0.f, 0.f};
    const int iw = wid < 4 ? wid : 11 - wid;
    const int i0 = iw * 16, n0 = wid * 16;
    v4u pbig[8], psm[5]; float pdt0 = 0.f, pdt1 = 0.f;
    const bf16* BCc = (const bf16*)a.out;
    constexpr int ACS_WAVE = 3;
#define SSD_ACS(sl, r0_, r1_) do { const float d0 = softplus_fast((r0_) + dtb), d1 = softplus_fast((r1_) + dtb); const float v0 = d0 * Ah, v1 = d1 * Ah, s_ = v0 + v1; float incl = s_; \
        _Pragma("unroll") for (int o_ = 1; o_ < 64; o_ <<= 1) { const float t_ = __shfl_up(incl, o_); if (lane >= o_) incl += t_; } \
        const float a0 = incl - s_ + v0, a1 = incl, last = __shfl(incl, 63); \
        ACS[(sl) * 128 + 2 * lane] = a0; ACS[(sl) * 128 + 2 * lane + 1] = a1; DTJ[(sl) * 128 + 2 * lane] = d0; DTJ[(sl) * 128 + 2 * lane + 1] = d1; \
        WJ[(sl) * 128 + 2 * lane] = exp_fast(last - a0) * d0; WJ[(sl) * 128 + 2 * lane + 1] = exp_fast(last - a1) * d1; if (lane == 0) MSC[sl] = exp_fast(last); \
        const float rt_ = __shfl(incl, (lane & 56) | 7); GJ[(sl) * 128 + 2 * lane] = exp_fast(fminf(rt_ - a0, 0.f)) * d0; GJ[(sl) * 128 + 2 * lane + 1] = exp_fast(fminf(rt_ - a1, 0.f)) * d1; } while (0)
#define SSD_PREFETCH(tc) do { OPQ_IDX(); const int hw_ = tid >> 8, cg_ = tid & 15, j0_ = 8 * ((tid >> 4) & 15); \
        const bf16* pb_ = BCc + (rowb + (tc) + j0_) * 512 + (hw_ ? 0 : 256) + g * 128 + cg_ * 8; \
        _Pragma("unroll") for (int i_ = 0; i_ < 8; ++i_) pbig[i_] = *(const v4u*)(pb_ + (size_t)i_ * 512); \
        const int cx_ = tid & 7, k0_ = 2 * (tid >> 3); const bf16* px_ = P + rowb * PW + 3072 + h * 64 + cx_ * 8; \
        _Pragma("unroll") for (int i_ = 0; i_ < 5; ++i_) { const int tt_ = (tc) + k0_ - 3 + i_; if (SSD_PF_GUARD) { psm[i_] = *(const v4u*)(px_ + (size_t)(tt_ < 0 ? 0 : tt_) * PW); if (tt_ < 0) psm[i_] = (v4u){0u, 0u, 0u, 0u}; } else psm[i_] = *(const v4u*)(px_ + (size_t)tt_ * PW); } \
        if (wid == ACS_WAVE) { pdt0 = DT[(rowb + (tc) + 2 * lane) * 16 + h]; pdt1 = DT[(rowb + (tc) + 2 * lane + 1) * 16 + h]; } } while (0)
    SPair sp; f32x4 sh0 = (f32x4){0.f, 0.f, 0.f, 0.f}, sh1 = sh0;
    if (spq >= 0) { OPQ_IDX(); sp_begin(sp, a, spq, lane); }
#define SSD_PF_GUARD true
    SSD_PREFETCH(0);
#undef SSD_PF_GUARD
#define SSD_PF_GUARD false
    if (wid == ACS_WAVE) { OPQ_IDX(); SSD_ACS(0, pdt0, pdt1); }
    __syncthreads();
#if defined(PROBE_MX)
    unsigned long long pt_[3] = {0, 0, 0}; unsigned long long tl_ = __builtin_amdgcn_s_memrealtime();
#define PSTAMP(k) do { const unsigned long long tn_ = __builtin_amdgcn_s_memrealtime(); pt_[k] += tn_ - tl_; tl_ = tn_; } while (0)
#else
#define PSTAMP(k) do { } while (0)
#endif
    for (int c = 0; c < SEQ / 128; ++c) {
        const int t0 = c * 128, sl = c & 1;
        {   OPQ_IDX();
            const int hw = tid >> 8, cg = tid & 15, j0 = 8 * ((tid >> 4) & 15);
#pragma unroll
            for (int jj = 0; jj < 8; ++jj) *(LAS v4u*)(lds + (hw ? L_BN : L_CN) + (j0 + jj) * MS + cg * 16) = pbig[jj];
            const int cx = tid & 7, k0 = 2 * (tid >> 3);
            ConvW cxv; { const LAS float* xw_ = (const LAS float*)(lds + L_XCW) + cx * 40;
#pragma unroll
                for (int k = 0; k < 4; ++k) { cxv.w[k][0] = *(const LAS f32x4*)(xw_ + k * 8); cxv.w[k][1] = *(const LAS f32x4*)(xw_ + k * 8 + 4); }
                cxv.b[0] = *(const LAS f32x4*)(xw_ + 32); cxv.b[1] = *(const LAS f32x4*)(xw_ + 36); }
            float s0[8], s1[8], s2[8], s3[8], s4[8], o0[8], o1[8];
            unpack8(psm[0], s0); unpack8(psm[1], s1); unpack8(psm[2], s2); unpack8(psm[3], s3); unpack8(psm[4], s4);
            conv_tok(cxv, s0, s1, s2, s3, o0); conv_tok(cxv, s1, s2, s3, s4, o1);
            const float w0 = WJ[sl * 128 + k0], w1 = WJ[sl * 128 + k0 + 1];
            float x0[8], x1[8];
#pragma unroll
            for (int q = 0; q < 8; ++q) { x0[q] = silu_fast(o0[q]); x1[q] = silu_fast(o1[q]); }
            *(LAS v4u*)(lds + L_XN + k0 * XNS + cx * 16) = (v4u){cvtpk(x0[0], x0[1]), cvtpk(x0[2], x0[3]), cvtpk(x0[4], x0[5]), cvtpk(x0[6], x0[7])};
            *(LAS v4u*)(lds + L_XN + (k0 + 1) * XNS + cx * 16) = (v4u){cvtpk(x1[0], x1[1]), cvtpk(x1[2], x1[3]), cvtpk(x1[4], x1[5]), cvtpk(x1[6], x1[7])};
            *(LAS v4u*)(lds + L_XWN + k0 * XNS + cx * 16) = (v4u){cvtpk(x0[0] * w0, x0[1] * w0), cvtpk(x0[2] * w0, x0[3] * w0), cvtpk(x0[4] * w0, x0[5] * w0), cvtpk(x0[6] * w0, x0[7] * w0)};
            *(LAS v4u*)(lds + L_XWN + (k0 + 1) * XNS + cx * 16) = (v4u){cvtpk(x1[0] * w1, x1[1] * w1), cvtpk(x1[2] * w1, x1[3] * w1), cvtpk(x1[4] * w1, x1[5] * w1), cvtpk(x1[6] * w1, x1[7] * w1)};
        }
        SSD_PREFETCH(t0 + 128);
        if (spq >= 0) sp_prefetch(sp, c, sh0, sh1);
        v4u zq[2];
        {   OPQ_IDX();
            const bf16* zp = P + (rowb + t0 + i0 + fr) * PW + 2048 + h * 64 + ((fq & 1) ? 16 + 4 * (fq - 1) : 4 * fq);
            zq[0] = *(const v4u*)zp; zq[1] = *(const v4u*)(zp + 32); }
        __syncthreads();
        PSTAMP(0);
        OPQ_IDX();
        f32x4 accY[4];
        {
            bf16x8 cf[4];
#pragma unroll
            for (int ks = 0; ks < 4; ++ks) cf[ks] = LDFRAG(L_CN, i0 + fr, ks);
            const int trq = (fr >> 2) & 3, trp = fr & 3;
            bf16x8 bt[4], wq[2][4];
#define ST_LOADW(pt_, s_) do { _Pragma("unroll") for (int ks_ = 0; ks_ < 4; ++ks_) { \
                const v2u w0_ = LDTR(lds + L_XWN + (32 * ks_ + 8 * fq + trq) * XNS + ((pt_) * 16 + 4 * trp) * 2), w1_ = LDTR(lds + L_XWN + (32 * ks_ + 8 * fq + 4 + trq) * XNS + ((pt_) * 16 + 4 * trp) * 2); \
                wq[s_][ks_] = __builtin_bit_cast(bf16x8, (v4u){w0_.x, w0_.y, w1_.x, w1_.y}); } } while (0)
#define ST_LOADH(pt_, s_) do { _Pragma("unroll") for (int ks_ = 0; ks_ < 4; ++ks_) wq[s_][ks_] = LDFRAG(L_H, (pt_) * 16 + fr, ks_); } while (0)
#pragma unroll
            for (int ks = 0; ks < 4; ++ks) { const v2u b0 = LDTR(lds + L_BN + (32 * ks + 8 * fq + trq) * MS + (n0 + 4 * trp) * 2), b1 = LDTR(lds + L_BN + (32 * ks + 8 * fq + 4 + trq) * MS + (n0 + 4 * trp) * 2);
                bt[ks] = __builtin_bit_cast(bf16x8, (v4u){b0.x, b0.y, b1.x, b1.y}); }
            ST_LOADW(0, 0);
            const float dec = MSC[sl];
            const float acs_i = ACS[sl * 128 + i0 + fr], e_i = exp_fast(acs_i);
            __builtin_amdgcn_sched_barrier(0);
#pragma unroll
            for (int pt = 0; pt < 4; ++pt) {
                if (pt < 3) ST_LOADW(pt + 1, (pt + 1) & 1); else ST_LOADH(0, 0);
                __builtin_amdgcn_sched_barrier(0);
                accH[pt] = accH[pt] * dec;
#pragma unroll
                for (int ks = 0; ks < 4; ++ks) accH[pt] = MFMA16(bt[ks], wq[pt & 1][ks], accH[pt]);
                __builtin_amdgcn_sched_barrier(0); }
#pragma unroll
            for (int pt = 0; pt < 4; ++pt) {
                if (pt < 3) ST_LOADH(pt + 1, (pt + 1) & 1);
                __builtin_amdgcn_sched_barrier(0);
                f32x4 acc = (f32x4){0.f, 0.f, 0.f, 0.f};
#pragma unroll
                for (int ks = 0; ks < 4; ++ks) acc = MFMA16(wq[pt & 1][ks], cf[ks], acc);
                accY[pt] = acc * e_i;
                __builtin_amdgcn_sched_barrier(0); }
#undef ST_LOADW
#undef ST_LOADH
            switch (iw >> 1) {
                case 0: ssd_tri<0>(lds, sl, i0, fr, fq, cf, acs_i, accY); break;
                case 1: ssd_tri<1>(lds, sl, i0, fr, fq, cf, acs_i, accY); break;
                case 2: ssd_tri<2>(lds, sl, i0, fr, fq, cf, acs_i, accY); break;
                default: ssd_tri<3>(lds, sl, i0, fr, fq, cf, acs_i, accY); break; }
#pragma unroll
            for (int pt = 0; pt < 4; ++pt) { const v2u xd = *(const LAS v2u*)(lds + L_XN + (i0 + fr) * XNS + (pt * 16 + 4 * fq) * 2);
                accY[pt][0] += Dh * bf_lo(xd.x); accY[pt][1] += Dh * bf_hi(xd.x); accY[pt][2] += Dh * bf_lo(xd.y); accY[pt][3] += Dh * bf_hi(xd.y); }
            if (wid == ACS_WAVE && c + 1 < SEQ / 128) SSD_ACS(sl ^ 1, pdt0, pdt1);
        }
        __syncthreads();
        PSTAMP(1);
        {
#pragma unroll
            for (int pt = 0; pt < 4; ++pt) { v2u w; w.x = cvtpk(accH[pt][0], accH[pt][1]); w.y = cvtpk(accH[pt][2], accH[pt][3]);
                *(LAS v2u*)(lds + L_H + (pt * 16 + fr) * MS + (n0 + 4 * fq) * 2) = w; }
            const size_t row = rowb + t0 + i0 + fr; float ss = 0.f;
            v2u zr[4];
#pragma unroll
            for (int pp = 0; pp < 2; ++pp) {
                const auto r0 = __builtin_amdgcn_permlane16_swap(zq[pp].x, zq[pp].z, false, false), r1 = __builtin_amdgcn_permlane16_swap(zq[pp].y, zq[pp].w, false, false);
                zr[2 * pp].x = r0[0]; zr[2 * pp].y = r1[0]; zr[2 * pp + 1].x = r0[1]; zr[2 * pp + 1].y = r1[1]; }
            v2u wo[4];
#pragma unroll
            for (int pt = 0; pt < 4; ++pt) {
                const float z[4] = {bf_lo(zr[pt].x), bf_hi(zr[pt].x), bf_lo(zr[pt].y), bf_hi(zr[pt].y)};
                float gv[4];
#pragma unroll
                for (int r = 0; r < 4; ++r) { gv[r] = accY[pt][r] * silu_fast(z[r]); ss += gv[r] * gv[r]; }
                wo[pt].x = cvtpk(gv[0], gv[1]); wo[pt].y = cvtpk(gv[2], gv[3]); }
            {   bf16* zp = P + row * PW + 2048 + h * 64 + ((fq & 1) ? 16 + 4 * (fq - 1) : 4 * fq);
#pragma unroll
                for (int pp = 0; pp < 2; ++pp) {
                    const auto r0 = __builtin_amdgcn_permlane16_swap(wo[2 * pp].x, wo[2 * pp + 1].x, false, false), r1 = __builtin_amdgcn_permlane16_swap(wo[2 * pp].y, wo[2 * pp + 1].y, false, false);
                    *(v4u*)(zp + pp * 32) = (v4u){r0[0], r1[0], r0[1], r1[1]}; } }
            ss = pg8::bfly16(ss, ss); ss = pg8::bfly32(ss, ss);
            if (fq == 0) SSS[row * 16 + h] = ss;
            if (spq >= 0) sp_step(sp, c, sh0, sh1, lane);
        }
        PSTAMP(2);
    }
#if defined(PROBE_MX)
    if (b == 0 && h == 0 && tid_in == 0) { unsigned long long* tp_ = (unsigned long long*)(a.ws + WS_CTL + 8192); tp_[8] = pt_[0]; tp_[9] = pt_[1]; tp_[10] = pt_[2]; }
#endif
    if (spq >= 0) { OPQ_IDX(); sp_end(sp, lane); }
    {   OPQ_IDX();
#pragma unroll
        for (int pt = 0; pt < 4; ++pt) *(f32x4*)(a.out + O_PSH + ((size_t)(b * NHEAD + h) * 64 + pt * 16 + fr) * 128 + n0 + 4 * fq) = accH[pt];
        for (int i = tid; i < 3 * 64; i += 512) { const int k = i >> 6, ch = h * 64 + (i & 63);
            a.out[O_PSC + (size_t)(b * 3 + k) * DXBC + ch] = bf1(P + (rowb + SEQ - 3 + k) * PW + 3072 + ch); }
        if ((h & 7) == 0) for (int i = tid; i < 3 * 256; i += 512) { const int k = i >> 8, ch = 1024 + ((i >> 7) & 1) * 256 + g * 128 + (i & 127);
            a.out[O_PSC + (size_t)(b * 3 + k) * DXBC + ch] = bf1(P + (rowb + SEQ - 3 + k) * PW + 3072 + ch); }
    }
    __syncthreads();
}

constexpr int XS = 144, LF = 68;
constexpr int LL_XC = 0, LL_WA = 18432, LL_WX = 27648, LL_XF = 36864, LL_A = 71680, LL_U = 106496, LL_SEGP = 141312, LL_SEGH = 143360, LL_HC = 145408, LL_PAR = 145920;
constexpr int LL_CW = 146688;
constexpr int LL_SEG2 = LL_CW + 1280;
static_assert(LL_SEG2 + 4096 <= MISC_OFF, "lru LDS map");
__device__ __forceinline__ float sigmoid_fast(float x) { return __builtin_amdgcn_rcpf(1.0f + __builtin_amdgcn_exp2f(-1.44269504f * x)); }
__device__ __forceinline__ float gelu_tanh_fast(float y) { const float v = 0.7978845608f * (y + 0.044715f * y * y * y); const float th = 1.0f - 2.0f * __builtin_amdgcn_rcpf(__builtin_amdgcn_exp2f(2.88539008f * v) + 1.0f); return 0.5f * y * (1.0f + th); }
__device__ __forceinline__ float one_minus_exp(float x) {
    const float ser = -x * (1.0f + x * (0.5f + x * (0.16666667f + x * (0.041666668f + x * (0.0083333338f + x * 0.0013888889f)))));
    const float dir = 1.0f - __builtin_amdgcn_exp2f(1.44269504f * x);
    return x > -0.3f ? ser : dir;
}
#define OPQ_IDX2() int tid = tid_in; asm volatile("" : "+v"(tid)); const int lane = tid & 63, fr = lane & 15, fq = lane >> 4; (void)fr; (void)fq; (void)lane

template <bool SAMPLE>
__device__ __forceinline__ void lru_unit_fast(const Args& a, LAS unsigned char* lds, int b, int hd, int tid_in, int wid) {
    bf16* P = (bf16*)(a.ws + WS_P); float* SSL = (float*)(a.ws + WS_SSL);
    const size_t rowb = SAMPLE ? (size_t)TP : (size_t)b * SEQ;
    LAS float* XF = (LAS float*)(lds + LL_XF); LAS float* AA = (LAS float*)(lds + LL_A); LAS float* UU = (LAS float*)(lds + LL_U);
    LAS float* SEGP = (LAS float*)(lds + LL_SEGP); LAS float* SEGH = (LAS float*)(lds + LL_SEGH); LAS float* HC = (LAS float*)(lds + LL_HC); LAS float* PAR = (LAS float*)(lds + LL_PAR);
    {   OPQ_IDX2();
        const float* Wa = a.in[I_LGAW] + (size_t)hd * 4096; const float* Wx = a.in[I_LGXW] + (size_t)hd * 4096;
        for (int idx = tid; idx < 4096; idx += 512) { const int i = idx >> 6, j = idx & 63;
            *(LAS unsigned short*)(lds + LL_WA + j * XS + i * 2) = (unsigned short)f2bf(Wa[idx]);
            *(LAS unsigned short*)(lds + LL_WX + j * XS + i * 2) = (unsigned short)f2bf(Wx[idx]); }
        if (tid < 64) { const int ch = hd * 64 + tid; PAR[tid] = a.in[I_LGAB][ch]; PAR[64 + tid] = a.in[I_LGXB][ch]; PAR[128 + tid] = 8.0f * softplus_f(-a.in[I_LAM][ch]); HC[tid] = 0.f; HC[64 + tid] = 0.f; }
    }
    __syncthreads();
    const int nchunk = SAMPLE ? 1 : SEQ / 128;
    for (int c = 0; c < nchunk; ++c) {
        const int t0 = c * 128;
        {   OPQ_IDX2();
            const int cg = tid & 7, j0 = 2 * (tid >> 3), ch0 = hd * 64 + cg * 8;
            const float* cw = a.in[I_LCW]; const float* cb = a.in[I_LCB];
            f32x4 w[4][2], bb[2];
#pragma unroll
            for (int k = 0; k < 4; ++k) { w[k][0] = *(const f32x4*)(cw + k * DLRU + ch0); w[k][1] = *(const f32x4*)(cw + k * DLRU + ch0 + 4); }
            bb[0] = *(const f32x4*)(cb + ch0); bb[1] = *(const f32x4*)(cb + ch0 + 4);
            if (!SAMPLE) {
                float xin[5][8];
#pragma unroll
                for (int i = 0; i < 5; ++i) { const int tt = t0 + j0 - 3 + i, ttc = tt < 0 ? 0 : tt;
                    v4u v = *(const v4u*)(P + (rowb + ttc) * PW + ch0);
                    if (tt < 0) v = (v4u){0u, 0u, 0u, 0u};
                    xin[i][0] = bf_lo(v.x); xin[i][1] = bf_hi(v.x); xin[i][2] = bf_lo(v.y); xin[i][3] = bf_hi(v.y); xin[i][4] = bf_lo(v.z); xin[i][5] = bf_hi(v.z); xin[i][6] = bf_lo(v.w); xin[i][7] = bf_hi(v.w); }
#pragma unroll
                for (int jj = 0; jj < 2; ++jj) { float o[8];
#pragma unroll
                    for (int q = 0; q < 8; ++q) o[q] = bb[q >> 2][q & 3] + w[0][q >> 2][q & 3] * xin[jj][q] + w[1][q >> 2][q & 3] * xin[jj + 1][q] + w[2][q >> 2][q & 3] * xin[jj + 2][q] + w[3][q >> 2][q & 3] * xin[jj + 3][q];
                    *(LAS f32x4*)(XF + (j0 + jj) * LF + cg * 8) = (f32x4){o[0], o[1], o[2], o[3]}; *(LAS f32x4*)(XF + (j0 + jj) * LF + cg * 8 + 4) = (f32x4){o[4], o[5], o[6], o[7]};
                    v4u pw; pw.x = pg8::cvt_pk_bf16(o[0], o[1]); pw.y = pg8::cvt_pk_bf16(o[2], o[3]); pw.z = pg8::cvt_pk_bf16(o[4], o[5]); pw.w = pg8::cvt_pk_bf16(o[6], o[7]);
                    *(LAS v4u*)(lds + LL_XC + (j0 + jj) * XS + cg * 16) = pw; }
            } else {
#pragma unroll
                for (int jj = 0; jj < 2; ++jj) { const int s = j0 + jj;
                    const v4u v = *(const v4u*)(P + (rowb + s) * PW + ch0);
                    const float xn[8] = {bf_lo(v.x), bf_hi(v.x), bf_lo(v.y), bf_hi(v.y), bf_lo(v.z), bf_hi(v.z), bf_lo(v.w), bf_hi(v.w)};
                    const float* sb = a.in[I_SLC] + (size_t)s * 3 * DLRU + ch0; float* so = a.out + O_SLC + (size_t)s * 3 * DLRU + ch0;
                    f32x4 h0[2], h1[2], h2[2];
#pragma unroll
                    for (int q = 0; q < 2; ++q) { h0[q] = *(const f32x4*)(sb + 4 * q); h1[q] = *(const f32x4*)(sb + DLRU + 4 * q); h2[q] = *(const f32x4*)(sb + 2 * DLRU + 4 * q); }
                    float o[8];
#pragma unroll
                    for (int q = 0; q < 8; ++q) o[q] = bb[q >> 2][q & 3] + w[0][q >> 2][q & 3] * h0[q >> 2][q & 3] + w[1][q >> 2][q & 3] * h1[q >> 2][q & 3] + w[2][q >> 2][q & 3] * h2[q >> 2][q & 3] + w[3][q >> 2][q & 3] * xn[q];
#pragma unroll
                    for (int q = 0; q < 2; ++q) { *(f32x4*)(so + 4 * q) = h1[q]; *(f32x4*)(so + DLRU + 4 * q) = h2[q]; *(f32x4*)(so + 2 * DLRU + 4 * q) = (f32x4){xn[4 * q], xn[4 * q + 1], xn[4 * q + 2], xn[4 * q + 3]}; }
                    *(LAS f32x4*)(XF + s * LF + cg * 8) = (f32x4){o[0], o[1], o[2], o[3]}; *(LAS f32x4*)(XF + s * LF + cg * 8 + 4) = (f32x4){o[4], o[5], o[6], o[7]};
                    v4u pw; pw.x = pg8::cvt_pk_bf16(o[0], o[1]); pw.y = pg8::cvt_pk_bf16(o[2], o[3]); pw.z = pg8::cvt_pk_bf16(o[4], o[5]); pw.w = pg8::cvt_pk_bf16(o[6], o[7]);
                    *(LAS v4u*)(lds + LL_XC + s * XS + cg * 16) = pw; }
            }
        }
        __syncthreads();
        {   OPQ_IDX2();
            const int tok = wid * 16 + fr;
            bf16x8 xf[2];
#pragma unroll
            for (int ks = 0; ks < 2; ++ks) xf[ks] = *(const LAS bf16x8*)(lds + LL_XC + tok * XS + ks * 64 + fq * 16);
#pragma unroll
            for (int jt = 0; jt < 4; ++jt) {
                f32x4 ga = (f32x4){0.f, 0.f, 0.f, 0.f}, gx = (f32x4){0.f, 0.f, 0.f, 0.f};
#pragma unroll
                for (int ks = 0; ks < 2; ++ks) {
                    ga = MFMA16(*(const LAS bf16x8*)(lds + LL_WA + (jt * 16 + fr) * XS + ks * 64 + fq * 16), xf[ks], ga);
                    gx = MFMA16(*(const LAS bf16x8*)(lds + LL_WX + (jt * 16 + fr) * XS + ks * 64 + fq * 16), xf[ks], gx); }
                const int j = jt * 16 + 4 * fq;
                const f32x4 ba = *(const LAS f32x4*)(PAR + j), bx = *(const LAS f32x4*)(PAR + 64 + j), sp = *(const LAS f32x4*)(PAR + 128 + j), xc = *(const LAS f32x4*)(XF + tok * LF + j);
                f32x4 av, uv;
#pragma unroll
                for (int r = 0; r < 4; ++r) { const float rr = sigmoid_fast(ga[r] + ba[r]), ig = sigmoid_fast(gx[r] + bx[r]), la = -rr * sp[r];
                    av[r] = __builtin_amdgcn_exp2f(1.44269504f * la); uv[r] = __builtin_amdgcn_sqrtf(fmaxf(fmaf(-av[r], av[r], 1.0f), 0.f)) * (ig * xc[r]); }
                *(LAS f32x4*)(AA + tok * LF + j) = av; *(LAS f32x4*)(UU + tok * LF + j) = uv;
            }
        }
        __syncthreads();
        if (!SAMPLE) {
            OPQ_IDX2();
            float cp[16], hl[16]; float pp = 1.f, hh = 0.f;
#pragma unroll
            for (int t = 0; t < 16; ++t) { const float at = AA[(wid * 16 + t) * LF + lane], ut = UU[(wid * 16 + t) * LF + lane]; pp *= at; hh = at * hh + ut; cp[t] = pp; hl[t] = hh; }
            SEGP[wid * 64 + lane] = pp; SEGH[wid * 64 + lane] = hh;
            __syncthreads();
            float cin = HC[(c & 1) * 64 + lane];
            for (int s = 0; s < wid; ++s) cin = SEGP[s * 64 + lane] * cin + SEGH[s * 64 + lane];
            if (wid == 7) HC[((c + 1) & 1) * 64 + lane] = hl[15] + cp[15] * cin;
            const int ch = hd * 64 + lane;
#pragma unroll
            for (int t = 0; t < 16; ++t) { const size_t row = rowb + t0 + wid * 16 + t; bf16* yp = P + row * PW + DLRU + ch;
                const float ht = hl[t] + cp[t] * cin, gv = ht * gelu_tanh_fast(bf1(yp));
                const float ss = wave_sum(gv * gv);
                *yp = f2bf1(gv);
                if (lane == 0) SSL[row * 16 + hd] = ss; }
            if (c == nchunk - 1 && wid == 7) a.out[O_PLH + (size_t)b * DLRU + ch] = hl[15] + cp[15] * cin;
        } else {
            OPQ_IDX2();
            const int ch = hd * 64 + lane;
#pragma unroll
            for (int t = 0; t < 16; ++t) { const int s = wid * 16 + t; const size_t row = rowb + s; bf16* yp = P + row * PW + DLRU + ch;
                const float ht = AA[s * LF + lane] * a.in[I_SLH][(size_t)s * DLRU + ch] + UU[s * LF + lane];
                a.out[O_SLH + (size_t)s * DLRU + ch] = ht;
                const float gv = ht * gelu_tanh_fast(bf1(yp));
                const float ss = wave_sum(gv * gv);
                *yp = f2bf1(gv);
                if (lane == 0) SSL[row * 16 + hd] = ss; }
        }
    }
    if (!SAMPLE) {
        OPQ_IDX2();
        for (int i = tid; i < 3 * 64; i += 512) { const int k = i >> 6, ch = hd * 64 + (i & 63);
            a.out[O_PLC + (size_t)(b * 3 + k) * DLRU + ch] = bf1(P + (rowb + SEQ - 3 + k) * PW + ch); }
    }
    __syncthreads();
}

__device__ __forceinline__ void lru_unit_prompt(const Args& a, LAS unsigned char* lds, int b, int hd, int tid_in, int wid, int spq, int spq2) {
    bf16* P = (bf16*)(a.ws + WS_P); float* SSL = (float*)(a.ws + WS_SSL);
    const size_t rowb = (size_t)b * SEQ;
    LAS float* XF = (LAS float*)(lds + LL_XF); LAS float* AA = (LAS float*)(lds + LL_A); LAS float* UU = (LAS float*)(lds + LL_U);
    LAS float* SEGP = (LAS float*)(lds + LL_SEGP); LAS float* SEGH = (LAS float*)(lds + LL_SEGH); LAS float* HC = (LAS float*)(lds + LL_HC); LAS float* PAR = (LAS float*)(lds + LL_PAR);
    v4u px[5]; v4u pyv[2];
#define LRU_PREF_X(tc) do { OPQ_IDX2(); const bf16* pp_ = P + rowb * PW + hd * 64 + (tid & 7) * 8; const int j0_ = 2 * (tid >> 3); \
        _Pragma("unroll") for (int i_ = 0; i_ < 5; ++i_) { const int tt_ = (tc) + j0_ - 3 + i_; if (LRU_PF_GUARD) { px[i_] = *(const v4u*)(pp_ + (size_t)(tt_ < 0 ? 0 : tt_) * PW); if (tt_ < 0) px[i_] = (v4u){0u, 0u, 0u, 0u}; } else px[i_] = *(const v4u*)(pp_ + (size_t)tt_ * PW); } } while (0)
#define LRU_PREF_Y(tc) do { OPQ_IDX2(); const bf16* yp_ = P + (rowb + (tc) + wid * 16 + fr) * PW + DLRU + hd * 64 + fq * 16; \
        pyv[0] = *(const v4u*)yp_; pyv[1] = *(const v4u*)(yp_ + 8); } while (0)
#define LRU_CONV() do { OPQ_IDX2(); const int cg = tid & 7, j0 = 2 * (tid >> 3); ConvW cv; { const LAS float* cw_ = (const LAS float*)(lds + LL_CW) + cg * 40; \
        _Pragma("unroll") for (int k_ = 0; k_ < 4; ++k_) { cv.w[k_][0] = *(const LAS f32x4*)(cw_ + k_ * 8); cv.w[k_][1] = *(const LAS f32x4*)(cw_ + k_ * 8 + 4); } cv.b[0] = *(const LAS f32x4*)(cw_ + 32); cv.b[1] = *(const LAS f32x4*)(cw_ + 36); } \
        float s0[8], s1[8], s2[8], s3[8], s4[8], o0[8], o1[8]; unpack8(px[0], s0); unpack8(px[1], s1); unpack8(px[2], s2); unpack8(px[3], s3); unpack8(px[4], s4); \
        conv_tok(cv, s0, s1, s2, s3, o0); conv_tok(cv, s1, s2, s3, s4, o1); \
        *(LAS f32x4*)(XF + j0 * LF + cg * 8) = (f32x4){o0[0], o0[1], o0[2], o0[3]}; *(LAS f32x4*)(XF + j0 * LF + cg * 8 + 4) = (f32x4){o0[4], o0[5], o0[6], o0[7]}; \
        *(LAS f32x4*)(XF + (j0 + 1) * LF + cg * 8) = (f32x4){o1[0], o1[1], o1[2], o1[3]}; *(LAS f32x4*)(XF + (j0 + 1) * LF + cg * 8 + 4) = (f32x4){o1[4], o1[5], o1[6], o1[7]}; \
        *(LAS v4u*)(lds + LL_XC + j0 * XS + cg * 16) = (v4u){pg8::cvt_pk_bf16(o0[0], o0[1]), pg8::cvt_pk_bf16(o0[2], o0[3]), pg8::cvt_pk_bf16(o0[4], o0[5]), pg8::cvt_pk_bf16(o0[6], o0[7])}; \
        *(LAS v4u*)(lds + LL_XC + (j0 + 1) * XS + cg * 16) = (v4u){pg8::cvt_pk_bf16(o1[0], o1[1]), pg8::cvt_pk_bf16(o1[2], o1[3]), pg8::cvt_pk_bf16(o1[4], o1[5]), pg8::cvt_pk_bf16(o1[6], o1[7])}; } while (0)
#define LRU_PF_GUARD true
    LRU_PREF_X(0); LRU_PREF_Y(0);
#undef LRU_PF_GUARD
#define LRU_PF_GUARD false
    {   OPQ_IDX2();
        const float* Wa = a.in[I_LGAW] + (size_t)hd * 4096; const float* Wx = a.in[I_LGXW] + (size_t)hd * 4096;
        float wa_[8], wx_[8];
#pragma unroll
        for (int q = 0; q < 8; ++q) { wa_[q] = __builtin_nontemporal_load(Wa + tid + 512 * q); wx_[q] = __builtin_nontemporal_load(Wx + tid + 512 * q); }
#pragma unroll
        for (int q = 0; q < 8; ++q) { const int idx = tid + 512 * q, i = idx >> 6, j = idx & 63;
            *(LAS unsigned short*)(lds + LL_WA + j * XS + i * 2) = (unsigned short)f2bf(wa_[q]);
            *(LAS unsigned short*)(lds + LL_WX + j * XS + i * 2) = (unsigned short)f2bf(wx_[q]); }
        if (tid < 64) { const int ch = hd * 64 + tid; PAR[tid] = a.in[I_LGAB][ch]; PAR[64 + tid] = a.in[I_LGXB][ch]; PAR[128 + tid] = 8.0f * softplus_f(-a.in[I_LAM][ch]); HC[tid] = 0.f; HC[64 + tid] = 0.f;
            LAS float* cw_ = (LAS float*)(lds + LL_CW) + (tid >> 3) * 40 + (tid & 7); const float* gw_ = a.in[I_LCW];
            cw_[0] = gw_[ch]; cw_[8] = gw_[DLRU + ch]; cw_[16] = gw_[2 * DLRU + ch]; cw_[24] = gw_[3 * DLRU + ch]; cw_[32] = a.in[I_LCB][ch]; }
    }
    SPair sp, sp2; f32x4 sh0 = (f32x4){0.f, 0.f, 0.f, 0.f}, sh1 = sh0, sh2 = sh0, sh3 = sh0;
    if (spq >= 0) { OPQ_IDX2(); sp_begin(sp, a, spq, lane); }
    if (spq2 >= 0) { OPQ_IDX2(); sp_begin(sp2, a, spq2, lane); }
    __syncthreads();
    LRU_CONV();
    for (int c = 0; c < SEQ / 128; ++c) {
        const int t0 = c * 128;
        asm volatile("s_waitcnt lgkmcnt(0)" ::: "memory");
        LAS float* SEGPc = (c & 1) ? (LAS float*)(lds + LL_SEG2) : SEGP; LAS float* SEGHc = (c & 1) ? (LAS float*)(lds + LL_SEG2 + 2048) : SEGH;
        {   OPQ_IDX2();
            const int tok = wid * 16 + fr;
            bf16x8 xf[2];
#pragma unroll
            for (int ks = 0; ks < 2; ++ks) xf[ks] = *(const LAS bf16x8*)(lds + LL_XC + tok * XS + ks * 64 + fq * 16);
            bf16x8 gw[2][4]; f32x4 gp[2][4];
#define LRU_LOADJ(jt_, s_) do { _Pragma("unroll") for (int ks_ = 0; ks_ < 2; ++ks_) { \
                    gw[s_][2 * ks_] = *(const LAS bf16x8*)(lds + LL_WA + ((jt_) * 16 + fr) * XS + ks_ * 64 + fq * 16); gw[s_][2 * ks_ + 1] = *(const LAS bf16x8*)(lds + LL_WX + ((jt_) * 16 + fr) * XS + ks_ * 64 + fq * 16); } \
                gp[s_][0] = *(const LAS f32x4*)(PAR + (jt_) * 16 + 4 * fq); gp[s_][1] = *(const LAS f32x4*)(PAR + 64 + (jt_) * 16 + 4 * fq); gp[s_][2] = *(const LAS f32x4*)(PAR + 128 + (jt_) * 16 + 4 * fq); \
                gp[s_][3] = *(const LAS f32x4*)(XF + tok * LF + (jt_) * 16 + 4 * fq); } while (0)
            LRU_LOADJ(0, 0);
            __builtin_amdgcn_sched_barrier(0);
#pragma unroll
            for (int jt = 0; jt < 4; ++jt) {
                if (jt < 3) LRU_LOADJ(jt + 1, (jt + 1) & 1);
                __builtin_amdgcn_sched_barrier(0);
                f32x4 ga = (f32x4){0.f, 0.f, 0.f, 0.f}, gx = (f32x4){0.f, 0.f, 0.f, 0.f};
#pragma unroll
                for (int ks = 0; ks < 2; ++ks) { ga = MFMA16(gw[jt & 1][2 * ks], xf[ks], ga); gx = MFMA16(gw[jt & 1][2 * ks + 1], xf[ks], gx); }
                const int j = jt * 16 + 4 * fq;
                const f32x4 ba = gp[jt & 1][0], bx = gp[jt & 1][1], sp = gp[jt & 1][2], xc = gp[jt & 1][3];
                f32x4 av, uv;
#pragma unroll
                for (int r = 0; r < 4; ++r) { const float rr = sigmoid_fast(ga[r] + ba[r]), ig = sigmoid_fast(gx[r] + bx[r]), la = -rr * sp[r];
                    av[r] = __builtin_amdgcn_exp2f(1.44269504f * la); uv[r] = __builtin_amdgcn_sqrtf(fmaxf(fmaf(-av[r], av[r], 1.0f), 0.f)) * (ig * xc[r]); }
                *(LAS f32x4*)(AA + tok * LF + j) = av; *(LAS f32x4*)(UU + tok * LF + j) = uv;
                __builtin_amdgcn_sched_barrier(0);
            }
#undef LRU_LOADJ
        }
        LRU_PREF_X(t0 + 128);
        if (spq >= 0) sp_prefetch(sp, c, sh0, sh1);
        if (spq2 >= 0) sp_prefetch(sp2, c, sh2, sh3);
        asm volatile("s_waitcnt lgkmcnt(0)" ::: "memory");
        OPQ_IDX2();
        float cp[16], hl[16]; float pp = 1.f, hh = 0.f;
#pragma unroll
        for (int t = 0; t < 16; ++t) { const float at = AA[(wid * 16 + t) * LF + lane], ut = UU[(wid * 16 + t) * LF + lane]; pp *= at; hh = at * hh + ut; cp[t] = pp; hl[t] = hh; }
        SEGPc[wid * 64 + lane] = pp; SEGHc[wid * 64 + lane] = hh;
        __syncthreads();
        float cin = HC[(c & 1) * 64 + lane];
        {   float sp_[7], sh_[7];
#pragma unroll
            for (int s = 0; s < 7; ++s) { sp_[s] = SEGPc[s * 64 + lane]; sh_[s] = SEGHc[s * 64 + lane]; }
#pragma unroll
            for (int s = 0; s < 7; ++s) { const float nx = sp_[s] * cin + sh_[s]; cin = s < wid ? nx : cin; } }
        const float hlast = hl[15] + cp[15] * cin;
        if (wid == 7) HC[((c + 1) & 1) * 64 + lane] = hlast;
        const int ch = hd * 64 + lane;
        float sq[16];
        {   LAS unsigned char* T_ = lds + LL_A + (wid * 16) * (LF * 4);
            LAS unsigned char* O_ = lds + LL_U + (wid * 16) * (LF * 4);
            const int trq = (fr >> 2) & 3, trp = fr & 3;
            *(LAS v4u*)(T_ + fr * 144 + fq * 32) = pyv[0]; *(LAS v4u*)(T_ + fr * 144 + fq * 32 + 16) = pyv[1];
            asm volatile("s_waitcnt lgkmcnt(0)" ::: "memory");
            v2u yq[4];
#pragma unroll
            for (int tb = 0; tb < 4; ++tb) yq[tb] = LDTR(T_ + (4 * tb + trq) * 144 + (fq * 16 + 4 * trp) * 2);
            unsigned ow[8];
#pragma unroll
            for (int tb = 0; tb < 4; ++tb) {
                const float y0 = bf_lo(yq[tb].x), y1 = bf_hi(yq[tb].x), y2 = bf_lo(yq[tb].y), y3 = bf_hi(yq[tb].y);
                const float g0 = (hl[4 * tb + 0] + cp[4 * tb + 0] * cin) * gelu_tanh_fast(y0), g1 = (hl[4 * tb + 1] + cp[4 * tb + 1] * cin) * gelu_tanh_fast(y1),
                            g2 = (hl[4 * tb + 2] + cp[4 * tb + 2] * cin) * gelu_tanh_fast(y2), g3 = (hl[4 * tb + 3] + cp[4 * tb + 3] * cin) * gelu_tanh_fast(y3);
                sq[4 * tb + 0] = g0 * g0; sq[4 * tb + 1] = g1 * g1; sq[4 * tb + 2] = g2 * g2; sq[4 * tb + 3] = g3 * g3;
                ow[2 * tb] = cvtpk(g0, g1); ow[2 * tb + 1] = cvtpk(g2, g3); }
            *(LAS v4u*)(O_ + lane * 48) = (v4u){ow[0], ow[1], ow[2], ow[3]}; *(LAS v4u*)(O_ + lane * 48 + 16) = (v4u){ow[4], ow[5], ow[6], ow[7]};
            asm volatile("s_waitcnt lgkmcnt(0)" ::: "memory");
            v2u oq[4];
#pragma unroll
            for (int r = 0; r < 4; ++r) oq[r] = LDTR(O_ + (fq * 16 + 4 * r + trq) * 48 + (4 * trp) * 2);
            bf16* yo = P + (rowb + t0 + wid * 16 + fr) * PW + DLRU + hd * 64 + fq * 16;
            *(v4u*)yo = (v4u){oq[0].x, oq[0].y, oq[1].x, oq[1].y}; *(v4u*)(yo + 8) = (v4u){oq[2].x, oq[2].y, oq[3].x, oq[3].y}; }
        {
            float w8[8], w4[4], w2[2], w1;
            const bool u5 = lane & 32, u4 = lane & 16, u3 = lane & 8, u2 = lane & 4;
#pragma unroll
            for (int k = 0; k < 8; ++k) w8[k] = pg8::bfly32(sq[k], sq[k + 8]);
#pragma unroll
            for (int k = 0; k < 4; ++k) w4[k] = pg8::bfly16(w8[k], w8[k + 4]);
#pragma unroll
            for (int k = 0; k < 2; ++k) { const float keep = u3 ? w4[k + 2] : w4[k], send = u3 ? w4[k] : w4[k + 2]; w2[k] = keep + __shfl_xor(send, 8); }
            { const float keep = u2 ? w2[1] : w2[0], send = u2 ? w2[0] : w2[1]; w1 = keep + __shfl_xor(send, 4); }
            w1 += __shfl_xor(w1, 2); w1 += __shfl_xor(w1, 1);
            const int tsel = ((lane >> 5) & 1) * 8 + ((lane >> 4) & 1) * 4 + ((lane >> 3) & 1) * 2 + ((lane >> 2) & 1);
            if ((lane & 3) == 0) SSL[(rowb + t0 + wid * 16 + tsel) * 16 + hd] = w1; }
        if (spq >= 0) sp_step(sp, c, sh0, sh1, lane);
        if (spq2 >= 0) sp_step(sp2, c, sh2, sh3, lane);
        if (c == SEQ / 128 - 1 && wid == 7) a.out[O_PLH + (size_t)b * DLRU + ch] = hlast;
        if (c + 1 < SEQ / 128) { LRU_PREF_Y(t0 + 128); LRU_CONV(); }
    }
    if (spq >= 0) { OPQ_IDX2(); sp_end(sp, lane); }
    if (spq2 >= 0) { OPQ_IDX2(); sp_end(sp2, lane); }
    __syncthreads();
    float dh_[2], dy_[2];
    {   OPQ_IDX2(); const int ch = hd * 64 + lane;
#pragma unroll
        for (int t = 0; t < 2; ++t) { const int sl = wid * 2 + t, sq = 16 * b + sl; dh_[t] = a.in[I_SLH][(size_t)sq * DLRU + ch]; dy_[t] = bf1(P + ((size_t)TP + sq) * PW + DLRU + ch); } }
    if (wid < 2) {   OPQ_IDX2();
        const int cg = tid & 7, sl = tid >> 3, sq = 16 * b + sl, ch0 = hd * 64 + cg * 8;
        ConvW cv; load_convw(cv, a.in[I_LCW], a.in[I_LCB], DLRU, ch0);
        const v4u v = *(const v4u*)(P + ((size_t)TP + sq) * PW + ch0);
        float xn[8]; unpack8(v, xn);
        const float* sb = a.in[I_SLC] + (size_t)sq * 3 * DLRU + ch0; float* so = a.out + O_SLC + (size_t)sq * 3 * DLRU + ch0;
        f32x4 h0[2], h1[2], h2[2];
#pragma unroll
        for (int q = 0; q < 2; ++q) { h0[q] = *(const f32x4*)(sb + 4 * q); h1[q] = *(const f32x4*)(sb + DLRU + 4 * q); h2[q] = *(const f32x4*)(sb + 2 * DLRU + 4 * q); }
        float o[8];
#pragma unroll
        for (int q = 0; q < 8; ++q) o[q] = cv.b[q >> 2][q & 3] + cv.w[0][q >> 2][q & 3] * h0[q >> 2][q & 3] + cv.w[1][q >> 2][q & 3] * h1[q >> 2][q & 3] + cv.w[2][q >> 2][q & 3] * h2[q >> 2][q & 3] + cv.w[3][q >> 2][q & 3] * xn[q];
#pragma unroll
        for (int q = 0; q < 2; ++q) { *(f32x4*)(so + 4 * q) = h1[q]; *(f32x4*)(so + DLRU + 4 * q) = h2[q]; *(f32x4*)(so + 2 * DLRU + 4 * q) = (f32x4){xn[4 * q], xn[4 * q + 1], xn[4 * q + 2], xn[4 * q + 3]}; }
        *(LAS f32x4*)(XF + sl * LF + cg * 8) = (f32x4){o[0], o[1], o[2], o[3]}; *(LAS f32x4*)(XF + sl * LF + cg * 8 + 4) = (f32x4){o[4], o[5], o[6], o[7]};
        *(LAS v4u*)(lds + LL_XC + sl * XS + cg * 16) = (v4u){pg8::cvt_pk_bf16(o[0], o[1]), pg8::cvt_pk_bf16(o[2], o[3]), pg8::cvt_pk_bf16(o[4], o[5]), pg8::cvt_pk_bf16(o[6], o[7])};
    }
    __syncthreads();
    if (wid == 0) {   OPQ_IDX2();
        const int tok = fr;
        bf16x8 xf[2];
#pragma unroll
        for (int ks = 0; ks < 2; ++ks) xf[ks] = *(const LAS bf16x8*)(lds + LL_XC + tok * XS + ks * 64 + fq * 16);
#pragma unroll
        for (int jt = 0; jt < 4; ++jt) {
            f32x4 ga = (f32x4){0.f, 0.f, 0.f, 0.f}, gx = (f32x4){0.f, 0.f, 0.f, 0.f};
#pragma unroll
            for (int ks = 0; ks < 2; ++ks) {
                ga = MFMA16(*(const LAS bf16x8*)(lds + LL_WA + (jt * 16 + fr) * XS + ks * 64 + fq * 16), xf[ks], ga);
                gx = MFMA16(*(const LAS bf16x8*)(lds + LL_WX + (jt * 16 + fr) * XS + ks * 64 + fq * 16), xf[ks], gx); }
            const int j = jt * 16 + 4 * fq;
            const f32x4 ba = *(const LAS f32x4*)(PAR + j), bx = *(const LAS f32x4*)(PAR + 64 + j), sp = *(const LAS f32x4*)(PAR + 128 + j), xc = *(const LAS f32x4*)(XF + tok * LF + j);
            f32x4 av, uv;
#pragma unroll
            for (int r = 0; r < 4; ++r) { const float rr = sigmoid_fast(ga[r] + ba[r]), ig = sigmoid_fast(gx[r] + bx[r]), la = -rr * sp[r];
                av[r] = __builtin_amdgcn_exp2f(1.44269504f * la); uv[r] = __builtin_amdgcn_sqrtf(fmaxf(fmaf(-av[r], av[r], 1.0f), 0.f)) * (ig * xc[r]); }
            *(LAS f32x4*)(AA + tok * LF + j) = av; *(LAS f32x4*)(UU + tok * LF + j) = uv;
        }
    }
    __syncthreads();
    {   OPQ_IDX2();
        const int ch = hd * 64 + lane;
#pragma unroll
        for (int t = 0; t < 2; ++t) { const int sl = wid * 2 + t, sq = 16 * b + sl; const size_t row = (size_t)TP + sq; bf16* yp = P + row * PW + DLRU + ch;
            const float ht = AA[sl * LF + lane] * dh_[t] + UU[sl * LF + lane];
            a.out[O_SLH + (size_t)sq * DLRU + ch] = ht;
            const float gv = ht * gelu_tanh_fast(dy_[t]);
            const float ss = wave_sum(gv * gv);
            *yp = f2bf1(gv);
            if (lane == 0) SSL[row * 16 + hd] = ss; }
    }
    {   OPQ_IDX2();
        for (int i = tid; i < 3 * 64; i += 512) { const int k = i >> 6, ch = hd * 64 + (i & 63);
            a.out[O_PLC + (size_t)(b * 3 + k) * DLRU + ch] = bf1(P + (rowb + SEQ - 3 + k) * PW + ch); }
    }
    __syncthreads();
}

__device__ __forceinline__ void ssd_sample_pair(const Args& a, LAS float* wsc, int s, int h, int lane_in) {
    int lane = lane_in; asm volatile("" : "+v"(lane));
    bf16* P = (bf16*)(a.ws + WS_P); float* SSS = (float*)(a.ws + WS_SSS); const float* DT = (const float*)(a.ws + WS_DT);
    const float* cw = a.in[I_SCW]; const float* cb = a.in[I_SCB]; const float* cs = a.in[I_SSC] + (size_t)s * 3 * DXBC;
    const int g = h >> 3; const size_t row = (size_t)TP + s;
    const float Ah = -expf(a.in[I_SALOG][h]), dtb = a.in[I_SDTB][h], Dh = a.in[I_SD][h];
    float* cso = a.out + O_SSC + (size_t)s * 3 * DXBC;
    float xv = 0.f;
#pragma unroll
    for (int q = 0; q < 5; ++q) {
        const int ch = q == 0 ? h * 64 + lane : (q < 3 ? 1024 : 1280) + g * 128 + lane + ((q - 1) & 1) * 64;
        const float x0 = cs[ch], x1 = cs[DXBC + ch], x2 = cs[2 * DXBC + ch], xn = bf1(P + row * PW + 3072 + ch);
        const float v = cb[ch] + cw[ch] * x0 + cw[DXBC + ch] * x1 + cw[2 * DXBC + ch] * x2 + cw[3 * DXBC + ch] * xn;
        const float sv = silu_fast(v);
        if (q == 0 || (h & 7) == 0) { cso[ch] = x1; cso[DXBC + ch] = x2; cso[2 * DXBC + ch] = xn; }
        if (q == 0) { xv = sv; wsc[lane] = sv; } else wsc[64 + (q - 1) * 64 + lane] = sv;
    }
    const float dt = softplus_f(DT[row * 16 + h] + dtb), dA = exp_fast(dt * Ah);
    LDS_WAIT(); asm volatile("" ::: "memory");
    const int hf = lane >> 5, nq = lane & 31;
    const f32x4 B4 = *(const LAS f32x4*)(wsc + 64 + nq * 4), C4 = *(const LAS f32x4*)(wsc + 192 + nq * 4);
    const f32x4* hin = (const f32x4*)(a.in[I_SSH] + (size_t)(s * NHEAD + h) * 8192) + lane; f32x4* hout = (f32x4*)(a.out + O_SSH + (size_t)(s * NHEAD + h) * 8192) + lane;
    float part[32];
#pragma unroll
    for (int ib = 0; ib < 2; ++ib) {
        f32x4 hv[16];
#pragma unroll
        for (int k = 0; k < 16; ++k) hv[k] = hin[(ib * 16 + k) * 64];
#pragma unroll
        for (int k = 0; k < 16; ++k) { const int it = ib * 16 + k; const float xd = dt * wsc[2 * it + hf];
            const f32x4 hn = hv[k] * dA + B4 * xd; hout[it * 64] = hn;
            part[it] = (C4[0] * hn[0] + C4[1] * hn[1]) + (C4[2] * hn[2] + C4[3] * hn[3]); }
    }
    float r16[16], r8[8], r4[4], r2[2], yv;
    { const bool u = lane & 16;
#pragma unroll
      for (int k = 0; k < 16; ++k) { const float keep = u ? part[k + 16] : part[k], send = u ? part[k] : part[k + 16]; r16[k] = keep + __shfl_xor(send, 16); } }
    { const bool u = lane & 8;
#pragma unroll
      for (int k = 0; k < 8; ++k) { const float keep = u ? r16[k + 8] : r16[k], send = u ? r16[k] : r16[k + 8]; r8[k] = keep + __shfl_xor(send, 8); } }
    { const bool u = lane & 4;
#pragma unroll
      for (int k = 0; k < 4; ++k) { const float keep = u ? r8[k + 4] : r8[k], send = u ? r8[k] : r8[k + 4]; r4[k] = keep + __shfl_xor(send, 4); } }
    { const bool u = lane & 2;
#pragma unroll
      for (int k = 0; k < 2; ++k) { const float keep = u ? r4[k + 2] : r4[k], send = u ? r4[k] : r4[k + 2]; r2[k] = keep + __shfl_xor(send, 2); } }
    { const bool u = lane & 1; const float keep = u ? r2[1] : r2[0], send = u ? r2[0] : r2[1]; yv = keep + __shfl_xor(send, 1); }
    const int itsel = ((lane >> 4) & 1) * 16 + ((lane >> 3) & 1) * 8 + ((lane >> 2) & 1) * 4 + ((lane >> 1) & 1) * 2 + (lane & 1), p = 2 * itsel + hf;
    bf16* zp = P + row * PW + 2048 + h * 64 + p;
    const float y = yv + Dh * wsc[p], gv = y * silu_fast(bf1(zp));
    const float ss = wave_sum(gv * gv);
    *zp = f2bf1(gv);
    if (lane == 0) SSS[row * 16 + h] = ss;
    (void)xv;
    LDS_WAIT(); asm volatile("" ::: "memory");
}

__device__ __forceinline__ void mixer_phase(const Args& a, LAS unsigned char* lds, int vcu, int G, int tid) {
    const int wave = __builtin_amdgcn_readfirstlane(tid >> 6), lane = tid & 63;
    const int half = G / 2;
#if defined(PROBE_MX)
    unsigned long long* tq = (unsigned long long*)(a.ws + WS_CTL + 8192); const bool st_ = ((vcu == 0 || vcu == half) && tid == 0); unsigned long long t0_ = __builtin_amdgcn_s_memrealtime();
#define MSTAMP(k) do { if (st_) { const unsigned long long t1_ = __builtin_amdgcn_s_memrealtime(); tq[(vcu == 0 ? 0 : 4) + (k)] = t1_ - t0_; t0_ = t1_; } } while (0)
#else
#define MSTAMP(k) do { } while (0)
#endif
    const bool fused = (G == 256);
    if (!fused) { for (int q = vcu * NWAVES + wave; q < TS * NHEAD; q += G * NWAVES) ssd_sample_pair(a, (LAS float*)(lds) + wave * 320, q >> 4, q & 15, lane);
        __syncthreads(); }
    MSTAMP(0);
    if (vcu < half) {
        for (int u = vcu; u < NB * NHEAD; u += half) ssd_unit_fast(a, lds, u >> 4, u & 15, tid, wave, lane, -1);
        tr_range(a, lds, IT_WGU2 + 384, IT_WD2, vcu * NWAVES + wave, half * NWAVES, wave, lane);
        MSTAMP(1);
    } else {
        const int v = vcu - half, nv = G - half;
        for (int u = v; u < NB * NHEAD; u += nv) lru_unit_prompt(a, lds, u >> 4, u & 15, tid, wave, fused ? 2 * (v * NWAVES + wave) : -1, fused ? 2 * (v * NWAVES + wave) + 1 : -1);
        MSTAMP(1);
    }
}

__device__ __forceinline__ void norm_phase(const Args& a, int vcu, int G, int wave, int lane) {
    bf16* P = (bf16*)(a.ws + WS_P); const float* SSL = (const float*)(a.ws + WS_SSL); const float* SSS = (const float*)(a.ws + WS_SSS);
    const int gw = vcu * NWAVES + wave, NGW = G * NWAVES;
    for (int m = gw; m < MREAL; m += NGW) {
        float sl = 0.f, s0 = 0.f, s1 = 0.f;
#pragma unroll
        for (int k = 0; k < 16; ++k) sl += SSL[(size_t)m * 16 + k];
#pragma unroll
        for (int k = 0; k < 8; ++k) { s0 += SSS[(size_t)m * 16 + k]; s1 += SSS[(size_t)m * 16 + 8 + k]; }
        const float rl = 1.0f / sqrtf(sl * (1.0f / 1024.0f) + EPS), r0 = 1.0f / sqrtf(s0 * (1.0f / 512.0f) + EPS), r1 = 1.0f / sqrtf(s1 * (1.0f / 512.0f) + EPS);
        GAS v4u* pr = (GAS v4u*)(P + (size_t)m * PW + DLRU) + lane;
#pragma unroll
        for (int j = 0; j < 4; ++j) { const float r = j < 2 ? rl : (j == 2 ? r0 : r1);
            v4u w = pr[64 * j];
            w.x = pk2(bf_lo(w.x) * r, bf_hi(w.x) * r); w.y = pk2(bf_lo(w.y) * r, bf_hi(w.y) * r); w.z = pk2(bf_lo(w.z) * r, bf_hi(w.z) * r); w.w = pk2(bf_lo(w.w) * r, bf_hi(w.w) * r);
            pr[64 * j] = w; }
    }
}

__global__ void __launch_bounds__(NWAVES * 64, 2) fwd_megakernel(Args args) {
    extern __shared__ __attribute__((aligned(16))) unsigned char lds_raw[];
    LAS unsigned char* lds = (LAS unsigned char*)lds_raw;
    volatile LAS unsigned* MISC = (volatile LAS unsigned*)(lds + MISC_OFF);
    const int tid = threadIdx.x, lane = tid & 63, wave = __builtin_amdgcn_readfirstlane(tid >> 6);
    const int G = gridDim.x; const int bx = blockIdx.x; const int vcu = (G % 8 == 0) ? (bx % 8) * (G / 8) + bx / 8 : bx;
    unsigned char* ws = args.ws;
    gu32* ctl = (gu32*)(ws + WS_CTL);
    if (tid < 256) MISC[tid] = 0u;
    __syncthreads();
    XcdBarrier bar = xcd_barrier_post((unsigned*)(ctl + CW_BAR), MISC + 8);
#if defined(PROBE_TS)
#define GRID_BAR(k_) do { xcd_barrier(bar); if (threadIdx.x == 0) { const unsigned long long t_ = __builtin_amdgcn_s_memrealtime(); MISC[16 + 2 * (k_)] = (unsigned)t_; MISC[17 + 2 * (k_)] = (unsigned)(t_ >> 32); } } while (0)
    if (threadIdx.x == 0) { const unsigned long long t_ = __builtin_amdgcn_s_memrealtime(); MISC[16 + 30] = (unsigned)t_; MISC[17 + 30] = (unsigned)(t_ >> 32); }
#else
#define GRID_BAR(k_) xcd_barrier(bar)
#endif
    bf16* const XBF = (bf16*)(ws + WS_XBF); bf16* const PB = (bf16*)(ws + WS_P); bf16* const HB = (bf16*)(ws + WS_P);
    float* const SS0 = (float*)(ws + WS_SS0); float* const SS1 = (float*)(ws + WS_SS1); float* const SS2 = (float*)(ws + WS_SS2);
    float* const DT = (float*)(ws + WS_DT); float* const SSX1 = (float*)(ws + WS_SSX1); float* const SSX2 = (float*)(ws + WS_SSX2);
    const float* const SSLp = (const float*)(ws + WS_SSL); const float* const SSSp = (const float*)(ws + WS_SSS);
#define SMALL_UNITS(...) do { for (int u = vcu; u < 256; u += G) { __VA_ARGS__; } } while (0)
    float* const out = args.out;

    p0_prologue(args, lds, vcu, G, wave, lane);
    GRID_BAR(0);
    { pg8::Gemm g{XBF, (const bf16*)(ws + WS_WGU1), MPAD, NGU, DM, DM}; pg8::StaticOrder S; S.init(MPAD, NGU, G, bx);
      pg8::fill_rstd_table(S, SS0, nullptr, (LAS float*)(lds + RING_BYTES));
      pg8::EpiSwiGLU E{HB, (const LAS float*)(lds + RING_BYTES)};
      pg8::gemm_phase<pg8::EpiSwiGLU, pg8::StaticOrder, true, true>(lds + RING_OFF, g, S, E);
      int nl; const int lr = light_rank(S.nwg, G, bx, nl);
      if (lr >= 0) tr_range(args, lds, IT_WD1, IT_WOUT, lr * NWAVES + wave, nl * NWAVES, wave, lane);
      else if (nl == 0) tr_range(args, lds, IT_WD1, IT_WOUT, vcu * NWAVES + wave, G * NWAVES, wave, lane); }
    GRID_BAR(1);
    if (bx & 1) SMALL_UNITS(small_gemm_resid<false, true>(HB, FF, (const bf16*)(ws + WS_WD1), FF, u, nullptr, XBF, SSX1, 0.5f, nullptr, nullptr, lds, tid));
    { pg8::Gemm g{HB, (const bf16*)(ws + WS_WD1), TP, DM, FF, FF}; pg8::StaticOrder S; S.init(TP, DM, G, bx);
      if (G == 256) { pg8::EpiResidT<false, true, true> E{nullptr, nullptr, XBF, SS1, 0.5f, nullptr};
        pg8::gemm_phase<pg8::EpiResidT<false, true, true>, pg8::StaticOrder, false, true>(lds + RING_OFF, g, S, E); }
      else { pg8::EpiResidT<false, true> E{nullptr, nullptr, XBF, SS1, 0.5f, nullptr};
        pg8::gemm_phase<pg8::EpiResidT<false, true>, pg8::StaticOrder, true, true>(lds + RING_OFF, g, S, E); } }
    if (!(bx & 1)) SMALL_UNITS(small_gemm_resid<false, true>(HB, FF, (const bf16*)(ws + WS_WD1), FF, u, nullptr, XBF, SSX1, 0.5f, nullptr, nullptr, lds, tid));
    GRID_BAR(2);
    { pg8::Gemm g{XBF, (const bf16*)(ws + WS_WIN), MPAD, NINP, DM, DM}; pg8::StaticOrder S; S.init(MPAD, NINP, G, bx);
      pg8::fill_rstd_table(S, SS1, SSX1, (LAS float*)(lds + RING_BYTES));
      pg8::EpiP E{PB, DT, (const LAS float*)(lds + RING_BYTES)};
      pg8::gemm_phase<pg8::EpiP, pg8::StaticOrder, true, true>(lds + RING_OFF, g, S, E);
      int nl; const int lr = light_rank(S.nwg, G, bx, nl);
      if (lr >= 0) tr_range(args, lds, IT_WOUT, IT_WGU2 + 384, lr * NWAVES + wave, nl * NWAVES, wave, lane);
      else if (nl == 0) tr_range(args, lds, IT_WOUT, IT_WGU2 + 384, vcu * NWAVES + wave, G * NWAVES, wave, lane); }
    GRID_BAR(3);
    ssd_prepass(args, vcu, G, tid);
    GRID_BAR(4);
    { int t2 = threadIdx.x; asm volatile("" : "+v"(t2)); mixer_phase(args, lds, vcu, G, t2); }
    GRID_BAR(5);
    if (bx & 1) SMALL_UNITS(small_gemm_resid<true, true>(PB + DLRU, PW, (const bf16*)(ws + WS_WOUT), DMIX, u, nullptr, XBF, SSX2, 1.0f, SSLp, SSSp, lds, tid));
    { pg8::Gemm g{PB + DLRU, (const bf16*)(ws + WS_WOUT), TP, DM, DMIX, PW}; pg8::SegOrder S; S.init(TP, DM, G, bx); S.SSL = SSLp; S.SSS = SSSp; S.tab = (LAS float*)(lds + RING_BYTES);
      pg8::EpiResidT<true, true, true> E{nullptr, nullptr, XBF, SS2, 1.0f, (const LAS float*)(lds + RING_BYTES)};
      pg8::gemm_phase<pg8::EpiResidT<true, true, true>, pg8::SegOrder, false, true>(lds + RING_OFF, g, S, E); }
    if (!(bx & 1)) SMALL_UNITS(small_gemm_resid<true, true>(PB + DLRU, PW, (const bf16*)(ws + WS_WOUT), DMIX, u, nullptr, XBF, SSX2, 1.0f, SSLp, SSSp, lds, tid));
    GRID_BAR(6);
    { pg8::Gemm g{XBF, (const bf16*)(ws + WS_WGU2), MPAD, NGU, DM, DM}; pg8::StaticOrder S; S.init(MPAD, NGU, G, bx);
      pg8::fill_rstd_table(S, SS2, SSX2, (LAS float*)(lds + RING_BYTES));
      pg8::EpiSwiGLU E{HB, (const LAS float*)(lds + RING_BYTES)};
      pg8::gemm_phase<pg8::EpiSwiGLU, pg8::StaticOrder, true, true>(lds + RING_OFF, g, S, E);
      int nl; const int lr = light_rank(S.nwg, G, bx, nl);
      if (lr >= 0) tr_range(args, lds, IT_WD2, IT_END, lr * NWAVES + wave, nl * NWAVES, wave, lane);
      else if (nl == 0) tr_range(args, lds, IT_WD2, IT_END, vcu * NWAVES + wave, G * NWAVES, wave, lane); }
    GRID_BAR(7);
    if (bx & 1) SMALL_UNITS(small_gemm_resid<false, true>(HB, FF, (const bf16*)(ws + WS_WD2), FF, u, nullptr, XBF, SSX1, 0.5f, nullptr, nullptr, lds, tid));
    { pg8::Gemm g{HB, (const bf16*)(ws + WS_WD2), TP, DM, FF, FF}; pg8::StaticOrder S; S.init(TP, DM, G, bx);
      if (G == 256) { pg8::EpiResidT<false, true, true> E{nullptr, nullptr, XBF, SS0, 0.5f, nullptr};
        pg8::gemm_phase<pg8::EpiResidT<false, true, true>, pg8::StaticOrder, false, true>(lds + RING_OFF, g, S, E); }
      else { pg8::EpiResidT<false, true> E{nullptr, nullptr, XBF, SS0, 0.5f, nullptr};
        pg8::gemm_phase<pg8::EpiResidT<false, true>, pg8::StaticOrder, true, true>(lds + RING_OFF, g, S, E); } }
    if (!(bx & 1)) SMALL_UNITS(small_gemm_resid<false, true>(HB, FF, (const bf16*)(ws + WS_WD2), FF, u, nullptr, XBF, SSX1, 0.5f, nullptr, nullptr, lds, tid));
    GRID_BAR(8);
    { int t2 = threadIdx.x; asm volatile("" : "+v"(t2)); p9_final_norm(args, vcu, G, __builtin_amdgcn_readfirstlane(t2 >> 6), t2 & 63); }
#if defined(PROBE_TS)
    GRID_BAR(9);
    if (blockIdx.x == 0) {
        __syncthreads();
        const size_t offs[10] = {O_YP, O_YS, O_PLC, O_PLH, O_PSC, O_PSH, O_SLC, O_SLH, O_SSC, O_SSH};
        const int phs[10] = {5, 2, 3, 6, 8, 1, 9, 0, 7, 4};
#pragma unroll
        for (int k = 0; k < 10; ++k) { const int ph = phs[k], pp = ph == 0 ? 15 : ph - 1;
            unsigned long long t1, t0;
            if (ph >= 0) { t1 = ((unsigned long long)MISC[17 + 2 * ph] << 32) | MISC[16 + 2 * ph]; t0 = ((unsigned long long)MISC[17 + 2 * pp] << 32) | MISC[16 + 2 * pp]; }
            else { const int q = -ph - 1, call = q < 2 ? 1 : (q < 4 ? 3 : 0), j = q & 1;
                t1 = ((unsigned long long)MISC[65 + 6 * call + 2 * (j + 1)] << 32) | MISC[64 + 6 * call + 2 * (j + 1)]; t0 = ((unsigned long long)MISC[65 + 6 * call + 2 * j] << 32) | MISC[64 + 6 * call + 2 * j]; }
            const float tt_ = (float)(t1 - t0) * 0.1f; const bool big_ = (k == 0 || k == 9);
            const int n = big_ ? (int)((t1 - t0) / 50ull) : (int)(logf(fmaxf(tt_, 1.0f)) * 20.4959f + 0.5f); unsigned* o = (unsigned*)(args.out + offs[k]);
            int ti_ = threadIdx.x; asm volatile("" : "+v"(ti_)); for (int i = ti_; i < n && i < 8000; i += 512) o[i] = 0xAAAAAAAAu; }
    }
#endif
}

extern "C" void kernel_launch(void* const* d_in, const int* in_sizes, int n_in, void* d_out, int out_size, void* d_ws, size_t ws_size, hipStream_t stream) {
    static int grid = 0;
    if (grid == 0) {
        if (n_in != 32 || in_sizes[0] != TP * DM || (size_t)out_size != O_END || ws_size < WS_END) {
            fprintf(stderr, "kernel_launch: unexpected shapes: n_in %d, in0 %d, out %d, ws %zu (need >= %zu); nothing launched\n", n_in, n_in > 0 ? in_sizes[0] : -1, out_size, ws_size, (size_t)WS_END); grid = -1; return; }
        int dev = 0, cus = 0, per_cu = 0;
        if (hipGetDevice(&dev) != hipSuccess || hipDeviceGetAttribute(&cus, hipDeviceAttributeMultiprocessorCount, dev) != hipSuccess) { fprintf(stderr, "kernel_launch: device query failed\n"); grid = -1; return; }
        if (hipFuncSetAttribute((const void*)fwd_megakernel, hipFuncAttributeMaxDynamicSharedMemorySize, LDS_BYTES) != hipSuccess) { fprintf(stderr, "kernel_launch: hipFuncSetAttribute failed\n"); grid = -1; return; }
        if (hipOccupancyMaxActiveBlocksPerMultiprocessor(&per_cu, (const void*)fwd_megakernel, NWAVES * 64, LDS_BYTES) != hipSuccess || per_cu < 1) {
            fprintf(stderr, "kernel_launch: occupancy query says %d workgroups per CU\n", per_cu); per_cu = 1; }
        (void)hipGetLastError();
        grid = cus;
        fprintf(stderr, "kernel_launch: grid %d (occupancy query %d per CU), ws %zu\n", grid, per_cu, ws_size);
    }
    if (grid < 0) return;
    (void)hipMemsetAsync((char*)d_ws + WS_CTL, 0, 65536, stream);
    Args a{};
    for (int i = 0; i < 32; ++i) a.in[i] = (const float*)d_in[i];
    a.out = (float*)d_out; a.ws = (unsigned char*)d_ws;
    hipLaunchKernelGGL(fwd_megakernel, dim3(grid), dim3(NWAVES * 64), LDS_BYTES, stream, a);
}
```

```cpp
#include <hip/hip_runtime.h>
#include <cstdio>
#include <cstdint>

constexpr int TP = 16384;
constexpr int TS = 128;
constexpr int MREAL = TP + TS;
constexpr int MPAD = 16640;
constexpr int DM = 1024, FF = 2816, NGU = 2 * FF, NIN = 4624, NINP = 4864, PW = 4608, DMIX = 2048;
constexpr int SEQ = 2048, NB = 8, DLRU = 1024, DXBC = 1536, NHEAD = 16;
constexpr float EPS = 1e-6f;

namespace pg8 {
#define PG8_LAS __attribute__((address_space(3)))
typedef unsigned short bf16_t;
typedef short bf16x8 __attribute__((ext_vector_type(8)));
typedef float f32x4 __attribute__((ext_vector_type(4)));
typedef unsigned u32x4 __attribute__((ext_vector_type(4)));
typedef unsigned u32x2 __attribute__((ext_vector_type(2)));
constexpr int BM = 256, BK = 64, HALF = 128, HTB = HALF * BK * 2  , STAGE_BYTES = 8 * HTB, NXCD = 8, WGM = 8;

__host__ __device__ __forceinline__ int lds_byte(int r, int c) { const int st = (r >> 4) * 2 + (c >> 5), rr = r & 15, cc = c & 31, ob = rr * 64 + cc * 2; return st * 1024 + (ob ^ (((ob >> 9) & 1) << 5)); }
__host__ __device__ __forceinline__ void stage_rc(int b, int& R, int& C) { const int st = b / 1024, sb = b % 1024, swz = sb ^ (((sb >> 9) & 1) << 5); R = (st >> 1) * 16 + swz / 64; C = (st & 1) * 32 + (swz % 64) / 2; }
__host__ __device__ __forceinline__ int perm32(int rho) { const int n = rho >> 4, i = rho & 15; return 8 * (i >> 2) + 4 * n + (i & 3); }

struct Unit { int pm, pn, ui; };
struct Gemm { const bf16_t* A; const bf16_t* Bt; int M, N, K, lda; };

struct StaticOrder {
    int nM, nN, nwg, G, c;
    __host__ __device__ void init(int M, int N, int G_, int c_) { nM = M / BM; nN = N / BM; nwg = nM * nN; G = G_; c = c_; }
    __host__ __device__ bool next(int i, Unit& u) const {
        const long L = (long)i * G + c; if (L >= nwg) return false;
        int wgid = (int)L; { const int q = nwg / NXCD, r = nwg % NXCD, xcd = wgid % NXCD, off = wgid / NXCD; wgid = (xcd < r ? xcd * (q + 1) : r * (q + 1) + (xcd - r) * q) + off; }
        const int nig = WGM * nN, gid = wgid / nig, fm = gid * WGM, gsz = (nM - fm) < WGM ? (nM - fm) : WGM;
        u.pm = fm + ((wgid % nig) % gsz); u.pn = (wgid % nig) / gsz; u.ui = i; return true;
    }
    __device__ __forceinline__ void a_ready(const Unit&) const {}
    __device__ __forceinline__ void done(const Unit&) const {}
};

typedef __bf16 bf16v2 __attribute__((ext_vector_type(2)));
typedef float f32v2 __attribute__((ext_vector_type(2)));
__device__ __forceinline__ unsigned cvt_pk_bf16(float lo, float hi) { const f32v2 v = {lo, hi}; return __builtin_bit_cast(unsigned, __builtin_convertvector(v, bf16v2)); }
__device__ __forceinline__ float bfly16(float a, float b) { const auto r = __builtin_amdgcn_permlane16_swap(__builtin_bit_cast(unsigned, a), __builtin_bit_cast(unsigned, b), false, false);
    return __builtin_bit_cast(float, (unsigned)r[0]) + __builtin_bit_cast(float, (unsigned)r[1]); }
__device__ __forceinline__ float bfly32(float a, float b) { const auto r = __builtin_amdgcn_permlane32_swap(__builtin_bit_cast(unsigned, a), __builtin_bit_cast(unsigned, b), false, false);
    return __builtin_bit_cast(float, (unsigned)r[0]) + __builtin_bit_cast(float, (unsigned)r[1]); }
__device__ __forceinline__ float silu_f(float x) { return x * __builtin_amdgcn_rcpf(1.0f + __builtin_amdgcn_exp2f(-1.44269504f * x)); }
__device__ __forceinline__ float rstd16(const float* ss) {
    const f32x4 a = *(const f32x4*)ss, b = *(const f32x4*)(ss + 4), c = *(const f32x4*)(ss + 8), d = *(const f32x4*)(ss + 12);
    const float s = (((a[0] + a[1]) + (a[2] + a[3])) + ((b[0] + b[1]) + (b[2] + b[3]))) + (((c[0] + c[1]) + (c[2] + c[3])) + ((d[0] + d[1]) + (d[2] + d[3])));
    return __builtin_amdgcn_rsqf(s * (1.0f / 1024.0f) + EPS);
}

__device__ __forceinline__ float rstd_row(const float* SS, const float* SSX, int row) {
    if (SSX != nullptr && row >= TP) { const float* p = SSX + (size_t)(row - TP) * 64; float s = 0.f;
#pragma unroll
        for (int k = 0; k < 16; ++k) { const f32x4 a = *(const f32x4*)(p + 4 * k); s += (a[0] + a[1]) + (a[2] + a[3]); }
        return __builtin_amdgcn_rsqf(s * (1.0f / 1024.0f) + EPS); }
    return rstd16(SS + (size_t)row * 16);
}

template <class Sched> __device__ __forceinline__ void fill_rstd_table(const Sched& S, const float* SS, const float* SSX, PG8_LAS float* tab) {
    int t = threadIdx.x; asm volatile("" : "+v"(t));
    const int r = t & 255, i0 = t >> 8;
    int row[4]; bool ok[4]; f32x4 q[4][4];
#pragma unroll
    for (int k = 0; k < 4; ++k) { Unit u; ok[k] = (i0 + 2 * k < 8) && S.next(i0 + 2 * k, u); row[k] = ok[k] ? u.pm * BM + r : 0; }
#pragma unroll
    for (int k = 0; k < 4; ++k) if (ok[k] && !(SSX != nullptr && row[k] >= TP)) { const float* ss = SS + (size_t)row[k] * 16;
        q[k][0] = *(const f32x4*)ss; q[k][1] = *(const f32x4*)(ss + 4); q[k][2] = *(const f32x4*)(ss + 8); q[k][3] = *(const f32x4*)(ss + 12); }
#pragma unroll
    for (int k = 0; k < 4; ++k) if (ok[k]) {
        float v;
        if (SSX != nullptr && row[k] >= TP) v = rstd_row(SS, SSX, row[k]);
        else { const f32x4 a = q[k][0], b = q[k][1], c = q[k][2], d = q[k][3];
            const float s = (((a[0] + a[1]) + (a[2] + a[3])) + ((b[0] + b[1]) + (b[2] + b[3]))) + (((c[0] + c[1]) + (c[2] + c[3])) + ((d[0] + d[1]) + (d[2] + d[3])));
            v = __builtin_amdgcn_rsqf(s * (1.0f / 1024.0f) + EPS); }
        tab[(i0 + 2 * k) * 256 + r] = v; }
    __syncthreads();
}


struct EpiSwiGLU {
    static constexpr bool PERM = true, AFTER_DRAIN = false, KSEG = false;
    bf16_t* H; const PG8_LAS float* tab;
    __device__ __forceinline__ void operator()(const f32x4 (&acc)[2][2][4][2], const Unit& u, int wr, int wc, int fr, int fq) const {
        const int row0 = u.pm * BM + wr * 64 + fr, col0 = u.pn * HALF + wc * 32 + 8 * fq;
#pragma unroll
        for (int ai = 0; ai < 2; ++ai)
#pragma unroll
            for (int m = 0; m < 4; ++m) {
                const int row = row0 + ai * HALF + m * 16;
                const float rs = tab[u.ui * 256 + (row - u.pm * BM)];
                float hv[8];
#pragma unroll
                for (int n = 0; n < 2; ++n)
#pragma unroll
                    for (int j = 0; j < 4; ++j) hv[4 * n + j] = silu_f(acc[ai][0][m][n][j] * rs) * (acc[ai][1][m][n][j] * rs);
                u32x4 w; w.x = cvt_pk_bf16(hv[0], hv[1]); w.y = cvt_pk_bf16(hv[2], hv[3]); w.z = cvt_pk_bf16(hv[4], hv[5]); w.w = cvt_pk_bf16(hv[6], hv[7]);
                *(u32x4*)(H + (size_t)row * FF + col0) = w;
            }
    }
};
template <bool KSEG_, bool BBF_, bool DRAIN_ = false> struct EpiResidT {
    static constexpr bool PERM = true, AFTER_DRAIN = DRAIN_, KSEG = KSEG_;
    const float* basep; const float* bases; bf16_t* xbf; float* SSo; float scale; const PG8_LAS float* tab;
    __device__ __forceinline__ void rescale(f32x4 (&acc)[2][2][4][2], int which, int wr, int fr) const {
#pragma unroll
        for (int ai = 0; ai < 2; ++ai)
#pragma unroll
            for (int m = 0; m < 4; ++m) { const float f = tab[(ai * HALF + wr * 64 + m * 16 + fr) * 4 + which];
#pragma unroll
                for (int bj = 0; bj < 2; ++bj)
#pragma unroll
                    for (int n = 0; n < 2; ++n) acc[ai][bj][m][n] = acc[ai][bj][m][n] * f; }
    }
    __device__ __forceinline__ void finish_group(const f32x4 (&acc)[2][2][4][2], const Unit& u, int ai, int m, int wr, int wc, int fr, int fq, const f32x4 (&b)[2][2]) const {
        const int row = u.pm * BM + ai * HALF + wr * 64 + m * 16 + fr; const bool real = row < MREAL;
        const float sc = KSEG_ ? scale * tab[(ai * HALF + wr * 64 + m * 16 + fr) * 4 + 2] : scale;
        float ss = 0.f;
#pragma unroll
        for (int bj = 0; bj < 2; ++bj) {
            f32x4 v0 = b[bj][0] + acc[ai][bj][m][0] * sc, v1 = b[bj][1] + acc[ai][bj][m][1] * sc;
            if (!real) { v0 = (f32x4){0.f, 0.f, 0.f, 0.f}; v1 = v0; }
            ss += ((v0[0] * v0[0] + v0[1] * v0[1]) + (v0[2] * v0[2] + v0[3] * v0[3])) + ((v1[0] * v1[0] + v1[1] * v1[1]) + (v1[2] * v1[2] + v1[3] * v1[3]));
            u32x4 w; w.x = cvt_pk_bf16(v0[0], v0[1]); w.y = cvt_pk_bf16(v0[2], v0[3]); w.z = cvt_pk_bf16(v1[0], v1[1]); w.w = cvt_pk_bf16(v1[2], v1[3]);
            *(u32x4*)(xbf + (size_t)row * DM + u.pn * BM + bj * HALF + wc * 32 + 8 * fq) = w; }
        ss = bfly16(ss, ss); ss = bfly32(ss, ss);
        if (fq == 0) SSo[(size_t)row * 16 + u.pn * 4 + wc] = ss;
    }
    __device__ __forceinline__ void unpack_bf(const u32x4 w, f32x4 (&b)[2]) const {
        b[0] = (f32x4){__uint_as_float(w.x << 16), __uint_as_float(w.x & 0xffff0000u), __uint_as_float(w.y << 16), __uint_as_float(w.y & 0xffff0000u)};
        b[1] = (f32x4){__uint_as_float(w.z << 16), __uint_as_float(w.z & 0xffff0000u), __uint_as_float(w.w << 16), __uint_as_float(w.w & 0xffff0000u)}; }
    __device__ __forceinline__ void operator()(const f32x4 (&acc)[2][2][4][2], const Unit& u, int wr, int wc, int fr, int fq) const {
#pragma unroll
        for (int ai = 0; ai < 2; ++ai)
#pragma unroll
            for (int m = 0; m < 4; ++m) {
                const int row = u.pm * BM + ai * HALF + wr * 64 + m * 16 + fr; const int rr = row < MREAL ? row : 0;
                const float* brow = rr < TP ? basep + (size_t)rr * DM : bases + (size_t)(rr - TP) * DM;
                f32x4 b[2][2];
#pragma unroll
                for (int bj = 0; bj < 2; ++bj) { const int col = u.pn * BM + bj * HALF + wc * 32 + 8 * fq;
                    if (BBF_) unpack_bf(*(const u32x4*)(xbf + (size_t)row * DM + col), b[bj]);
                    else { b[bj][0] = *(const f32x4*)(brow + col); b[bj][1] = *(const f32x4*)(brow + col + 4); } }
                finish_group(acc, u, ai, m, wr, wc, fr, fq, b);
            }
    }
    __device__ __forceinline__ void fused(const f32x4 (&acc)[2][2][4][2], const Unit& u, int wr, int wc, int fr, int fq, PG8_LAS unsigned char*, int, int) const {
        static_assert(!DRAIN_ || BBF_, "the drained epilogue preloads a bf16 residual tile");
        u32x4 pre[2][4][2];
#pragma unroll
        for (int ai = 0; ai < 2; ++ai)
#pragma unroll
            for (int m = 0; m < 4; ++m)
#pragma unroll
                for (int bj = 0; bj < 2; ++bj) pre[ai][m][bj] = *(const u32x4*)(xbf + (size_t)(u.pm * BM + ai * HALF + wr * 64 + m * 16 + fr) * DM + u.pn * BM + bj * HALF + wc * 32 + 8 * fq);
#pragma unroll
        for (int ai = 0; ai < 2; ++ai)
#pragma unroll
            for (int m = 0; m < 4; ++m) { f32x4 b[2][2]; unpack_bf(pre[ai][m][0], b[0]); unpack_bf(pre[ai][m][1], b[1]); finish_group(acc, u, ai, m, wr, wc, fr, fq, b); }
    }
};
struct SegOrder : StaticOrder {
    const float* SSL; const float* SSS; PG8_LAS float* tab;
    __device__ __forceinline__ void a_ready(const Unit& u) const {
        const int t = threadIdx.x;
        if (t < 256) { const size_t row = (size_t)u.pm * BM + t; float sl = 0.f, s0 = 0.f, s1 = 0.f;
#pragma unroll
            for (int k = 0; k < 4; ++k) { const f32x4 a = *(const f32x4*)(SSL + row * 16 + 4 * k); sl += (a[0] + a[1]) + (a[2] + a[3]); }
#pragma unroll
            for (int k = 0; k < 2; ++k) { const f32x4 a = *(const f32x4*)(SSS + row * 16 + 4 * k), b = *(const f32x4*)(SSS + row * 16 + 8 + 4 * k); s0 += (a[0] + a[1]) + (a[2] + a[3]); s1 += (b[0] + b[1]) + (b[2] + b[3]); }
            const float r0 = 1.0f / sqrtf(sl * (1.0f / 1024.0f) + EPS), r1 = 1.0f / sqrtf(s0 * (1.0f / 512.0f) + EPS), r2 = 1.0f / sqrtf(s1 * (1.0f / 512.0f) + EPS);
            *(PG8_LAS f32x4*)(tab + t * 4) = (f32x4){r0 / r1, r1 / r2, r2, 0.f}; }
        asm volatile("s_waitcnt lgkmcnt(0)" ::: "memory"); __builtin_amdgcn_s_barrier(); asm volatile("" ::: "memory");
    }
};
struct EpiP {
    static constexpr bool PERM = true, AFTER_DRAIN = false, KSEG = false;
    bf16_t* P; float* DT; const PG8_LAS float* tab;
    __device__ __forceinline__ void operator()(const f32x4 (&acc)[2][2][4][2], const Unit& u, int wr, int wc, int fr, int fq) const {
        const int row0 = u.pm * BM + wr * 64 + fr;
#pragma unroll
        for (int ai = 0; ai < 2; ++ai)
#pragma unroll
            for (int m = 0; m < 4; ++m) {
                const int row = row0 + ai * HALF + m * 16;
                const float rs = tab[u.ui * 256 + (row - u.pm * BM)];
                if (u.pn < 18) {
#pragma unroll
                    for (int bj = 0; bj < 2; ++bj) {
                        const f32x4 v0 = acc[ai][bj][m][0] * rs, v1 = acc[ai][bj][m][1] * rs;
                        u32x4 w; w.x = cvt_pk_bf16(v0[0], v0[1]); w.y = cvt_pk_bf16(v0[2], v0[3]); w.z = cvt_pk_bf16(v1[0], v1[1]); w.w = cvt_pk_bf16(v1[2], v1[3]);
                        *(u32x4*)(P + (size_t)row * PW + u.pn * BM + bj * HALF + wc * 32 + 8 * fq) = w;
                    }
                } else if (wc == 0 && fq < 2) {
                    *(f32x4*)(DT + (size_t)row * 16 + 8 * fq) = acc[ai][0][m][0] * rs;
                    *(f32x4*)(DT + (size_t)row * 16 + 8 * fq + 4) = acc[ai][0][m][1] * rs;
                }
            }
    }
};

template <class Epi, class Sched, bool ALIGN_EPI = false, bool SP2 = false>
__device__ __forceinline__ void gemm_phase(PG8_LAS unsigned char* lds, const Gemm g, const Sched& S, const Epi& E) {
    int tid_ = threadIdx.x; asm volatile("" : "+v"(tid_));
    const int tid = tid_, wid = __builtin_amdgcn_readfirstlane(tid >> 6), lane = tid & 63, wr = wid >> 2, wc = wid & 3, fr = lane & 15, fq = lane >> 4;
    const int K = g.K, nt = K / BK;
    unsigned voffA[2], voffB[2];
#pragma unroll
    for (int i = 0; i < 2; ++i) { int R, C; stage_rc(tid * 16 + i * 8192, R, C); const int Rb = Epi::PERM ? ((R & ~31) + perm32(R & 31)) : R;
        voffA[i] = (unsigned)(R * g.lda + C) * 2u; voffB[i] = (unsigned)(Rb * K + C) * 2u; }
    const size_t kstep = (size_t)(BK * 2);
    const size_t hstepA = (size_t)HALF * g.lda * 2, hstepB = (size_t)HALF * K * 2;
    const size_t tstepA = 2 * hstepA, tstepB = 2 * hstepB;
    const unsigned ldsw = (unsigned)wid * 1024u;
    const int aoff = lds_byte(wr * 64 + fr, fq * 8), boff = lds_byte(wc * 32 + fr, fq * 8);
#define PG8_SA(b, h) (((b) * 2 + (h)) * HTB)
#define PG8_SB(b, h) ((4 + (b) * 2 + (h)) * HTB)
#define PG8_STAGE(bufoff, gbase, voff) do { _Pragma("unroll") for (int _i = 0; _i < 2; ++_i) \
        __builtin_amdgcn_global_load_lds((const unsigned*)((const char*)(gbase) + (voff)[_i]), (PG8_LAS unsigned*)(lds + (bufoff) + ldsw + _i * 8192), 16, 0, 0); } while (0)
#define PG8_LDA(dst, b, h) do { _Pragma("unroll") for (int m = 0; m < 4; ++m) _Pragma("unroll") for (int k = 0; k < 2; ++k) dst[m][k] = *(const PG8_LAS bf16x8*)(lds + PG8_SA(b, h) + aoff + m * 2048 + k * 1024); } while (0)
#define PG8_LDB(dst, b, h) do { _Pragma("unroll") for (int n = 0; n < 2; ++n) _Pragma("unroll") for (int k = 0; k < 2; ++k) dst[n][k] = *(const PG8_LAS bf16x8*)(lds + PG8_SB(b, h) + boff + n * 2048 + k * 1024); } while (0)
#define PG8_MMA(ai, bj, At, Bt) do { __builtin_amdgcn_s_setprio(1); _Pragma("unroll") for (int m = 0; m < 4; ++m) _Pragma("unroll") for (int n = 0; n < 2; ++n) _Pragma("unroll") for (int k = 0; k < 2; ++k) \
        acc[ai][bj][m][n] = __builtin_amdgcn_mfma_f32_16x16x32_bf16(Bt[n][k], At[m][k], acc[ai][bj][m][n], 0, 0, 0); __builtin_amdgcn_s_setprio(0); } while (0)
#define PG8_WAIT_V(n) asm volatile("s_waitcnt vmcnt(" #n ")" ::: "memory")
#define PG8_WAIT_L(n) asm volatile("s_waitcnt lgkmcnt(" #n ")" ::: "memory")
#define PG8_BAR __builtin_amdgcn_s_barrier()
#define PG8_SCHED __builtin_amdgcn_sched_barrier(0)
#if defined(PROBE_GEMM)
#define PG8_PSTAMP(j_) do { if (blockIdx.x == 0 && threadIdx.x == 0) { volatile PG8_LAS unsigned* ms_ = (volatile PG8_LAS unsigned*)(lds + (163840 - 1024)); const unsigned ix_ = ms_[60]; const unsigned long long t_ = __builtin_amdgcn_s_memrealtime(); \
        ms_[64 + 6 * ix_ + 2 * (j_)] = (unsigned)t_; ms_[65 + 6 * ix_ + 2 * (j_)] = (unsigned)(t_ >> 32); if ((j_) == 2) ms_[60] = ix_ + 1; } } while (0)
#else
#define PG8_PSTAMP(j_) do { } while (0)
#endif
    Unit cur, nxt; int ui = 0;
    if (!S.next(0, cur)) return;
    PG8_PSTAMP(0);
    f32x4 acc[2][2][4][2];
#pragma unroll
    for (int a = 0; a < 2; ++a)
#pragma unroll
        for (int b = 0; b < 2; ++b)
#pragma unroll
            for (int m = 0; m < 4; ++m)
#pragma unroll
                for (int n = 0; n < 2; ++n) acc[a][b][m][n] = (f32x4){0.f, 0.f, 0.f, 0.f};
    bf16x8 At[4][2], B0[2][2], B1[2][2];
    const char* cA = (const char*)g.A + (size_t)cur.pm * tstepA; const char* cB = (const char*)g.Bt + (size_t)cur.pn * tstepB;
    S.a_ready(cur);
    if constexpr (SP2) {
        PG8_STAGE(PG8_SB(0, 0), cB, voffB); PG8_STAGE(PG8_SB(0, 1), cB + hstepB, voffB); PG8_STAGE(PG8_SA(0, 0), cA, voffA); PG8_STAGE(PG8_SA(0, 1), cA + hstepA, voffA);
        if (wr == 1) PG8_BAR;
        PG8_WAIT_V(2); PG8_BAR;
        PG8_STAGE(PG8_SB(1, 0), cB + kstep, voffB); PG8_STAGE(PG8_SA(1, 0), cA + kstep, voffA); PG8_STAGE(PG8_SB(1, 1), cB + hstepB + kstep, voffB);
        PG8_WAIT_V(6); PG8_BAR;
    } else {
        PG8_STAGE(PG8_SB(0, 0), cB, voffB); PG8_STAGE(PG8_SA(0, 0), cA, voffA); PG8_STAGE(PG8_SB(0, 1), cB + hstepB, voffB); PG8_STAGE(PG8_SA(0, 1), cA + hstepA, voffA);
        if (wr == 1) PG8_BAR;
        PG8_WAIT_V(4); PG8_BAR;
        PG8_STAGE(PG8_SB(1, 0), cB + kstep, voffB); PG8_STAGE(PG8_SA(1, 0), cA + kstep, voffA); PG8_STAGE(PG8_SB(1, 1), cB + hstepB + kstep, voffB);
        PG8_WAIT_V(6); PG8_BAR;
    }
    for (;;) {
        const bool has_next = S.next(ui + 1, nxt);
        const char* nA = has_next ? (const char*)g.A + (size_t)nxt.pm * tstepA : cA; const char* nB = has_next ? (const char*)g.Bt + (size_t)nxt.pn * tstepB : cB;
        for (int t = 0; t < nt; t += 2) {
            if constexpr (Epi::KSEG) { if (t == 16 || t == 24) E.rescale(acc, t == 16 ? 0 : 1, wr, fr); }
            const bool last = (t == nt - 2);
            const char* a1 = cA + (size_t)(t + 1) * kstep;
            const char* a2 = last ? nA : cA + (size_t)(t + 2) * kstep; const char* b2 = last ? nB : cB + (size_t)(t + 2) * kstep;
            const char* a3 = a2 + kstep; const char* b3 = b2 + kstep;
            if (last && has_next) S.a_ready(nxt);
            if constexpr (SP2) {
            PG8_LDB(B0, 0, 0); PG8_LDB(B1, 0, 1); PG8_SCHED; PG8_LDA(At, 0, 0); PG8_STAGE(PG8_SA(1, 1), a1 + hstepA, voffA);
            PG8_WAIT_V(8); PG8_WAIT_L(0); PG8_BAR; PG8_MMA(0, 0, At, B0); PG8_MMA(0, 1, At, B1); PG8_BAR; PG8_SCHED;
            PG8_LDA(At, 0, 1); PG8_STAGE(PG8_SB(0, 0), b2, voffB); PG8_STAGE(PG8_SB(0, 1), b2 + hstepB, voffB); PG8_STAGE(PG8_SA(0, 0), a2, voffA);
            PG8_WAIT_V(8); PG8_WAIT_L(0); PG8_BAR; PG8_MMA(1, 0, At, B0); PG8_MMA(1, 1, At, B1); PG8_BAR; PG8_SCHED;
            PG8_LDB(B0, 1, 0); PG8_LDB(B1, 1, 1); PG8_SCHED; PG8_LDA(At, 1, 0); PG8_STAGE(PG8_SA(0, 1), a2 + hstepA, voffA);
            PG8_WAIT_V(8); PG8_WAIT_L(0); PG8_BAR; PG8_MMA(0, 0, At, B0); PG8_MMA(0, 1, At, B1); PG8_BAR; PG8_SCHED;
            PG8_LDA(At, 1, 1); PG8_STAGE(PG8_SB(1, 0), b3, voffB); PG8_STAGE(PG8_SB(1, 1), b3 + hstepB, voffB); PG8_STAGE(PG8_SA(1, 0), a3, voffA);
            PG8_WAIT_V(8); PG8_WAIT_L(0); PG8_BAR; PG8_MMA(1, 0, At, B0); PG8_MMA(1, 1, At, B1); PG8_BAR; PG8_SCHED;
            } else {
            PG8_LDB(B0, 0, 0); PG8_SCHED; PG8_LDA(At, 0, 0); PG8_STAGE(PG8_SA(1, 1), a1 + hstepA, voffA);
            PG8_WAIT_L(8); PG8_BAR; PG8_WAIT_L(0); PG8_MMA(0, 0, At, B0); PG8_BAR; PG8_SCHED;
            PG8_LDB(B1, 0, 1); PG8_STAGE(PG8_SB(0, 0), b2, voffB);
            PG8_BAR; PG8_WAIT_L(0); PG8_MMA(0, 1, At, B1); PG8_BAR;
            PG8_LDA(At, 0, 1); PG8_STAGE(PG8_SA(0, 0), a2, voffA);
            PG8_BAR; PG8_WAIT_L(0); PG8_MMA(1, 0, At, B0); PG8_BAR; PG8_SCHED;
            PG8_STAGE(PG8_SB(0, 1), b2 + hstepB, voffB);
            PG8_WAIT_V(6); PG8_BAR; PG8_MMA(1, 1, At, B1); PG8_BAR;
            PG8_LDB(B0, 1, 0); PG8_SCHED; PG8_LDA(At, 1, 0); PG8_STAGE(PG8_SA(0, 1), a2 + hstepA, voffA);
            PG8_WAIT_L(8); PG8_BAR; PG8_WAIT_L(0); PG8_MMA(0, 0, At, B0); PG8_BAR; PG8_SCHED;
            PG8_LDB(B1, 1, 1); PG8_STAGE(PG8_SB(1, 0), b3, voffB);
            PG8_BAR; PG8_WAIT_L(0); PG8_MMA(0, 1, At, B1); PG8_BAR;
            PG8_LDA(At, 1, 1); PG8_STAGE(PG8_SA(1, 0), a3, voffA);
            PG8_BAR; PG8_WAIT_L(0); PG8_MMA(1, 0, At, B0); PG8_BAR; PG8_SCHED;
            PG8_STAGE(PG8_SB(1, 1), b3 + hstepB, voffB);
            PG8_WAIT_V(6); PG8_BAR; PG8_MMA(1, 1, At, B1); PG8_BAR;
            }
        }
        if constexpr (ALIGN_EPI) { if (wr == 0) PG8_BAR; }
        if (!has_next) PG8_PSTAMP(1);
        if constexpr (!Epi::AFTER_DRAIN) { E(acc, cur, wr, wc, fr, fq); S.done(cur); }
        if (!has_next) break;
#pragma unroll
        for (int a = 0; a < 2; ++a)
#pragma unroll
            for (int b = 0; b < 2; ++b)
#pragma unroll
                for (int m = 0; m < 4; ++m)
#pragma unroll
                    for (int n = 0; n < 2; ++n) acc[a][b][m][n] = (f32x4){0.f, 0.f, 0.f, 0.f};
        cur = nxt; cA = nA; cB = nB; ++ui;
        if constexpr (ALIGN_EPI) { if (wr == 1) PG8_BAR; }
    }
    PG8_PSTAMP(2);
    PG8_WAIT_V(0);
    if constexpr (!ALIGN_EPI) { if (wr == 0) PG8_BAR; }
    PG8_BAR;
    if constexpr (Epi::AFTER_DRAIN) { E.fused(acc, cur, wr, wc, fr, fq, lds, wid, lane); S.done(cur); }
#undef PG8_SA
#undef PG8_SB
#undef PG8_STAGE
#undef PG8_LDA
#undef PG8_LDB
#undef PG8_MMA
#undef PG8_WAIT_V
#undef PG8_WAIT_L
#undef PG8_BAR
#undef PG8_SCHED
}
}

constexpr size_t MiB = 1u << 20;
constexpr size_t WS_CTL = 0, CTL_ZERO_BYTES = 1 * MiB;
constexpr size_t WS_WGU1 = 2 * MiB;
constexpr size_t WS_WD1 = 13 * MiB;
constexpr size_t WS_WIN = 19 * MiB;
constexpr size_t WS_WOUT = 29 * MiB;
constexpr size_t WS_WGU2 = 33 * MiB;
constexpr size_t WS_WD2 = 44 * MiB;
constexpr size_t WS_XBF = 50 * MiB;
constexpr size_t WS_SS0 = 83 * MiB, WS_SS1 = 85 * MiB, WS_SS2 = 87 * MiB, WS_SSL = 89 * MiB, WS_SSS = 91 * MiB;
constexpr size_t WS_SSX1 = WS_SS1 + 3 * MiB / 2, WS_SSX2 = WS_SS2 + 3 * MiB / 2;
constexpr size_t WS_DT = 93 * MiB;
constexpr size_t WS_P = 96 * MiB;
constexpr size_t WS_END = 243 * MiB;
static_assert(WS_P + (size_t)MPAD * PW * 2 <= WS_END && WS_XBF + (size_t)MPAD * DM * 2 <= WS_SS0 && WS_WD2 + (size_t)DM * FF * 2 <= WS_XBF, "d_ws map");
constexpr int CW_TMO = 0;
constexpr int CW_BAR = 4096;

constexpr size_t O_YP = 0, O_YS = 16777216, O_PLC = 16908288, O_PLH = 16932864, O_PSC = 16941056, O_PSH = 16977920,
                 O_SLC = 18026496, O_SLH = 18419712, O_SSC = 18550784, O_SSH = 19140608, O_END = 35917824;

constexpr int RING_OFF = 0, RING_BYTES = 131072;
constexpr int LDS_BYTES = 163840;
constexpr int MISC_OFF = LDS_BYTES - 1024;
constexpr int NWAVES = 8;

#define GAS __attribute__((address_space(1)))
#define LAS __attribute__((address_space(3)))
typedef unsigned short bf16;
typedef unsigned v4u __attribute__((ext_vector_type(4)));
typedef float f32x4 __attribute__((ext_vector_type(4)));
typedef short bf16x8 __attribute__((ext_vector_type(8)));
typedef GAS unsigned gu32;
typedef GAS unsigned long long gu64;
#define RLX_AGENT __ATOMIC_RELAXED, __HIP_MEMORY_SCOPE_AGENT
#define LDS_WAIT() asm volatile("s_waitcnt lgkmcnt(0)" ::: "memory")
#define VM_WAIT() asm volatile("s_waitcnt vmcnt(0)" ::: "memory")
__device__ __forceinline__ unsigned long long rt() { return __builtin_amdgcn_s_memrealtime(); }
__device__ __forceinline__ unsigned f2bf(float f) { unsigned u = __builtin_bit_cast(unsigned, f); return (u + 0x7fffu + ((u >> 16) & 1u)) >> 16; }
__device__ __forceinline__ unsigned pk2(float lo, float hi) { return f2bf(lo) | (f2bf(hi) << 16); }

#define XB_TMO      128
#define XB_XCNT(j)  (256  + 64 * (j))
#define XB_XSUB(j)  (1280 + 64 * (j))
#define XB_XGEN(j)  (2304 + 64 * (j))
#define XB_TOP      3328
#define XB_TOPGEN   3392
#define XCD_BAR_WORDS 3456
#define XB_SPIN_CAP (1u << 18)

__device__ __forceinline__ unsigned xb_ld(unsigned* p)              { return __hip_atomic_load(p, __ATOMIC_RELAXED, __HIP_MEMORY_SCOPE_AGENT); }
__device__ __forceinline__ unsigned xb_add(unsigned* p, unsigned v) { return __hip_atomic_fetch_add(p, v, __ATOMIC_RELAXED, __HIP_MEMORY_SCOPE_AGENT); }
__device__ __forceinline__ unsigned xb_xcc_id() { return (unsigned)__builtin_amdgcn_s_getreg((3 << 11) | 20) & 0xFu; }
#define XB_SPIN(cond, bar) do { unsigned _sp = 0; while (cond) { __builtin_amdgcn_s_sleep(1); \
    if ((++_sp & 255u) == 0u) { if (xb_ld(&(bar)[XB_TMO])) break; if (_sp > XB_SPIN_CAP) { atomicAdd(&(bar)[XB_TMO], 1u); break; } } } } while (0)

struct XcdBarrier {
    unsigned* bar; unsigned x;
    volatile LAS unsigned* st;
};

__device__ __forceinline__ XcdBarrier xcd_barrier_post(unsigned* bar, volatile LAS unsigned* st) {
    XcdBarrier b; b.bar = bar; b.x = xb_xcc_id(); b.st = st;
    if (threadIdx.x == 0) (void)xb_add(&bar[XB_XCNT(b.x)], 1u);
    return b;
}
__device__ __forceinline__ void xcd_barrier_complete(unsigned* bar, unsigned x, unsigned& nloc, unsigned& nx) {
    const unsigned G = gridDim.x * gridDim.y * gridDim.z;
    unsigned sum, cnt, mine, sp = 0u;
    for (;;) {
        sum = 0u; cnt = 0u; mine = 0u;
#pragma unroll
        for (unsigned j = 0; j < 16; ++j) { const unsigned c = xb_ld(&bar[XB_XCNT(j)]); sum += c; cnt += (c > 0u) ? 1u : 0u; mine = (j == x) ? c : mine; }
        if (sum == G) break;
        __builtin_amdgcn_s_sleep(1);
        if ((++sp & 255u) == 0u) { if (xb_ld(&bar[XB_TMO])) break; if (sp > XB_SPIN_CAP) { atomicAdd(&bar[XB_TMO], 1u); break; } }
    }
    nloc = mine > 0u ? mine : 1u; nx = cnt > 0u ? cnt : 1u;
}

__device__ __forceinline__ void xcd_barrier(const XcdBarrier& b) {
    asm volatile("s_waitcnt vmcnt(0)" ::: "memory");
    __syncthreads();
    if (threadIdx.x == 0) {
        unsigned* bar = b.bar;
        __builtin_amdgcn_s_waitcnt(0);
        unsigned nloc = b.st[0], nx = b.st[1];
        if (nloc == 0u) { xcd_barrier_complete(bar, b.x, nloc, nx); b.st[0] = nloc; b.st[1] = nx; }
        const unsigned old = xb_add(&bar[XB_XSUB(b.x)], 1u);
        const unsigned gen = old / nloc;
        if (old + 1u == (gen + 1u) * nloc) {
            __builtin_amdgcn_fence(__ATOMIC_RELEASE, "agent");
            asm volatile("s_waitcnt vmcnt(0)" ::: "memory");
            const unsigned og = xb_add(&bar[XB_TOP], 1u);
            const unsigned tg = og / nx;
            if (og + 1u == (tg + 1u) * nx) xb_add(&bar[XB_TOPGEN], 1u);
            else XB_SPIN(xb_ld(&bar[XB_TOPGEN]) == tg, bar);
            __builtin_amdgcn_fence(__ATOMIC_ACQUIRE, "agent");
            xb_add(&bar[XB_XGEN(b.x)], 1u);
            asm volatile("s_waitcnt vmcnt(0)" ::: "memory");
        } else {
            XB_SPIN(xb_ld(&bar[XB_XGEN(b.x)]) == gen, bar);
            __builtin_amdgcn_fence(__ATOMIC_ACQUIRE, "agent");
            asm volatile("s_waitcnt vmcnt(0)" ::: "memory");
        }
    }
    __syncthreads();
}

struct Args { const float* in[32]; float* out; unsigned char* ws; };
enum { I_XP = 0, I_XS, I_SLC, I_SLH, I_SSC, I_SSH, I_F1N, I_F1G, I_F1U, I_F1D, I_MIXN, I_WIN, I_LCW, I_LCB, I_LGAW, I_LGAB, I_LGXW, I_LGXB,
       I_LAM, I_LON, I_SCW, I_SCB, I_SDTB, I_SALOG, I_SD, I_SNORM, I_WOUT, I_F2N, I_F2G, I_F2U, I_F2D, I_FINN };

__device__ __forceinline__ float wave_sum(float v) {
#pragma unroll
    for (int o = 1; o < 64; o <<= 1) v += __shfl_xor(v, o);
    return v;
}
__device__ __forceinline__ float bf_lo(unsigned w) { return __uint_as_float(w << 16); }
__device__ __forceinline__ float bf_hi(unsigned w) { return __uint_as_float(w & 0xffff0000u); }

__device__ __forceinline__ void tr_item(const float* src, int ld, int col0, int nvalid, const float* gain, int k0, bf16* dst, int K, int row0, LAS float* scr, int lane) {
    const int ksub = lane >> 4, n4 = (lane & 15) * 4;
    f32x4 v[16];
    const bool ok = n4 < nvalid;
    const float* sp = src + (size_t)(k0 + ksub) * ld + col0 + (ok ? n4 : 0);
    float gq[16];
#pragma unroll
    for (int i = 0; i < 16; ++i) gq[i] = gain ? gain[k0 + 4 * i + ksub] : 1.0f;
#pragma unroll
    for (int i = 0; i < 16; ++i) v[i] = __builtin_nontemporal_load((const f32x4*)(sp + (size_t)(4 * i) * ld));
#pragma unroll
    for (int i = 0; i < 16; ++i) { const int kk = 4 * i + ksub; const float gg = gq[i];
        f32x4 x = ok ? v[i] * gg : (f32x4){0.f, 0.f, 0.f, 0.f};
        LAS float* d = scr + kk * 65 + n4; d[0] = x[0]; d[1] = x[1]; d[2] = x[2]; d[3] = x[3]; }
    LDS_WAIT(); asm volatile("" ::: "memory");
    const int c = lane & 7;
#pragma unroll
    for (int j = 0; j < 8; ++j) { const int n = (lane >> 3) + 8 * j; const LAS float* s = scr + (8 * c) * 65 + n;
        v4u o; o.x = pg8::cvt_pk_bf16(s[0 * 65], s[1 * 65]); o.y = pg8::cvt_pk_bf16(s[2 * 65], s[3 * 65]); o.z = pg8::cvt_pk_bf16(s[4 * 65], s[5 * 65]); o.w = pg8::cvt_pk_bf16(s[6 * 65], s[7 * 65]);
        *(GAS v4u*)(dst + (size_t)(row0 + n) * K + k0 + 8 * c) = o; }
    LDS_WAIT(); asm volatile("" ::: "memory");
}
__device__ __forceinline__ void tr_gu(const float* wg, const float* wu, const float* gain, bf16* dst, int it, LAS float* scr, int lane) {
    constexpr int NRB = NGU / 64; const int kb = it / NRB, rb = it % NRB, tile = rb >> 2, w = rb & 3;
    tr_item(w < 2 ? wg : wu, FF, 128 * tile + 64 * (w & 1), 64, gain, 64 * kb, dst, DM, 64 * rb, scr, lane);
}
constexpr int I_GU = (DM / 64) * (NGU / 64), I_D = (FF / 64) * (DM / 64), I_IN = (DM / 64) * (NINP / 64), I_OUT = (DMIX / 64) * (DM / 64);
constexpr int IT_WD1 = I_GU, IT_WIN = IT_WD1 + I_D, IT_WOUT = IT_WIN + I_IN, IT_WGU2 = IT_WOUT + I_OUT, IT_WD2 = IT_WGU2 + I_GU, IT_END = IT_WD2 + I_D;
__device__ __forceinline__ void tr_range(const Args& a, LAS unsigned char* lds, int lo, int hi, int wk, int nwk, int wave, int lane_in) {
    int lane = lane_in; asm volatile("" : "+v"(lane));
    unsigned char* ws = a.ws;
    LAS float* scr = (LAS float*)(lds + wave * 17408);
    for (int it = lo + wk; it < hi; it += nwk) {
        int r = it;
        if (r < IT_WD1) { tr_gu(a.in[I_F1G], a.in[I_F1U], a.in[I_F1N], (bf16*)(ws + WS_WGU1), r, scr, lane); continue; }
        if (r < IT_WIN) { r -= IT_WD1; const int kb = r / (DM / 64), rb = r % (DM / 64); tr_item(a.in[I_F1D], DM, 64 * rb, 64, nullptr, 64 * kb, (bf16*)(ws + WS_WD1), FF, 64 * rb, scr, lane); continue; }
        if (r < IT_WOUT) { r -= IT_WIN; const int kb = r / (NINP / 64), rb = r % (NINP / 64); const int nv = NIN - 64 * rb < 0 ? 0 : (NIN - 64 * rb > 64 ? 64 : NIN - 64 * rb);
            tr_item(a.in[I_WIN], NIN, nv > 0 ? 64 * rb : 0, nv, a.in[I_MIXN], 64 * kb, (bf16*)(ws + WS_WIN), DM, 64 * rb, scr, lane); continue; }
        if (r < IT_WGU2) { r -= IT_WOUT; const int kb = r / (DM / 64), rb = r % (DM / 64); const int k0 = 64 * kb;
            const float* gain = k0 < DLRU ? a.in[I_LON] : a.in[I_SNORM] - DLRU;
            tr_item(a.in[I_WOUT], DM, 64 * rb, 64, gain, k0, (bf16*)(ws + WS_WOUT), DMIX, 64 * rb, scr, lane); continue; }
        if (r < IT_WD2) { tr_gu(a.in[I_F2G], a.in[I_F2U], a.in[I_F2N], (bf16*)(ws + WS_WGU2), r - IT_WGU2, scr, lane); continue; }
        { r -= IT_WD2; const int kb = r / (DM / 64), rb = r % (DM / 64); tr_item(a.in[I_F2D], DM, 64 * rb, 64, nullptr, 64 * kb, (bf16*)(ws + WS_WD2), FF, 64 * rb, scr, lane); }
    }
}
__device__ __forceinline__ void p0_prologue(const Args& a, LAS unsigned char* lds, int vcu, int G, int wave, int lane) {
    unsigned char* ws = a.ws;
    const int gw = vcu * NWAVES + wave, NGW = G * NWAVES;
    tr_range(a, lds, 0, IT_WD1, gw, NGW, wave, lane);
    bf16* xbf = (bf16*)(ws + WS_XBF); float* ss0 = (float*)(ws + WS_SS0);
    for (int m = gw; m < MPAD; m += NGW) {
        f32x4 v[2][2]; float s = 0.f;
        if (m < MREAL) { const GAS f32x4* xr = (const GAS f32x4*)(m < TP ? a.in[I_XP] + (size_t)m * DM : a.in[I_XS] + (size_t)(m - TP) * DM) + 2 * lane;
#pragma unroll
            for (int j = 0; j < 2; ++j) { v[j][0] = __builtin_nontemporal_load(xr + 128 * j); v[j][1] = __builtin_nontemporal_load(xr + 128 * j + 1);
                s += ((v[j][0].x * v[j][0].x + v[j][0].y * v[j][0].y) + (v[j][0].z * v[j][0].z + v[j][0].w * v[j][0].w)) + ((v[j][1].x * v[j][1].x + v[j][1].y * v[j][1].y) + (v[j][1].z * v[j][1].z + v[j][1].w * v[j][1].w)); }
        } else {
#pragma unroll
            for (int j = 0; j < 2; ++j) { v[j][0] = (f32x4){0.f, 0.f, 0.f, 0.f}; v[j][1] = v[j][0]; }
        }
        s = wave_sum(s);
        GAS v4u* o16 = (GAS v4u*)(xbf + (size_t)m * DM) + lane;
#pragma unroll
        for (int j = 0; j < 2; ++j) o16[64 * j] = (v4u){pg8::cvt_pk_bf16(v[j][0].x, v[j][0].y), pg8::cvt_pk_bf16(v[j][0].z, v[j][0].w), pg8::cvt_pk_bf16(v[j][1].x, v[j][1].y), pg8::cvt_pk_bf16(v[j][1].z, v[j][1].w)};
        if (lane < 16) ss0[(size_t)m * 16 + lane] = lane == 0 ? s : 0.f;
    }
}
__device__ __forceinline__ int light_rank(int nwg, int G, int c, int& nlight) {
    const int rem = nwg % G; nlight = rem == 0 ? 0 : G - rem; return (rem != 0 && c >= rem) ? c - rem : -1;
}

__device__ __forceinline__ void p9_final_norm(const Args& a, int vcu, int G, int wave, int lane) {
    const int gw = vcu * NWAVES + wave, NGW = G * NWAVES;
    const bf16* xbf = (const bf16*)(a.ws + WS_XBF); const float* SS = (const float*)(a.ws + WS_SS0); const float* SSX = (const float*)(a.ws + WS_SSX1);
    const GAS f32x4* gn = (const GAS f32x4*)a.in[I_FINN] + 2 * lane;
    f32x4 gv[2][2];
#pragma unroll
    for (int j = 0; j < 2; ++j) { gv[j][0] = gn[128 * j]; gv[j][1] = gn[128 * j + 1]; }
    for (int m = gw; m < MREAL; m += NGW) {
        const float rs = pg8::rstd_row(SS, SSX, m);
        const GAS v4u* xr = (const GAS v4u*)(xbf + (size_t)m * DM) + lane; GAS f32x4* yr = (GAS f32x4*)(a.out + (size_t)m * DM) + 2 * lane;
#pragma unroll
        for (int j = 0; j < 2; ++j) { const v4u w = xr[64 * j];
            __builtin_nontemporal_store((f32x4){bf_lo(w.x), bf_hi(w.x), bf_lo(w.y), bf_hi(w.y)} * rs * gv[j][0], yr + 128 * j);
            __builtin_nontemporal_store((f32x4){bf_lo(w.z), bf_hi(w.z), bf_lo(w.w), bf_hi(w.w)} * rs * gv[j][1], yr + 128 * j + 1); }
    }
}

template <bool SEG3, bool BBF>
__device__ __forceinline__ void small_gemm_resid(const bf16* A, int lda, const bf16* Bt, int K, int id, const float* base, bf16* xbf, float* SSX, float scale,
                                                 const float* SSL, const float* SSS, LAS unsigned char* red, int tid_in) {
    int tid = tid_in; asm volatile("" : "+v"(tid));
    const int wid = __builtin_amdgcn_readfirstlane(tid >> 6), lane = tid & 63, fr = lane & 15, fq = lane >> 4;
    const int rg = id & 3, u = id >> 2, rh = wid >> 2, kq = wid & 3, Kq = K >> 2;
    const int s = rg * 32 + rh * 16 + fr; const size_t row = (size_t)TP + s;
    const bf16* ap = A + row * lda + kq * Kq + fq * 8; const bf16* bp = Bt + (size_t)(u * 16 + fr) * K + kq * Kq + fq * 8;
    f32x4 acc = (f32x4){0.f, 0.f, 0.f, 0.f};
    constexpr int NB = SEG3 ? 8 : 11;
    for (int k0 = 0; k0 < Kq; k0 += NB * 32) {
        bf16x8 av[NB], bv[NB];
#pragma unroll
        for (int ks = 0; ks < NB; ++ks) if (k0 + ks * 32 < Kq) { av[ks] = *(const bf16x8*)(ap + k0 + ks * 32); bv[ks] = *(const bf16x8*)(bp + k0 + ks * 32); }
#pragma unroll
        for (int ks = 0; ks < NB; ++ks) if (k0 + ks * 32 < Kq) acc = __builtin_amdgcn_mfma_f32_16x16x32_bf16(bv[ks], av[ks], acc, 0, 0, 0);
    }
    if (SEG3) { float sm = 0.f;
        if (kq < 2) {
#pragma unroll
            for (int k = 0; k < 16; ++k) sm += SSL[row * 16 + k];
            sm *= (1.0f / 1024.0f);
        } else {
#pragma unroll
            for (int k = 0; k < 8; ++k) sm += SSS[row * 16 + (kq - 2) * 8 + k];
            sm *= (1.0f / 512.0f); }
        acc = acc * (1.0f / sqrtf(sm + EPS)); }
    *(LAS f32x4*)(red + (wid * 64 + lane) * 16) = acc;
    __syncthreads();
    if (kq == 0) {
        f32x4 tot = acc;
#pragma unroll
        for (int q = 1; q < 4; ++q) tot += *(const LAS f32x4*)(red + ((wid + q) * 64 + lane) * 16);
        const int col = u * 16 + 4 * fq;
        f32x4 bv;
        if (BBF) { const pg8::u32x2 b2 = *(const pg8::u32x2*)(xbf + row * DM + col); bv = (f32x4){bf_lo(b2.x), bf_hi(b2.x), bf_lo(b2.y), bf_hi(b2.y)}; }
        else bv = *(const f32x4*)(base + (size_t)s * DM + col);
        const f32x4 v = bv + tot * scale;
        pg8::u32x2 w; w.x = pg8::cvt_pk_bf16(v[0], v[1]); w.y = pg8::cvt_pk_bf16(v[2], v[3]);
        *(pg8::u32x2*)(xbf + row * DM + col) = w;
        float ss = (v[0] * v[0] + v[1] * v[1]) + (v[2] * v[2] + v[3] * v[3]);
        ss = pg8::bfly16(ss, ss); ss = pg8::bfly32(ss, ss);
        if (fq == 0) SSX[(size_t)s * 64 + u] = ss;
    }
    __syncthreads();
}

__device__ __forceinline__ float softplus_f(float x) { return x > 20.f ? x : log1pf(expf(x)); }
__device__ __forceinline__ float sigmoid_f(float x) { return 1.0f / (1.0f + expf(-x)); }
__device__ __forceinline__ float gelu_tanh_f(float y) { const float v = 0.7978845608f * (y + 0.044715f * y * y * y); const float th = 1.0f - 2.0f / (expf(2.0f * v) + 1.0f); return 0.5f * y * (1.0f + th); }
__device__ __forceinline__ float bf1(const bf16* p) { return __uint_as_float((unsigned)(*p) << 16); }
__device__ __forceinline__ bf16 f2bf1(float f) { return (bf16)f2bf(f); }

__device__ __forceinline__ void naive_lru(const Args& a, LAS float* Wl, LAS float* xcl, int hd, int row0, int nseq, int L, bool sample, int lane) {
    bf16* P = (bf16*)(a.ws + WS_P); float* SSL = (float*)(a.ws + WS_SSL);
    const float* Wa = a.in[I_LGAW] + (size_t)hd * 4096; const float* Wx = a.in[I_LGXW] + (size_t)hd * 4096;
    for (int i = 0; i < 64; ++i) { Wl[i * 64 + lane] = Wa[i * 64 + lane]; Wl[4096 + i * 64 + lane] = Wx[i * 64 + lane]; }
    LDS_WAIT();
    const int ch = hd * 64 + lane;
    const float cw0 = a.in[I_LCW][ch], cw1 = a.in[I_LCW][DLRU + ch], cw2 = a.in[I_LCW][2 * DLRU + ch], cw3 = a.in[I_LCW][3 * DLRU + ch], cb = a.in[I_LCB][ch];
    const float ba = a.in[I_LGAB][ch], bx = a.in[I_LGXB][ch], sp = 8.0f * softplus_f(-a.in[I_LAM][ch]);
    for (int s = 0; s < nseq; ++s) {
        float xm3 = 0.f, xm2 = 0.f, xm1 = 0.f, h = 0.f;
        if (sample) { xm3 = a.in[I_SLC][(size_t)(s * 3 + 0) * DLRU + ch]; xm2 = a.in[I_SLC][(size_t)(s * 3 + 1) * DLRU + ch]; xm1 = a.in[I_SLC][(size_t)(s * 3 + 2) * DLRU + ch]; h = a.in[I_SLH][(size_t)s * DLRU + ch]; }
        for (int t = 0; t < L; ++t) {
            const size_t row = (size_t)row0 + (size_t)s * L + t;
            const float x0 = bf1(P + row * PW + ch);
            const float xc = cb + cw0 * xm3 + cw1 * xm2 + cw2 * xm1 + cw3 * x0;
            xm3 = xm2; xm2 = xm1; xm1 = x0;
            xcl[lane] = xc; LDS_WAIT(); asm volatile("" ::: "memory");
            float ga = ba, gx = bx;
#pragma unroll 8
            for (int i = 0; i < 64; ++i) { const float xi = xcl[i]; ga += xi * Wl[i * 64 + lane]; gx += xi * Wl[4096 + i * 64 + lane]; }
            LDS_WAIT(); asm volatile("" ::: "memory");
            const float r = sigmoid_f(ga), ig = sigmoid_f(gx), log_a = -r * sp, av = expf(log_a), u = sqrtf(-expm1f(2.0f * log_a)) * (ig * xc);
            h = av * h + u;
            const float gv = h * gelu_tanh_f(bf1(P + row * PW + DLRU + ch));
            const float ss = wave_sum(gv * gv);
            if (lane == 0) SSL[row * 16 + hd] = ss;
            P[row * PW + DLRU + ch] = f2bf1(gv);
        }
        if (sample) { a.out[O_SLH + (size_t)s * DLRU + ch] = h;
            a.out[O_SLC + (size_t)(s * 3 + 0) * DLRU + ch] = xm3; a.out[O_SLC + (size_t)(s * 3 + 1) * DLRU + ch] = xm2; a.out[O_SLC + (size_t)(s * 3 + 2) * DLRU + ch] = xm1; }
        else { const int b = row0 / SEQ; a.out[O_PLH + (size_t)b * DLRU + ch] = h;
            a.out[O_PLC + (size_t)(b * 3 + 0) * DLRU + ch] = xm3; a.out[O_PLC + (size_t)(b * 3 + 1) * DLRU + ch] = xm2; a.out[O_PLC + (size_t)(b * 3 + 2) * DLRU + ch] = xm1; }
    }
}

__device__ __forceinline__ void naive_ssd(const Args& a, LAS float* sc, int h, int row0, int L, bool sample, int s, int tid) {
    bf16* P = (bf16*)(a.ws + WS_P); float* SSS = (float*)(a.ws + WS_SSS); const float* DT = (const float*)(a.ws + WS_DT);
    const int g = h >> 3, p = tid >> 3, nb = tid & 7;
    LAS float* xs = sc; LAS float* Bv = sc + 64; LAS float* Cv = sc + 192; LAS float* ssq = sc + 320; LAS float* dd = sc + 384;
    const float Ah = -expf(a.in[I_SALOG][h]), dtb = a.in[I_SDTB][h], Dh = a.in[I_SD][h];
    const int cch = tid < 64 ? h * 64 + tid : (tid < 192 ? 1024 + g * 128 + (tid - 64) : 1280 + g * 128 + (tid - 192));
    float cw0 = 0.f, cw1 = 0.f, cw2 = 0.f, cw3 = 0.f, cb = 0.f, xm3 = 0.f, xm2 = 0.f, xm1 = 0.f;
    if (tid < 320) { cw0 = a.in[I_SCW][cch]; cw1 = a.in[I_SCW][DXBC + cch]; cw2 = a.in[I_SCW][2 * DXBC + cch]; cw3 = a.in[I_SCW][3 * DXBC + cch]; cb = a.in[I_SCB][cch];
        if (sample) { xm3 = a.in[I_SSC][(size_t)(s * 3 + 0) * DXBC + cch]; xm2 = a.in[I_SSC][(size_t)(s * 3 + 1) * DXBC + cch]; xm1 = a.in[I_SSC][(size_t)(s * 3 + 2) * DXBC + cch]; } }
    float hst[16];
    const size_t sbase = ((size_t)(s * NHEAD + h) * 64 + p) * 128 + nb * 16;
#pragma unroll
    for (int k = 0; k < 16; ++k) hst[k] = sample ? a.in[I_SSH][sbase + k] : 0.f;
    for (int t = 0; t < L; ++t) {
        const size_t row = (size_t)row0 + t;
        if (tid < 320) { const float x0 = bf1(P + row * PW + 3072 + cch); const float v = cb + cw0 * xm3 + cw1 * xm2 + cw2 * xm1 + cw3 * x0; xm3 = xm2; xm2 = xm1; xm1 = x0;
            sc[tid] = v / (1.0f + expf(-v)); }
        if (tid == 320) { const float dt = softplus_f(DT[row * 16 + h] + dtb); dd[0] = dt; dd[1] = expf(dt * Ah); }
        __syncthreads();
        const float dt = dd[0], dA = dd[1], xp = xs[p], xdt = dt * xp; float yp = 0.f;
#pragma unroll
        for (int k = 0; k < 16; ++k) { hst[k] = hst[k] * dA + xdt * Bv[nb * 16 + k]; yp += Cv[nb * 16 + k] * hst[k]; }
        yp += __shfl_xor(yp, 1); yp += __shfl_xor(yp, 2); yp += __shfl_xor(yp, 4);
        if (nb == 0) { const float y = yp + Dh * xp; const float z = bf1(P + row * PW + 2048 + h * 64 + p); const float gv = y * (z / (1.0f + expf(-z)));
            ssq[p] = gv * gv; P[row * PW + 2048 + h * 64 + p] = f2bf1(gv); }
        __syncthreads();
        if (tid == 0) { float ssum = 0.f; for (int i = 0; i < 64; ++i) ssum += ssq[i]; SSS[row * 16 + h] = ssum; }
    }
    float* so = a.out + (sample ? O_SSH : O_PSH) + sbase;
#pragma unroll
    for (int k = 0; k < 16; ++k) so[k] = hst[k];
    if (tid < 320) { float* co = a.out + (sample ? O_SSC : O_PSC) + (size_t)(s * 3) * DXBC + cch; co[0] = xm3; co[DXBC] = xm2; co[2 * DXBC] = xm1; }
    __syncthreads();
}


constexpr int MS = 272;
constexpr int XNS = 144;
constexpr int L_CN = 0, L_BN = 34816, L_XN = 69632, L_XWN = L_XN + 128 * XNS, L_H = L_XWN + 128 * XNS, L_ACS = L_H + 64 * MS, L_DTJ = L_ACS + 1024, L_WJ = L_DTJ + 1024, L_MSC = L_WJ + 1024;
constexpr int L_XCW = L_MSC + 128;
constexpr int L_GJ = L_XCW + 1280;
static_assert(L_GJ + 1024 <= MISC_OFF && L_MSC + 64 <= L_XCW, "mixer LDS map");
__device__ __forceinline__ unsigned cvtpk(float lo, float hi) { return pg8::cvt_pk_bf16(lo, hi); }
__device__ __forceinline__ float softplus_fast(float x) { const float t = __builtin_amdgcn_exp2f(1.44269504f * x); return x > 20.f ? x : (x < -15.f ? t : 0.693147181f * __builtin_amdgcn_logf(1.0f + t)); }
__device__ __forceinline__ float silu_fast(float x) { return x * __builtin_amdgcn_rcpf(1.0f + __builtin_amdgcn_exp2f(-1.44269504f * x)); }
__device__ __forceinline__ float exp_fast(float x) { return __builtin_amdgcn_exp2f(1.44269504f * x); }
typedef unsigned v2u __attribute__((ext_vector_type(2)));
typedef short s4v_t __attribute__((ext_vector_type(4)));
#define LDTR(addr_) (__builtin_bit_cast(v2u, __builtin_amdgcn_ds_read_tr16_b64_v4i16((LAS s4v_t*)(addr_))))
#define MFMA16(a, b, c) __builtin_amdgcn_mfma_f32_16x16x32_bf16((a), (b), (c), 0, 0, 0)
#define LDFRAG(base, row, ks) (*(const LAS bf16x8*)(lds + (base) + (row) * MS + (ks) * 64 + fq * 16))
#define OPQ_IDX() int tid = tid_in; asm volatile("" : "+v"(tid)); const int lane = tid & 63, fr = lane & 15, fq = lane >> 4; (void)fr; (void)fq; (void)lane

struct ConvW { f32x4 w[4][2], b[2]; };
__device__ __forceinline__ void load_convw(ConvW& c, const float* cw, const float* cb, int ld, int ch) {
#pragma unroll
    for (int k = 0; k < 4; ++k) { c.w[k][0] = *(const f32x4*)(cw + k * ld + ch); c.w[k][1] = *(const f32x4*)(cw + k * ld + ch + 4); }
    c.b[0] = *(const f32x4*)(cb + ch); c.b[1] = *(const f32x4*)(cb + ch + 4);
}
__device__ __forceinline__ void unpack8(const v4u v, float (&x)[8]) { x[0] = bf_lo(v.x); x[1] = bf_hi(v.x); x[2] = bf_lo(v.y); x[3] = bf_hi(v.y); x[4] = bf_lo(v.z); x[5] = bf_hi(v.z); x[6] = bf_lo(v.w); x[7] = bf_hi(v.w); }
__device__ __forceinline__ void conv_tok(const ConvW& c, const float (&r0)[8], const float (&r1)[8], const float (&r2)[8], const float (&r3)[8], float (&o)[8]) {
#pragma unroll
    for (int q = 0; q < 8; ++q) o[q] = c.b[q >> 2][q & 3] + c.w[0][q >> 2][q & 3] * r0[q] + c.w[1][q >> 2][q & 3] * r1[q] + c.w[2][q >> 2][q & 3] * r2[q] + c.w[3][q >> 2][q & 3] * r3[q];
}


struct SPair { const f32x4* hin; f32x4* hout; f32x4 B4, C4; float dt, dA, xv, yacc, Dh, zv; bf16* zp; float* sss; float pp0, pp1, pp2, pp3, pp4, pp5, pp6, pp7; };
struct SPRaw { float x0[5], x1[5], x2[5], xn[5], w0[5], w1[5], w2[5], w3[5], bb[5]; float dtraw, dtb, alog, dh, zv; };
__device__ __forceinline__ void sp_load(SPRaw& r, const Args& a, int q, int lane) {
    const bf16* P = (const bf16*)(a.ws + WS_P); const float* DT = (const float*)(a.ws + WS_DT);
    const int s = q >> 4, h = q & 15, g = h >> 3; const size_t row = (size_t)TP + s;
    const float* cw = a.in[I_SCW]; const float* cb = a.in[I_SCB]; const float* cs = a.in[I_SSC] + (size_t)s * 3 * DXBC;
#pragma unroll
    for (int k = 0; k < 5; ++k) {
        const int ch = k == 0 ? h * 64 + lane : (k < 3 ? 1024 : 1280) + g * 128 + lane + ((k - 1) & 1) * 64;
        r.x0[k] = cs[ch]; r.x1[k] = cs[DXBC + ch]; r.x2[k] = cs[2 * DXBC + ch]; r.xn[k] = bf1(P + row * PW + 3072 + ch);
        r.bb[k] = cb[ch]; r.w0[k] = cw[ch]; r.w1[k] = cw[DXBC + ch]; r.w2[k] = cw[2 * DXBC + ch]; r.w3[k] = cw[3 * DXBC + ch]; }
    r.dtraw = DT[row * 16 + h]; r.dtb = a.in[I_SDTB][h]; r.alog = a.in[I_SALOG][h]; r.dh = a.in[I_SD][h]; r.zv = bf1(P + row * PW + 2048 + h * 64 + lane);
}
__device__ __forceinline__ void sp_finish(SPair& sp, const SPRaw& r, const Args& a, int q, int lane) {
    bf16* P = (bf16*)(a.ws + WS_P);
    const int s = q >> 4, h = q & 15, g = h >> 3; const size_t row = (size_t)TP + s;
    float* cso = a.out + O_SSC + (size_t)s * 3 * DXBC;
    float sv[5];
#pragma unroll
    for (int k = 0; k < 5; ++k) {
        const int ch = k == 0 ? h * 64 + lane : (k < 3 ? 1024 : 1280) + g * 128 + lane + ((k - 1) & 1) * 64;
        sv[k] = silu_fast(r.bb[k] + r.w0[k] * r.x0[k] + r.w1[k] * r.x1[k] + r.w2[k] * r.x2[k] + r.w3[k] * r.xn[k]);
        if (k == 0 || (h & 7) == 0) { cso[ch] = r.x1[k]; cso[DXBC + ch] = r.x2[k]; cso[2 * DXBC + ch] = r.xn[k]; } }
    const int nb = 4 * (lane & 31);
#pragma unroll
    for (int j = 0; j < 4; ++j) { const int src = (nb + j) & 63; const bool hi = (nb + j) >= 64;
        const float b0 = __shfl(sv[1], src), b1 = __shfl(sv[2], src), c0 = __shfl(sv[3], src), c1 = __shfl(sv[4], src);
        sp.B4[j] = hi ? b1 : b0; sp.C4[j] = hi ? c1 : c0; }
    sp.xv = sv[0];
    sp.dt = softplus_f(r.dtraw + r.dtb); sp.dA = exp_fast(sp.dt * -expf(r.alog)); sp.Dh = r.dh;
    sp.hin = (const f32x4*)(a.in[I_SSH] + (size_t)q * 8192) + lane; sp.hout = (f32x4*)(a.out + O_SSH + (size_t)q * 8192) + lane;
    sp.yacc = 0.f; sp.pp0 = sp.pp1 = sp.pp2 = sp.pp3 = sp.pp4 = sp.pp5 = sp.pp6 = sp.pp7 = 0.f; sp.zp = P + row * PW + 2048 + h * 64 + lane; sp.sss = (float*)(a.ws + WS_SSS) + row * 16 + h;
    sp.zv = r.zv;
}
__device__ __forceinline__ void sp_begin(SPair& sp, const Args& a, int q, int lane) { SPRaw r; sp_load(r, a, q, lane); asm volatile("s_waitcnt vmcnt(0)" ::: "memory"); sp_finish(sp, r, a, q, lane); }
__device__ __forceinline__ void sp_prefetch(const SPair& sp, int c, f32x4& h0, f32x4& h1) { h0 = __builtin_nontemporal_load(sp.hin + (2 * c) * 64); h1 = __builtin_nontemporal_load(sp.hin + (2 * c + 1) * 64); }
__device__ __forceinline__ void sp_step(SPair& sp, int c, const f32x4 h0, const f32x4 h1, int lane) {
    const int hf = lane >> 5;
    const float xa0 = __shfl(sp.xv, 4 * c), xa1 = __shfl(sp.xv, 4 * c + 1), xb0 = __shfl(sp.xv, 4 * c + 2), xb1 = __shfl(sp.xv, 4 * c + 3);
    const float xd0 = sp.dt * (hf ? xa1 : xa0), xd1 = sp.dt * (hf ? xb1 : xb0);
    const f32x4 n0 = h0 * sp.dA + sp.B4 * xd0, n1 = h1 * sp.dA + sp.B4 * xd1;
    __builtin_nontemporal_store(n0, sp.hout + (2 * c) * 64); __builtin_nontemporal_store(n1, sp.hout + (2 * c + 1) * 64);
    const float p0 = (sp.C4[0] * n0[0] + sp.C4[1] * n0[1]) + (sp.C4[2] * n0[2] + sp.C4[3] * n0[3]), p1 = (sp.C4[0] * n1[0] + sp.C4[1] * n1[1]) + (sp.C4[2] * n1[2] + sp.C4[3] * n1[3]);
    const int cc = c & 3;
    if (cc == 0) { sp.pp0 = p0; sp.pp1 = p1; } else if (cc == 1) { sp.pp2 = p0; sp.pp3 = p1; } else if (cc == 2) { sp.pp4 = p0; sp.pp5 = p1; } else { sp.pp6 = p0; sp.pp7 = p1;
        const bool u4 = lane & 16, u3 = lane & 8, u2 = lane & 4;
        float a0 = pg8::bfly16(sp.pp0, sp.pp4), a1 = pg8::bfly16(sp.pp1, sp.pp5), a2 = pg8::bfly16(sp.pp2, sp.pp6), a3 = pg8::bfly16(sp.pp3, sp.pp7);
        float b0 = (u3 ? a2 : a0) + __shfl_xor(u3 ? a0 : a2, 8), b1 = (u3 ? a3 : a1) + __shfl_xor(u3 ? a1 : a3, 8);
        float t = (u2 ? b1 : b0) + __shfl_xor(u2 ? b0 : b1, 4);
        t += __shfl_xor(t, 2); t += __shfl_xor(t, 1);
        const int src = 32 * (lane & 1) + 16 * ((lane >> 3) & 1) + 8 * ((lane >> 2) & 1) + 4 * ((lane >> 1) & 1);
        const float got = __shfl(t, src);
        if ((lane >> 4) == (c >> 2)) sp.yacc = got; }
}
__device__ __forceinline__ void sp_end(SPair& sp, int lane) {
    const float y = sp.yacc + sp.Dh * sp.xv, gv = y * silu_fast(sp.zv);
    const float ss = wave_sum(gv * gv);
    *sp.zp = f2bf1(gv);
    if (lane == 0) *sp.sss = ss;
}

__device__ __forceinline__ void ssd_prepass(const Args& a, int vcu, int G, int tid_in) {
    int tid = tid_in; asm volatile("" : "+v"(tid));
    const bf16* P = (const bf16*)(a.ws + WS_P); bf16* BCc = (bf16*)a.out;
    for (int it = vcu * 512 + tid; it < (TP / 8) * 64; it += G * 512) {
        const int cg = it & 63, run = it >> 6, row0 = run * 8, tt0 = row0 & (SEQ - 1), cch = 1024 + cg * 8;
        const bf16* pb = P + (size_t)(row0 - tt0) * PW + 3072 + cch;
        v4u raw[11];
#pragma unroll
        for (int i = 0; i < 11; ++i) { const int tt = tt0 - 3 + i; raw[i] = *(const v4u*)(pb + (size_t)(tt < 0 ? 0 : tt) * PW); if (tt < 0) raw[i] = (v4u){0u, 0u, 0u, 0u}; }
        ConvW cwv; load_convw(cwv, a.in[I_SCW], a.in[I_SCB], DXBC, cch);
        float r0[8], r1[8], r2[8], r3[8];
        unpack8(raw[0], r0); unpack8(raw[1], r1); unpack8(raw[2], r2);
#pragma unroll
        for (int jj = 0; jj < 8; ++jj) { float o[8];
            if ((jj & 3) == 0) { unpack8(raw[jj + 3], r3); conv_tok(cwv, r0, r1, r2, r3, o); }
            if ((jj & 3) == 1) { unpack8(raw[jj + 3], r0); conv_tok(cwv, r1, r2, r3, r0, o); }
            if ((jj & 3) == 2) { unpack8(raw[jj + 3], r1); conv_tok(cwv, r2, r3, r0, r1, o); }
            if ((jj & 3) == 3) { unpack8(raw[jj + 3], r2); conv_tok(cwv, r3, r0, r1, r2, o); }
            v4u w; w.x = cvtpk(silu_fast(o[0]), silu_fast(o[1])); w.y = cvtpk(silu_fast(o[2]), silu_fast(o[3])); w.z = cvtpk(silu_fast(o[4]), silu_fast(o[5])); w.w = cvtpk(silu_fast(o[6]), silu_fast(o[7]));
            *(v4u*)(BCc + (size_t)(row0 + jj) * 512 + cg * 8) = w; }
    }
}

template <int KM>
__device__ __forceinline__ void ssd_tri(LAS unsigned char* lds, int sl, int i0, int fr, int fq, const bf16x8 (&cf)[4], float acs_i, f32x4 (&accY)[4]) {
    const LAS float* ACS = (const LAS float*)(lds + L_ACS); const LAS float* DTJ = (const LAS float*)(lds + L_DTJ); const LAS float* GJ = (const LAS float*)(lds + L_GJ);
    bf16x8 bq[2][4], xq[4];
#define TRI_LOADB(jt_, s_) do { _Pragma("unroll") for (int ks_ = 0; ks_ < 4; ++ks_) bq[s_][ks_] = LDFRAG(L_BN, (jt_) * 16 + fr, ks_); } while (0)
#define TRI_LOADX(kp_) do { _Pragma("unroll") for (int pt_ = 0; pt_ < 4; ++pt_) { \
            const v2u xa_ = LDTR(lds + L_XN + (32 * (kp_) + 4 * fq + ((fr >> 2) & 3)) * XNS + (pt_ * 16 + 4 * (fr & 3)) * 2), xb_ = LDTR(lds + L_XN + (32 * (kp_) + 16 + 4 * fq + ((fr >> 2) & 3)) * XNS + (pt_ * 16 + 4 * (fr & 3)) * 2); \
            xq[pt_] = __builtin_bit_cast(bf16x8, (v4u){xa_.x, xa_.y, xb_.x, xb_.y}); } } while (0)
    TRI_LOADB(0, 0);
    __builtin_amdgcn_sched_barrier(0);
#pragma unroll
    for (int kp = 0; kp <= KM; ++kp) {
        f32x4 cb[2];
        TRI_LOADB(2 * kp + 1, 1); TRI_LOADX(kp);
        __builtin_amdgcn_sched_barrier(0);
        { f32x4 acc = (f32x4){0.f, 0.f, 0.f, 0.f};
#pragma unroll
          for (int ks = 0; ks < 4; ++ks) acc = MFMA16(bq[0][ks], cf[ks], acc);
          cb[0] = acc; }
        __builtin_amdgcn_sched_barrier(0);
        if (kp < KM) TRI_LOADB(2 * kp + 2, 0);
        float ra0 = 0.f, ra1 = 0.f; f32x4 dq0, dq1;
        if (kp < KM) { ra0 = ACS[sl * 128 + (2 * kp) * 16 + 15]; ra1 = ACS[sl * 128 + (2 * kp + 1) * 16 + 15];
            dq0 = *(const LAS f32x4*)(GJ + sl * 128 + (2 * kp) * 16 + 4 * fq); dq1 = *(const LAS f32x4*)(GJ + sl * 128 + (2 * kp + 1) * 16 + 4 * fq); }
        else { dq0 = *(const LAS f32x4*)(ACS + sl * 128 + (2 * kp) * 16 + 4 * fq); dq1 = *(const LAS f32x4*)(ACS + sl * 128 + (2 * kp + 1) * 16 + 4 * fq); }
        __builtin_amdgcn_sched_barrier(0);
        { f32x4 acc = (f32x4){0.f, 0.f, 0.f, 0.f};
#pragma unroll
          for (int ks = 0; ks < 4; ++ks) acc = MFMA16(bq[1][ks], cf[ks], acc);
          cb[1] = acc; }
        unsigned mw[4];
#pragma unroll
        for (int hh = 0; hh < 2; ++hh) { const int jt = 2 * kp + hh;
            float mv[4];
            if (kp < KM) {
                const float rf = exp_fast(fminf(acs_i - (hh ? ra1 : ra0), 0.f));
                const f32x4 gj = hh ? dq1 : dq0;
#pragma unroll
                for (int r = 0; r < 4; ++r) mv[r] = cb[hh][r] * (rf * gj[r]);
            } else {
                const f32x4 aj = hh ? dq1 : dq0, dj = *(const LAS f32x4*)(DTJ + sl * 128 + jt * 16 + 4 * fq);
#pragma unroll
                for (int r = 0; r < 4; ++r) { const float e = exp_fast(fminf(acs_i - aj[r], 0.f)) * dj[r]; mv[r] = (jt * 16 + 4 * fq + r <= i0 + fr) ? cb[hh][r] * e : 0.f; } }
            mw[2 * hh] = cvtpk(mv[0], mv[1]); mw[2 * hh + 1] = cvtpk(mv[2], mv[3]); }
        const bf16x8 mf = __builtin_bit_cast(bf16x8, (v4u){mw[0], mw[1], mw[2], mw[3]});
#pragma unroll
        for (int pt = 0; pt < 4; ++pt) accY[pt] = MFMA16(xq[pt], mf, accY[pt]);
        __builtin_amdgcn_sched_barrier(0);
    }
#undef TRI_LOADB
#undef TRI_LOADX
}

__device__ __forceinline__ void ssd_unit_fast(const Args& a, LAS unsigned char* lds, int b, int h, int tid_in, int wid, int lane_in, int spq) {
    bf16* P = (bf16*)(a.ws + WS_P); float* SSS = (float*)(a.ws + WS_SSS); const float* DT = (const float*)(a.ws + WS_DT);
    const int g = h >> 3;
    const float Ah = -expf(a.in[I_SALOG][h]), dtb = a.in[I_SDTB][h], Dh = a.in[I_SD][h];
    const float* cw = a.in[I_SCW]; const float* cb = a.in[I_SCB];
    LAS float* ACS = (LAS float*)(lds + L_ACS); LAS float* DTJ = (LAS float*)(lds + L_DTJ); LAS float* WJ = (LAS float*)(lds + L_WJ); LAS float* MSC = (LAS float*)(lds + L_MSC); LAS float* GJ = (LAS float*)(lds + L_GJ);
    const size_t rowb = (size_t)b * SEQ;
    for (int i = tid_in; i < 64 * MS / 16; i += 512) *(LAS v4u*)(lds + L_H + i * 16) = (v4u){0u, 0u, 0u, 0u};
    if (tid_in < 64) { LAS float* xw_ = (LAS float*)(lds + L_XCW) + (tid_in >> 3) * 40 + (tid_in & 7); const int ch_ = h * 64 + tid_in;
        xw_[0] = cw[ch_]; xw_[8] = cw[DXBC + ch_]; xw_[16] = cw[2 * DXBC + ch_]; xw_[24] = cw[3 * DXBC + ch_]; xw_[32] = cb[ch_]; }
    f32x4 accH[4];
#pragma unroll
    for (int pt = 0; pt < 4; ++pt) accH[pt] = (f32x4){0.f, 0.f, 0.f, 0.f};
    const int iw = wid < 4 ? wid : 11 - wid;
    const int i0 = iw * 16, n0 = wid * 16;
    v4u pbig[8], psm[5]; float pdt0 = 0.f, pdt1 = 0.f;
    const bf16* BCc = (const bf16*)a.out;
    constexpr int ACS_WAVE = 3;
#define SSD_ACS(sl, r0_, r1_) do { const float d0 = softplus_fast((r0_) + dtb), d1 = softplus_fast((r1_) + dtb); const float v0 = d0 * Ah, v1 = d1 * Ah, s_ = v0 + v1; float incl = s_; \
        _Pragma("unroll") for (int o_ = 1; o_ < 64; o_ <<= 1) { const float t_ = __shfl_up(incl, o_); if (lane >= o_) incl += t_; } \
        const float a0 = incl - s_ + v0, a1 = incl, last = __shfl(incl, 63); \
        ACS[(sl) * 128 + 2 * lane] = a0; ACS[(sl) * 128 + 2 * lane + 1] = a1; DTJ[(sl) * 128 + 2 * lane] = d0; DTJ[(sl) * 128 + 2 * lane + 1] = d1; \
        WJ[(sl) * 128 + 2 * lane] = exp_fast(last - a0) * d0; WJ[(sl) * 128 + 2 * lane + 1] = exp_fast(last - a1) * d1; if (lane == 0) MSC[sl] = exp_fast(last); \
        const float rt_ = __shfl(incl, (lane & 56) | 7); GJ[(sl) * 128 + 2 * lane] = exp_fast(fminf(rt_ - a0, 0.f)) * d0; GJ[(sl) * 128 + 2 * lane + 1] = exp_fast(fminf(rt_ - a1, 0.f)) * d1; } while (0)
#define SSD_PREFETCH(tc) do { OPQ_IDX(); const int hw_ = tid >> 8, cg_ = tid & 15, j0_ = 8 * ((tid >> 4) & 15); \
        const bf16* pb_ = BCc + (rowb + (tc) + j0_) * 512 + (hw_ ? 0 : 256) + g * 128 + cg_ * 8; \
        _Pragma("unroll") for (int i_ = 0; i_ < 8; ++i_) pbig[i_] = *(const v4u*)(pb_ + (size_t)i_ * 512); \
        const int cx_ = tid & 7, k0_ = 2 * (tid >> 3); const bf16* px_ = P + rowb * PW + 3072 + h * 64 + cx_ * 8; \
        _Pragma("unroll") for (int i_ = 0; i_ < 5; ++i_) { const int tt_ = (tc) + k0_ - 3 + i_; if (SSD_PF_GUARD) { psm[i_] = *(const v4u*)(px_ + (size_t)(tt_ < 0 ? 0 : tt_) * PW); if (tt_ < 0) psm[i_] = (v4u){0u, 0u, 0u, 0u}; } else psm[i_] = *(const v4u*)(px_ + (size_t)tt_ * PW); } \
        if (wid == ACS_WAVE) { pdt0 = DT[(rowb + (tc) + 2 * lane) * 16 + h]; pdt1 = DT[(rowb + (tc) + 2 * lane + 1) * 16 + h]; } } while (0)
    SPair sp; f32x4 sh0 = (f32x4){0.f, 0.f, 0.f, 0.f}, sh1 = sh0;
    if (spq >= 0) { OPQ_IDX(); sp_begin(sp, a, spq, lane); }
#define SSD_PF_GUARD true
    SSD_PREFETCH(0);
#undef SSD_PF_GUARD
#define SSD_PF_GUARD false
    if (wid == ACS_WAVE) { OPQ_IDX(); SSD_ACS(0, pdt0, pdt1); }
    __syncthreads();
#if defined(PROBE_MX)
    unsigned long long pt_[3] = {0, 0, 0}; unsigned long long tl_ = __builtin_amdgcn_s_memrealtime();
#define PSTAMP(k) do { const unsigned long long tn_ = __builtin_amdgcn_s_memrealtime(); pt_[k] += tn_ - tl_; tl_ = tn_; } while (0)
#else
#define PSTAMP(k) do { } while (0)
#endif
    for (int c = 0; c < SEQ / 128; ++c) {
        const int t0 = c * 128, sl = c & 1;
        {   OPQ_IDX();
            const int hw = tid >> 8, cg = tid & 15, j0 = 8 * ((tid >> 4) & 15);
#pragma unroll
            for (int jj = 0; jj < 8; ++jj) *(LAS v4u*)(lds + (hw ? L_BN : L_CN) + (j0 + jj) * MS + cg * 16) = pbig[jj];
            const int cx = tid & 7, k0 = 2 * (tid >> 3);
            ConvW cxv; { const LAS float* xw_ = (const LAS float*)(lds + L_XCW) + cx * 40;
#pragma unroll
                for (int k = 0; k < 4; ++k) { cxv.w[k][0] = *(const LAS f32x4*)(xw_ + k * 8); cxv.w[k][1] = *(const LAS f32x4*)(xw_ + k * 8 + 4); }
                cxv.b[0] = *(const LAS f32x4*)(xw_ + 32); cxv.b[1] = *(const LAS f32x4*)(xw_ + 36); }
            float s0[8], s1[8], s2[8], s3[8], s4[8], o0[8], o1[8];
            unpack8(psm[0], s0); unpack8(psm[1], s1); unpack8(psm[2], s2); unpack8(psm[3], s3); unpack8(psm[4], s4);
            conv_tok(cxv, s0, s1, s2, s3, o0); conv_tok(cxv, s1, s2, s3, s4, o1);
            const float w0 = WJ[sl * 128 + k0], w1 = WJ[sl * 128 + k0 + 1];
            float x0[8], x1[8];
#pragma unroll
            for (int q = 0; q < 8; ++q) { x0[q] = silu_fast(o0[q]); x1[q] = silu_fast(o1[q]); }
            *(LAS v4u*)(lds + L_XN + k0 * XNS + cx * 16) = (v4u){cvtpk(x0[0], x0[1]), cvtpk(x0[2], x0[3]), cvtpk(x0[4], x0[5]), cvtpk(x0[6], x0[7])};
            *(LAS v4u*)(lds + L_XN + (k0 + 1) * XNS + cx * 16) = (v4u){cvtpk(x1[0], x1[1]), cvtpk(x1[2], x1[3]), cvtpk(x1[4], x1[5]), cvtpk(x1[6], x1[7])};
            *(LAS v4u*)(lds + L_XWN + k0 * XNS + cx * 16) = (v4u){cvtpk(x0[0] * w0, x0[1] * w0), cvtpk(x0[2] * w0, x0[3] * w0), cvtpk(x0[4] * w0, x0[5] * w0), cvtpk(x0[6] * w0, x0[7] * w0)};
            *(LAS v4u*)(lds + L_XWN + (k0 + 1) * XNS + cx * 16) = (v4u){cvtpk(x1[0] * w1, x1[1] * w1), cvtpk(x1[2] * w1, x1[3] * w1), cvtpk(x1[4] * w1, x1[5] * w1), cvtpk(x1[6] * w1, x1[7] * w1)};
        }
        SSD_PREFETCH(t0 + 128);
        if (spq >= 0) sp_prefetch(sp, c, sh0, sh1);
        v4u zq[2];
        {   OPQ_IDX();
            const bf16* zp = P + (rowb + t0 + i0 + fr) * PW + 2048 + h * 64 + ((fq & 1) ? 16 + 4 * (fq - 1) : 4 * fq);
            zq[0] = *(const v4u*)zp; zq[1] = *(const v4u*)(zp + 32); }
        __syncthreads();
        PSTAMP(0);
        OPQ_IDX();
        f32x4 accY[4];
        {
            bf16x8 cf[4];
#pragma unroll
            for (int ks = 0; ks < 4; ++ks) cf[ks] = LDFRAG(L_CN, i0 + fr, ks);
            const int trq = (fr >> 2) & 3, trp = fr & 3;
            bf16x8 bt[4], wq[2][4];
#define ST_LOADW(pt_, s_) do { _Pragma("unroll") for (int ks_ = 0; ks_ < 4; ++ks_) { \
                const v2u w0_ = LDTR(lds + L_XWN + (32 * ks_ + 8 * fq + trq) * XNS + ((pt_) * 16 + 4 * trp) * 2), w1_ = LDTR(lds + L_XWN + (32 * ks_ + 8 * fq + 4 + trq) * XNS + ((pt_) * 16 + 4 * trp) * 2); \
                wq[s_][ks_] = __builtin_bit_cast(bf16x8, (v4u){w0_.x, w0_.y, w1_.x, w1_.y}); } } while (0)
#define ST_LOADH(pt_, s_) do { _Pragma("unroll") for (int ks_ = 0; ks_ < 4; ++ks_) wq[s_][ks_] = LDFRAG(L_H, (pt_) * 16 + fr, ks_); } while (0)
#pragma unroll
            for (int ks = 0; ks < 4; ++ks) { const v2u b0 = LDTR(lds + L_BN + (32 * ks + 8 * fq + trq) * MS + (n0 + 4 * trp) * 2), b1 = LDTR(lds + L_BN + (32 * ks + 8 * fq + 4 + trq) * MS + (n0 + 4 * trp) * 2);
                bt[ks] = __builtin_bit_cast(bf16x8, (v4u){b0.x, b0.y, b1.x, b1.y}); }
            ST_LOADW(0, 0);
            const float dec = MSC[sl];
            const float acs_i = ACS[sl * 128 + i0 + fr], e_i = exp_fast(acs_i);
            __builtin_amdgcn_sched_barrier(0);
#pragma unroll
            for (int pt = 0; pt < 4; ++pt) {
                if (pt < 3) ST_LOADW(pt + 1, (pt + 1) & 1); else ST_LOADH(0, 0);
                __builtin_amdgcn_sched_barrier(0);
                accH[pt] = accH[pt] * dec;
#pragma unroll
                for (int ks = 0; ks < 4; ++ks) accH[pt] = MFMA16(bt[ks], wq[pt & 1][ks], accH[pt]);
                __builtin_amdgcn_sched_barrier(0); }
#pragma unroll
            for (int pt = 0; pt < 4; ++pt) {
                if (pt < 3) ST_LOADH(pt + 1, (pt + 1) & 1);
                __builtin_amdgcn_sched_barrier(0);
                f32x4 acc = (f32x4){0.f, 0.f, 0.f, 0.f};
#pragma unroll
                for (int ks = 0; ks < 4; ++ks) acc = MFMA16(wq[pt & 1][ks], cf[ks], acc);
                accY[pt] = acc * e_i;
                __builtin_amdgcn_sched_barrier(0); }
#undef ST_LOADW
#undef ST_LOADH
            switch (iw >> 1) {
                case 0: ssd_tri<0>(lds, sl, i0, fr, fq, cf, acs_i, accY); break;
                case 1: ssd_tri<1>(lds, sl, i0, fr, fq, cf, acs_i, accY); break;
                case 2: ssd_tri<2>(lds, sl, i0, fr, fq, cf, acs_i, accY); break;
                default: ssd_tri<3>(lds, sl, i0, fr, fq, cf, acs_i, accY); break; }
#pragma unroll
            for (int pt = 0; pt < 4; ++pt) { const v2u xd = *(const LAS v2u*)(lds + L_XN + (i0 + fr) * XNS + (pt * 16 + 4 * fq) * 2);
                accY[pt][0] += Dh * bf_lo(xd.x); accY[pt][1] += Dh * bf_hi(xd.x); accY[pt][2] += Dh * bf_lo(xd.y); accY[pt][3] += Dh * bf_hi(xd.y); }
            if (wid == ACS_WAVE && c + 1 < SEQ / 128) SSD_ACS(sl ^ 1, pdt0, pdt1);
        }
        __syncthreads();
        PSTAMP(1);
        {
#pragma unroll
            for (int pt = 0; pt < 4; ++pt) { v2u w; w.x = cvtpk(accH[pt][0], accH[pt][1]); w.y = cvtpk(accH[pt][2], accH[pt][3]);
                *(LAS v2u*)(lds + L_H + (pt * 16 + fr) * MS + (n0 + 4 * fq) * 2) = w; }
            const size_t row = rowb + t0 + i0 + fr; float ss = 0.f;
            v2u zr[4];
#pragma unroll
            for (int pp = 0; pp < 2; ++pp) {
                const auto r0 = __builtin_amdgcn_permlane16_swap(zq[pp].x, zq[pp].z, false, false), r1 = __builtin_amdgcn_permlane16_swap(zq[pp].y, zq[pp].w, false, false);
                zr[2 * pp].x = r0[0]; zr[2 * pp].y = r1[0]; zr[2 * pp + 1].x = r0[1]; zr[2 * pp + 1].y = r1[1]; }
            v2u wo[4];
#pragma unroll
            for (int pt = 0; pt < 4; ++pt) {
                const float z[4] = {bf_lo(zr[pt].x), bf_hi(zr[pt].x), bf_lo(zr[pt].y), bf_hi(zr[pt].y)};
                float gv[4];
#pragma unroll
                for (int r = 0; r < 4; ++r) { gv[r] = accY[pt][r] * silu_fast(z[r]); ss += gv[r] * gv[r]; }
                wo[pt].x = cvtpk(gv[0], gv[1]); wo[pt].y = cvtpk(gv[2], gv[3]); }
            {   bf16* zp = P + row * PW + 2048 + h * 64 + ((fq & 1) ? 16 + 4 * (fq - 1) : 4 * fq);
#pragma unroll
                for (int pp = 0; pp < 2; ++pp) {
                    const auto r0 = __builtin_amdgcn_permlane16_swap(wo[2 * pp].x, wo[2 * pp + 1].x, false, false), r1 = __builtin_amdgcn_permlane16_swap(wo[2 * pp].y, wo[2 * pp + 1].y, false, false);
                    *(v4u*)(zp + pp * 32) = (v4u){r0[0], r1[0], r0[1], r1[1]}; } }
            ss = pg8::bfly16(ss, ss); ss = pg8::bfly32(ss, ss);
            if (fq == 0) SSS[row * 16 + h] = ss;
            if (spq >= 0) sp_step(sp, c, sh0, sh1, lane);
        }
        PSTAMP(2);
    }
#if defined(PROBE_MX)
    if (b == 0 && h == 0 && tid_in == 0) { unsigned long long* tp_ = (unsigned long long*)(a.ws + WS_CTL + 8192); tp_[8] = pt_[0]; tp_[9] = pt_[1]; tp_[10] = pt_[2]; }
#endif
    if (spq >= 0) { OPQ_IDX(); sp_end(sp, lane); }
    {   OPQ_IDX();
#pragma unroll
        for (int pt = 0; pt < 4; ++pt) *(f32x4*)(a.out + O_PSH + ((size_t)(b * NHEAD + h) * 64 + pt * 16 + fr) * 128 + n0 + 4 * fq) = accH[pt];
        for (int i = tid; i < 3 * 64; i += 512) { const int k = i >> 6, ch = h * 64 + (i & 63);
            a.out[O_PSC + (size_t)(b * 3 + k) * DXBC + ch] = bf1(P + (rowb + SEQ - 3 + k) * PW + 3072 + ch); }
        if ((h & 7) == 0) for (int i = tid; i < 3 * 256; i += 512) { const int k = i >> 8, ch = 1024 + ((i >> 7) & 1) * 256 + g * 128 + (i & 127);
            a.out[O_PSC + (size_t)(b * 3 + k) * DXBC + ch] = bf1(P + (rowb + SEQ - 3 + k) * PW + 3072 + ch); }
    }
    __syncthreads();
}

constexpr int XS = 144, LF = 68;
constexpr int LL_XC = 0, LL_WA = 18432, LL_WX = 27648, LL_XF = 36864, LL_A = 71680, LL_U = 106496, LL_SEGP = 141312, LL_SEGH = 143360, LL_HC = 145408, LL_PAR = 145920;
constexpr int LL_CW = 146688;
constexpr int LL_SEG2 = LL_CW + 1280;
static_assert(LL_SEG2 + 4096 <= MISC_OFF, "lru LDS map");
__device__ __forceinline__ float sigmoid_fast(float x) { return __builtin_amdgcn_rcpf(1.0f + __builtin_amdgcn_exp2f(-1.44269504f * x)); }
__device__ __forceinline__ float gelu_tanh_fast(float y) { const float v = 0.7978845608f * (y + 0.044715f * y * y * y); const float th = 1.0f - 2.0f * __builtin_amdgcn_rcpf(__builtin_amdgcn_exp2f(2.88539008f * v) + 1.0f); return 0.5f * y * (1.0f + th); }
__device__ __forceinline__ float one_minus_exp(float x) {
    const float ser = -x * (1.0f + x * (0.5f + x * (0.16666667f + x * (0.041666668f + x * (0.0083333338f + x * 0.0013888889f)))));
    const float dir = 1.0f - __builtin_amdgcn_exp2f(1.44269504f * x);
    return x > -0.3f ? ser : dir;
}
#define OPQ_IDX2() int tid = tid_in; asm volatile("" : "+v"(tid)); const int lane = tid & 63, fr = lane & 15, fq = lane >> 4; (void)fr; (void)fq; (void)lane

template <bool SAMPLE>
__device__ __forceinline__ void lru_unit_fast(const Args& a, LAS unsigned char* lds, int b, int hd, int tid_in, int wid) {
    bf16* P = (bf16*)(a.ws + WS_P); float* SSL = (float*)(a.ws + WS_SSL);
    const size_t rowb = SAMPLE ? (size_t)TP : (size_t)b * SEQ;
    LAS float* XF = (LAS float*)(lds + LL_XF); LAS float* AA = (LAS float*)(lds + LL_A); LAS float* UU = (LAS float*)(lds + LL_U);
    LAS float* SEGP = (LAS float*)(lds + LL_SEGP); LAS float* SEGH = (LAS float*)(lds + LL_SEGH); LAS float* HC = (LAS float*)(lds + LL_HC); LAS float* PAR = (LAS float*)(lds + LL_PAR);
    {   OPQ_IDX2();
        const float* Wa = a.in[I_LGAW] + (size_t)hd * 4096; const float* Wx = a.in[I_LGXW] + (size_t)hd * 4096;
        for (int idx = tid; idx < 4096; idx += 512) { const int i = idx >> 6, j = idx & 63;
            *(LAS unsigned short*)(lds + LL_WA + j * XS + i * 2) = (unsigned short)f2bf(Wa[idx]);
            *(LAS unsigned short*)(lds + LL_WX + j * XS + i * 2) = (unsigned short)f2bf(Wx[idx]); }
        if (tid < 64) { const int ch = hd * 64 + tid; PAR[tid] = a.in[I_LGAB][ch]; PAR[64 + tid] = a.in[I_LGXB][ch]; PAR[128 + tid] = 8.0f * softplus_f(-a.in[I_LAM][ch]); HC[tid] = 0.f; HC[64 + tid] = 0.f; }
    }
    __syncthreads();
    const int nchunk = SAMPLE ? 1 : SEQ / 128;
    for (int c = 0; c < nchunk; ++c) {
        const int t0 = c * 128;
        {   OPQ_IDX2();
            const int cg = tid & 7, j0 = 2 * (tid >> 3), ch0 = hd * 64 + cg * 8;
            const float* cw = a.in[I_LCW]; const float* cb = a.in[I_LCB];
            f32x4 w[4][2], bb[2];
#pragma unroll
            for (int k = 0; k < 4; ++k) { w[k][0] = *(const f32x4*)(cw + k * DLRU + ch0); w[k][1] = *(const f32x4*)(cw + k * DLRU + ch0 + 4); }
            bb[0] = *(const f32x4*)(cb + ch0); bb[1] = *(const f32x4*)(cb + ch0 + 4);
            if (!SAMPLE) {
                float xin[5][8];
#pragma unroll
                for (int i = 0; i < 5; ++i) { const int tt = t0 + j0 - 3 + i, ttc = tt < 0 ? 0 : tt;
                    v4u v = *(const v4u*)(P + (rowb + ttc) * PW + ch0);
                    if (tt < 0) v = (v4u){0u, 0u, 0u, 0u};
                    xin[i][0] = bf_lo(v.x); xin[i][1] = bf_hi(v.x); xin[i][2] = bf_lo(v.y); xin[i][3] = bf_hi(v.y); xin[i][4] = bf_lo(v.z); xin[i][5] = bf_hi(v.z); xin[i][6] = bf_lo(v.w); xin[i][7] = bf_hi(v.w); }
#pragma unroll
                for (int jj = 0; jj < 2; ++jj) { float o[8];
#pragma unroll
                    for (int q = 0; q < 8; ++q) o[q] = bb[q >> 2][q & 3] + w[0][q >> 2][q & 3] * xin[jj][q] + w[1][q >> 2][q & 3] * xin[jj + 1][q] + w[2][q >> 2][q & 3] * xin[jj + 2][q] + w[3][q >> 2][q & 3] * xin[jj + 3][q];
                    *(LAS f32x4*)(XF + (j0 + jj) * LF + cg * 8) = (f32x4){o[0], o[1], o[2], o[3]}; *(LAS f32x4*)(XF + (j0 + jj) * LF + cg * 8 + 4) = (f32x4){o[4], o[5], o[6], o[7]};
                    v4u pw; pw.x = pg8::cvt_pk_bf16(o[0], o[1]); pw.y = pg8::cvt_pk_bf16(o[2], o[3]); pw.z = pg8::cvt_pk_bf16(o[4], o[5]); pw.w = pg8::cvt_pk_bf16(o[6], o[7]);
                    *(LAS v4u*)(lds + LL_XC + (j0 + jj) * XS + cg * 16) = pw; }
            } else {
#pragma unroll
                for (int jj = 0; jj < 2; ++jj) { const int s = j0 + jj;
                    const v4u v = *(const v4u*)(P + (rowb + s) * PW + ch0);
                    const float xn[8] = {bf_lo(v.x), bf_hi(v.x), bf_lo(v.y), bf_hi(v.y), bf_lo(v.z), bf_hi(v.z), bf_lo(v.w), bf_hi(v.w)};
                    const float* sb = a.in[I_SLC] + (size_t)s * 3 * DLRU + ch0; float* so = a.out + O_SLC + (size_t)s * 3 * DLRU + ch0;
                    f32x4 h0[2], h1[2], h2[2];
#pragma unroll
                    for (int q = 0; q < 2; ++q) { h0[q] = *(const f32x4*)(sb + 4 * q); h1[q] = *(const f32x4*)(sb + DLRU + 4 * q); h2[q] = *(const f32x4*)(sb + 2 * DLRU + 4 * q); }
                    float o[8];
#pragma unroll
                    for (int q = 0; q < 8; ++q) o[q] = bb[q >> 2][q & 3] + w[0][q >> 2][q & 3] * h0[q >> 2][q & 3] + w[1][q >> 2][q & 3] * h1[q >> 2][q & 3] + w[2][q >> 2][q & 3] * h2[q >> 2][q & 3] + w[3][q >> 2][q & 3] * xn[q];
#pragma unroll
                    for (int q = 0; q < 2; ++q) { *(f32x4*)(so + 4 * q) = h1[q]; *(f32x4*)(so + DLRU + 4 * q) = h2[q]; *(f32x4*)(so + 2 * DLRU + 4 * q) = (f32x4){xn[4 * q], xn[4 * q + 1], xn[4 * q + 2], xn[4 * q + 3]}; }
                    *(LAS f32x4*)(XF + s * LF + cg * 8) = (f32x4){o[0], o[1], o[2], o[3]}; *(LAS f32x4*)(XF + s * LF + cg * 8 + 4) = (f32x4){o[4], o[5], o[6], o[7]};
                    v4u pw; pw.x = pg8::cvt_pk_bf16(o[0], o[1]); pw.y = pg8::cvt_pk_bf16(o[2], o[3]); pw.z = pg8::cvt_pk_bf16(o[4], o[5]); pw.w = pg8::cvt_pk_bf16(o[6], o[7]);
                    *(LAS v4u*)(lds + LL_XC + s * XS + cg * 16) = pw; }
            }
        }
        __syncthreads();
        {   OPQ_IDX2();
            const int tok = wid * 16 + fr;
            bf16x8 xf[2];
#pragma unroll
            for (int ks = 0; ks < 2; ++ks) xf[ks] = *(const LAS bf16x8*)(lds + LL_XC + tok * XS + ks * 64 + fq * 16);
#pragma unroll
            for (int jt = 0; jt < 4; ++jt) {
                f32x4 ga = (f32x4){0.f, 0.f, 0.f, 0.f}, gx = (f32x4){0.f, 0.f, 0.f, 0.f};
#pragma unroll
                for (int ks = 0; ks < 2; ++ks) {
                    ga = MFMA16(*(const LAS bf16x8*)(lds + LL_WA + (jt * 16 + fr) * XS + ks * 64 + fq * 16), xf[ks], ga);
                    gx = MFMA16(*(const LAS bf16x8*)(lds + LL_WX + (jt * 16 + fr) * XS + ks * 64 + fq * 16), xf[ks], gx); }
                const int j = jt * 16 + 4 * fq;
                const f32x4 ba = *(const LAS f32x4*)(PAR + j), bx = *(const LAS f32x4*)(PAR + 64 + j), sp = *(const LAS f32x4*)(PAR + 128 + j), xc = *(const LAS f32x4*)(XF + tok * LF + j);
                f32x4 av, uv;
#pragma unroll
                for (int r = 0; r < 4; ++r) { const float rr = sigmoid_fast(ga[r] + ba[r]), ig = sigmoid_fast(gx[r] + bx[r]), la = -rr * sp[r];
                    av[r] = __builtin_amdgcn_exp2f(1.44269504f * la); uv[r] = __builtin_amdgcn_sqrtf(fmaxf(fmaf(-av[r], av[r], 1.0f), 0.f)) * (ig * xc[r]); }
                *(LAS f32x4*)(AA + tok * LF + j) = av; *(LAS f32x4*)(UU + tok * LF + j) = uv;
            }
        }
        __syncthreads();
        if (!SAMPLE) {
            OPQ_IDX2();
            float cp[16], hl[16]; float pp = 1.f, hh = 0.f;
#pragma unroll
            for (int t = 0; t < 16; ++t) { const float at = AA[(wid * 16 + t) * LF + lane], ut = UU[(wid * 16 + t) * LF + lane]; pp *= at; hh = at * hh + ut; cp[t] = pp; hl[t] = hh; }
            SEGP[wid * 64 + lane] = pp; SEGH[wid * 64 + lane] = hh;
            __syncthreads();
            float cin = HC[(c & 1) * 64 + lane];
            for (int s = 0; s < wid; ++s) cin = SEGP[s * 64 + lane] * cin + SEGH[s * 64 + lane];
            if (wid == 7) HC[((c + 1) & 1) * 64 + lane] = hl[15] + cp[15] * cin;
            const int ch = hd * 64 + lane;
#pragma unroll
            for (int t = 0; t < 16; ++t) { const size_t row = rowb + t0 + wid * 16 + t; bf16* yp = P + row * PW + DLRU + ch;
                const float ht = hl[t] + cp[t] * cin, gv = ht * gelu_tanh_fast(bf1(yp));
                const float ss = wave_sum(gv * gv);
                *yp = f2bf1(gv);
                if (lane == 0) SSL[row * 16 + hd] = ss; }
            if (c == nchunk - 1 && wid == 7) a.out[O_PLH + (size_t)b * DLRU + ch] = hl[15] + cp[15] * cin;
        } else {
            OPQ_IDX2();
            const int ch = hd * 64 + lane;
#pragma unroll
            for (int t = 0; t < 16; ++t) { const int s = wid * 16 + t; const size_t row = rowb + s; bf16* yp = P + row * PW + DLRU + ch;
                const float ht = AA[s * LF + lane] * a.in[I_SLH][(size_t)s * DLRU + ch] + UU[s * LF + lane];
                a.out[O_SLH + (size_t)s * DLRU + ch] = ht;
                const float gv = ht * gelu_tanh_fast(bf1(yp));
                const float ss = wave_sum(gv * gv);
                *yp = f2bf1(gv);
                if (lane == 0) SSL[row * 16 + hd] = ss; }
        }
    }
    if (!SAMPLE) {
        OPQ_IDX2();
        for (int i = tid; i < 3 * 64; i += 512) { const int k = i >> 6, ch = hd * 64 + (i & 63);
            a.out[O_PLC + (size_t)(b * 3 + k) * DLRU + ch] = bf1(P + (rowb + SEQ - 3 + k) * PW + ch); }
    }
    __syncthreads();
}

__device__ __forceinline__ void lru_unit_prompt(const Args& a, LAS unsigned char* lds, int b, int hd, int tid_in, int wid, int spq, int spq2) {
    bf16* P = (bf16*)(a.ws + WS_P); float* SSL = (float*)(a.ws + WS_SSL);
    const size_t rowb = (size_t)b * SEQ;
    LAS float* XF = (LAS float*)(lds + LL_XF); LAS float* AA = (LAS float*)(lds + LL_A); LAS float* UU = (LAS float*)(lds + LL_U);
    LAS float* SEGP = (LAS float*)(lds + LL_SEGP); LAS float* SEGH = (LAS float*)(lds + LL_SEGH); LAS float* HC = (LAS float*)(lds + LL_HC); LAS float* PAR = (LAS float*)(lds + LL_PAR);
    v4u px[5]; v4u pyv[2];
#define LRU_PREF_X(tc) do { OPQ_IDX2(); const bf16* pp_ = P + rowb * PW + hd * 64 + (tid & 7) * 8; const int j0_ = 2 * (tid >> 3); \
        _Pragma("unroll") for (int i_ = 0; i_ < 5; ++i_) { const int tt_ = (tc) + j0_ - 3 + i_; if (LRU_PF_GUARD) { px[i_] = *(const v4u*)(pp_ + (size_t)(tt_ < 0 ? 0 : tt_) * PW); if (tt_ < 0) px[i_] = (v4u){0u, 0u, 0u, 0u}; } else px[i_] = *(const v4u*)(pp_ + (size_t)tt_ * PW); } } while (0)
#define LRU_PREF_Y(tc) do { OPQ_IDX2(); const bf16* yp_ = P + (rowb + (tc) + wid * 16 + fr) * PW + DLRU + hd * 64 + fq * 16; \
        pyv[0] = *(const v4u*)yp_; pyv[1] = *(const v4u*)(yp_ + 8); } while (0)
#define LRU_CONV() do { OPQ_IDX2(); const int cg = tid & 7, j0 = 2 * (tid >> 3); ConvW cv; { const LAS float* cw_ = (const LAS float*)(lds + LL_CW) + cg * 40; \
        _Pragma("unroll") for (int k_ = 0; k_ < 4; ++k_) { cv.w[k_][0] = *(const LAS f32x4*)(cw_ + k_ * 8); cv.w[k_][1] = *(const LAS f32x4*)(cw_ + k_ * 8 + 4); } cv.b[0] = *(const LAS f32x4*)(cw_ + 32); cv.b[1] = *(const LAS f32x4*)(cw_ + 36); } \
        float s0[8], s1[8], s2[8], s3[8], s4[8], o0[8], o1[8]; unpack8(px[0], s0); unpack8(px[1], s1); unpack8(px[2], s2); unpack8(px[3], s3); unpack8(px[4], s4); \
        conv_tok(cv, s0, s1, s2, s3, o0); conv_tok(cv, s1, s2, s3, s4, o1); \
        *(LAS f32x4*)(XF + j0 * LF + cg * 8) = (f32x4){o0[0], o0[1], o0[2], o0[3]}; *(LAS f32x4*)(XF + j0 * LF + cg * 8 + 4) = (f32x4){o0[4], o0[5], o0[6], o0[7]}; \
        *(LAS f32x4*)(XF + (j0 + 1) * LF + cg * 8) = (f32x4){o1[0], o1[1], o1[2], o1[3]}; *(LAS f32x4*)(XF + (j0 + 1) * LF + cg * 8 + 4) = (f32x4){o1[4], o1[5], o1[6], o1[7]}; \
        *(LAS v4u*)(lds + LL_XC + j0 * XS + cg * 16) = (v4u){pg8::cvt_pk_bf16(o0[0], o0[1]), pg8::cvt_pk_bf16(o0[2], o0[3]), pg8::cvt_pk_bf16(o0[4], o0[5]), pg8::cvt_pk_bf16(o0[6], o0[7])}; \
        *(LAS v4u*)(lds + LL_XC + (j0 + 1) * XS + cg * 16) = (v4u){pg8::cvt_pk_bf16(o1[0], o1[1]), pg8::cvt_pk_bf16(o1[2], o1[3]), pg8::cvt_pk_bf16(o1[4], o1[5]), pg8::cvt_pk_bf16(o1[6], o1[7])}; } while (0)
#define LRU_PF_GUARD true
    LRU_PREF_X(0); LRU_PREF_Y(0);
#undef LRU_PF_GUARD
#define LRU_PF_GUARD false
    {   OPQ_IDX2();
        const float* Wa = a.in[I_LGAW] + (size_t)hd * 4096; const float* Wx = a.in[I_LGXW] + (size_t)hd * 4096;
        float wa_[8], wx_[8];
#pragma unroll
        for (int q = 0; q < 8; ++q) { wa_[q] = __builtin_nontemporal_load(Wa + tid + 512 * q); wx_[q] = __builtin_nontemporal_load(Wx + tid + 512 * q); }
#pragma unroll
        for (int q = 0; q < 8; ++q) { const int idx = tid + 512 * q, i = idx >> 6, j = idx & 63;
            *(LAS unsigned short*)(lds + LL_WA + j * XS + i * 2) = (unsigned short)f2bf(wa_[q]);
            *(LAS unsigned short*)(lds + LL_WX + j * XS + i * 2) = (unsigned short)f2bf(wx_[q]); }
        if (tid < 64) { const int ch = hd * 64 + tid; PAR[tid] = a.in[I_LGAB][ch]; PAR[64 + tid] = a.in[I_LGXB][ch]; PAR[128 + tid] = 8.0f * softplus_f(-a.in[I_LAM][ch]); HC[tid] = 0.f; HC[64 + tid] = 0.f;
            LAS float* cw_ = (LAS float*)(lds + LL_CW) + (tid >> 3) * 40 + (tid & 7); const float* gw_ = a.in[I_LCW];
            cw_[0] = gw_[ch]; cw_[8] = gw_[DLRU + ch]; cw_[16] = gw_[2 * DLRU + ch]; cw_[24] = gw_[3 * DLRU + ch]; cw_[32] = a.in[I_LCB][ch]; }
    }
    SPair sp, sp2; f32x4 sh0 = (f32x4){0.f, 0.f, 0.f, 0.f}, sh1 = sh0, sh2 = sh0, sh3 = sh0;
    if (spq >= 0 && spq2 >= 0) { OPQ_IDX2(); SPRaw r1_, r2_; sp_load(r1_, a, spq, lane); sp_load(r2_, a, spq2, lane);
        asm volatile("s_waitcnt vmcnt(0)" ::: "memory"); sp_finish(sp, r1_, a, spq, lane); sp_finish(sp2, r2_, a, spq2, lane); }
    else { if (spq >= 0) { OPQ_IDX2(); sp_begin(sp, a, spq, lane); }
           if (spq2 >= 0) { OPQ_IDX2(); sp_begin(sp2, a, spq2, lane); } }
    __syncthreads();
    LRU_CONV();
    for (int c = 0; c < SEQ / 128; ++c) {
        const int t0 = c * 128;
        asm volatile("s_waitcnt lgkmcnt(0)" ::: "memory");
        LAS float* SEGPc = (c & 1) ? (LAS float*)(lds + LL_SEG2) : SEGP; LAS float* SEGHc = (c & 1) ? (LAS float*)(lds + LL_SEG2 + 2048) : SEGH;
        {   OPQ_IDX2();
            const int tok = wid * 16 + fr;
            bf16x8 xf[2];
#pragma unroll
            for (int ks = 0; ks < 2; ++ks) xf[ks] = *(const LAS bf16x8*)(lds + LL_XC + tok * XS + ks * 64 + fq * 16);
            bf16x8 gw[2][4]; f32x4 gp[2][4];
#define LRU_LOADJ(jt_, s_) do { _Pragma("unroll") for (int ks_ = 0; ks_ < 2; ++ks_) { \
                    gw[s_][2 * ks_] = *(const LAS bf16x8*)(lds + LL_WA + ((jt_) * 16 + fr) * XS + ks_ * 64 + fq * 16); gw[s_][2 * ks_ + 1] = *(const LAS bf16x8*)(lds + LL_WX + ((jt_) * 16 + fr) * XS + ks_ * 64 + fq * 16); } \
                gp[s_][0] = *(const LAS f32x4*)(PAR + (jt_) * 16 + 4 * fq); gp[s_][1] = *(const LAS f32x4*)(PAR + 64 + (jt_) * 16 + 4 * fq); gp[s_][2] = *(const LAS f32x4*)(PAR + 128 + (jt_) * 16 + 4 * fq); \
                gp[s_][3] = *(const LAS f32x4*)(XF + tok * LF + (jt_) * 16 + 4 * fq); } while (0)
            LRU_LOADJ(0, 0);
            __builtin_amdgcn_sched_barrier(0);
#pragma unroll
            for (int jt = 0; jt < 4; ++jt) {
                if (jt < 3) LRU_LOADJ(jt + 1, (jt + 1) & 1);
                __builtin_amdgcn_sched_barrier(0);
                f32x4 ga = (f32x4){0.f, 0.f, 0.f, 0.f}, gx = (f32x4){0.f, 0.f, 0.f, 0.f};
#pragma unroll
                for (int ks = 0; ks < 2; ++ks) { ga = MFMA16(gw[jt & 1][2 * ks], xf[ks], ga); gx = MFMA16(gw[jt & 1][2 * ks + 1], xf[ks], gx); }
                const int j = jt * 16 + 4 * fq;
                const f32x4 ba = gp[jt & 1][0], bx = gp[jt & 1][1], sp = gp[jt & 1][2], xc = gp[jt & 1][3];
                f32x4 av, uv;
#pragma unroll
                for (int r = 0; r < 4; ++r) { const float rr = sigmoid_fast(ga[r] + ba[r]), ig = sigmoid_fast(gx[r] + bx[r]), la = -rr * sp[r];
                    av[r] = __builtin_amdgcn_exp2f(1.44269504f * la); uv[r] = __builtin_amdgcn_sqrtf(fmaxf(fmaf(-av[r], av[r], 1.0f), 0.f)) * (ig * xc[r]); }
                *(LAS f32x4*)(AA + tok * LF + j) = av; *(LAS f32x4*)(UU + tok * LF + j) = uv;
                __builtin_amdgcn_sched_barrier(0);
            }
#undef LRU_LOADJ
        }
        LRU_PREF_X(t0 + 128);
        if (spq >= 0) sp_prefetch(sp, c, sh0, sh1);
        if (spq2 >= 0) sp_prefetch(sp2, c, sh2, sh3);
        asm volatile("s_waitcnt lgkmcnt(0)" ::: "memory");
        OPQ_IDX2();
        float cp[16], hl[16]; float pp = 1.f, hh = 0.f;
#pragma unroll
        for (int t = 0; t < 16; ++t) { const float at = AA[(wid * 16 + t) * LF + lane], ut = UU[(wid * 16 + t) * LF + lane]; pp *= at; hh = at * hh + ut; cp[t] = pp; hl[t] = hh; }
        SEGPc[wid * 64 + lane] = pp; SEGHc[wid * 64 + lane] = hh;
        __syncthreads();
        float cin = HC[(c & 1) * 64 + lane];
        {   float sp_[7], sh_[7];
#pragma unroll
            for (int s = 0; s < 7; ++s) { sp_[s] = SEGPc[s * 64 + lane]; sh_[s] = SEGHc[s * 64 + lane]; }
#pragma unroll
            for (int s = 0; s < 7; ++s) { const float nx = sp_[s] * cin + sh_[s]; cin = s < wid ? nx : cin; } }
        const float hlast = hl[15] + cp[15] * cin;
        if (wid == 7) HC[((c + 1) & 1) * 64 + lane] = hlast;
        const int ch = hd * 64 + lane;
        float sq[16];
        {   LAS unsigned char* T_ = lds + LL_A + (wid * 16) * (LF * 4);
            LAS unsigned char* O_ = lds + LL_U + (wid * 16) * (LF * 4);
            const int trq = (fr >> 2) & 3, trp = fr & 3;
            *(LAS v4u*)(T_ + fr * 144 + fq * 32) = pyv[0]; *(LAS v4u*)(T_ + fr * 144 + fq * 32 + 16) = pyv[1];
            asm volatile("s_waitcnt lgkmcnt(0)" ::: "memory");
            v2u yq[4];
#pragma unroll
            for (int tb = 0; tb < 4; ++tb) yq[tb] = LDTR(T_ + (4 * tb + trq) * 144 + (fq * 16 + 4 * trp) * 2);
            unsigned ow[8];
#pragma unroll
            for (int tb = 0; tb < 4; ++tb) {
                const float y0 = bf_lo(yq[tb].x), y1 = bf_hi(yq[tb].x), y2 = bf_lo(yq[tb].y), y3 = bf_hi(yq[tb].y);
                const float g0 = (hl[4 * tb + 0] + cp[4 * tb + 0] * cin) * gelu_tanh_fast(y0), g1 = (hl[4 * tb + 1] + cp[4 * tb + 1] * cin) * gelu_tanh_fast(y1),
                            g2 = (hl[4 * tb + 2] + cp[4 * tb + 2] * cin) * gelu_tanh_fast(y2), g3 = (hl[4 * tb + 3] + cp[4 * tb + 3] * cin) * gelu_tanh_fast(y3);
                sq[4 * tb + 0] = g0 * g0; sq[4 * tb + 1] = g1 * g1; sq[4 * tb + 2] = g2 * g2; sq[4 * tb + 3] = g3 * g3;
                ow[2 * tb] = cvtpk(g0, g1); ow[2 * tb + 1] = cvtpk(g2, g3); }
            *(LAS v4u*)(O_ + lane * 48) = (v4u){ow[0], ow[1], ow[2], ow[3]}; *(LAS v4u*)(O_ + lane * 48 + 16) = (v4u){ow[4], ow[5], ow[6], ow[7]};
            asm volatile("s_waitcnt lgkmcnt(0)" ::: "memory");
            v2u oq[4];
#pragma unroll
            for (int r = 0; r < 4; ++r) oq[r] = LDTR(O_ + (fq * 16 + 4 * r + trq) * 48 + (4 * trp) * 2);
            bf16* yo = P + (rowb + t0 + wid * 16 + fr) * PW + DLRU + hd * 64 + fq * 16;
            *(v4u*)yo = (v4u){oq[0].x, oq[0].y, oq[1].x, oq[1].y}; *(v4u*)(yo + 8) = (v4u){oq[2].x, oq[2].y, oq[3].x, oq[3].y}; }
        {
            float w8[8], w4[4], w2[2], w1;
            const bool u5 = lane & 32, u4 = lane & 16, u3 = lane & 8, u2 = lane & 4;
#pragma unroll
            for (int k = 0; k < 8; ++k) w8[k] = pg8::bfly32(sq[k], sq[k + 8]);
#pragma unroll
            for (int k = 0; k < 4; ++k) w4[k] = pg8::bfly16(w8[k], w8[k + 4]);
#pragma unroll
            for (int k = 0; k < 2; ++k) { const float keep = u3 ? w4[k + 2] : w4[k], send = u3 ? w4[k] : w4[k + 2]; w2[k] = keep + __shfl_xor(send, 8); }
            { const float keep = u2 ? w2[1] : w2[0], send = u2 ? w2[0] : w2[1]; w1 = keep + __shfl_xor(send, 4); }
            w1 += __shfl_xor(w1, 2); w1 += __shfl_xor(w1, 1);
            const int tsel = ((lane >> 5) & 1) * 8 + ((lane >> 4) & 1) * 4 + ((lane >> 3) & 1) * 2 + ((lane >> 2) & 1);
            if ((lane & 3) == 0) SSL[(rowb + t0 + wid * 16 + tsel) * 16 + hd] = w1; }
        if (spq >= 0) sp_step(sp, c, sh0, sh1, lane);
        if (spq2 >= 0) sp_step(sp2, c, sh2, sh3, lane);
        if (c == SEQ / 128 - 1 && wid == 7) a.out[O_PLH + (size_t)b * DLRU + ch] = hlast;
        if (c + 1 < SEQ / 128) { LRU_PREF_Y(t0 + 128); LRU_CONV(); }
    }
    if (spq >= 0) { OPQ_IDX2(); sp_end(sp, lane); }
    if (spq2 >= 0) { OPQ_IDX2(); sp_end(sp2, lane); }
    __syncthreads();
    float dh_[2], dy_[2];
    {   OPQ_IDX2(); const int ch = hd * 64 + lane;
#pragma unroll
        for (int t = 0; t < 2; ++t) { const int sl = wid * 2 + t, sq = 16 * b + sl; dh_[t] = a.in[I_SLH][(size_t)sq * DLRU + ch]; dy_[t] = bf1(P + ((size_t)TP + sq) * PW + DLRU + ch); } }
    if (wid < 2) {   OPQ_IDX2();
        const int cg = tid & 7, sl = tid >> 3, sq = 16 * b + sl, ch0 = hd * 64 + cg * 8;
        ConvW cv; load_convw(cv, a.in[I_LCW], a.in[I_LCB], DLRU, ch0);
        const v4u v = *(const v4u*)(P + ((size_t)TP + sq) * PW + ch0);
        float xn[8]; unpack8(v, xn);
        const float* sb = a.in[I_SLC] + (size_t)sq * 3 * DLRU + ch0; float* so = a.out + O_SLC + (size_t)sq * 3 * DLRU + ch0;
        f32x4 h0[2], h1[2], h2[2];
#pragma unroll
        for (int q = 0; q < 2; ++q) { h0[q] = *(const f32x4*)(sb + 4 * q); h1[q] = *(const f32x4*)(sb + DLRU + 4 * q); h2[q] = *(const f32x4*)(sb + 2 * DLRU + 4 * q); }
        float o[8];
#pragma unroll
        for (int q = 0; q < 8; ++q) o[q] = cv.b[q >> 2][q & 3] + cv.w[0][q >> 2][q & 3] * h0[q >> 2][q & 3] + cv.w[1][q >> 2][q & 3] * h1[q >> 2][q & 3] + cv.w[2][q >> 2][q & 3] * h2[q >> 2][q & 3] + cv.w[3][q >> 2][q & 3] * xn[q];
#pragma unroll
        for (int q = 0; q < 2; ++q) { *(f32x4*)(so + 4 * q) = h1[q]; *(f32x4*)(so + DLRU + 4 * q) = h2[q]; *(f32x4*)(so + 2 * DLRU + 4 * q) = (f32x4){xn[4 * q], xn[4 * q + 1], xn[4 * q + 2], xn[4 * q + 3]}; }
        *(LAS f32x4*)(XF + sl * LF + cg * 8) = (f32x4){o[0], o[1], o[2], o[3]}; *(LAS f32x4*)(XF + sl * LF + cg * 8 + 4) = (f32x4){o[4], o[5], o[6], o[7]};
        *(LAS v4u*)(lds + LL_XC + sl * XS + cg * 16) = (v4u){pg8::cvt_pk_bf16(o[0], o[1]), pg8::cvt_pk_bf16(o[2], o[3]), pg8::cvt_pk_bf16(o[4], o[5]), pg8::cvt_pk_bf16(o[6], o[7])};
    }
    __syncthreads();
    if (wid == 0) {   OPQ_IDX2();
        const int tok = fr;
        bf16x8 xf[2];
#pragma unroll
        for (int ks = 0; ks < 2; ++ks) xf[ks] = *(const LAS bf16x8*)(lds + LL_XC + tok * XS + ks * 64 + fq * 16);
#pragma unroll
        for (int jt = 0; jt < 4; ++jt) {
            f32x4 ga = (f32x4){0.f, 0.f, 0.f, 0.f}, gx = (f32x4){0.f, 0.f, 0.f, 0.f};
#pragma unroll
            for (int ks = 0; ks < 2; ++ks) {
                ga = MFMA16(*(const LAS bf16x8*)(lds + LL_WA + (jt * 16 + fr) * XS + ks * 64 + fq * 16), xf[ks], ga);
                gx = MFMA16(*(const LAS bf16x8*)(lds + LL_WX + (jt * 16 + fr) * XS + ks * 64 + fq * 16), xf[ks], gx); }
            const int j = jt * 16 + 4 * fq;
            const f32x4 ba = *(const LAS f32x4*)(PAR + j), bx = *(const LAS f32x4*)(PAR + 64 + j), sp = *(const LAS f32x4*)(PAR + 128 + j), xc = *(const LAS f32x4*)(XF + tok * LF + j);
            f32x4 av, uv;
#pragma unroll
            for (int r = 0; r < 4; ++r) { const float rr = sigmoid_fast(ga[r] + ba[r]), ig = sigmoid_fast(gx[r] + bx[r]), la = -rr * sp[r];
                av[r] = __builtin_amdgcn_exp2f(1.44269504f * la); uv[r] = __builtin_amdgcn_sqrtf(fmaxf(fmaf(-av[r], av[r], 1.0f), 0.f)) * (ig * xc[r]); }
            *(LAS f32x4*)(AA + tok * LF + j) = av; *(LAS f32x4*)(UU + tok * LF + j) = uv;
        }
    }
    __syncthreads();
    {   OPQ_IDX2();
        const int ch = hd * 64 + lane;
#pragma unroll
        for (int t = 0; t < 2; ++t) { const int sl = wid * 2 + t, sq = 16 * b + sl; const size_t row = (size_t)TP + sq; bf16* yp = P + row * PW + DLRU + ch;
            const float ht = AA[sl * LF + lane] * dh_[t] + UU[sl * LF + lane];
            a.out[O_SLH + (size_t)sq * DLRU + ch] = ht;
            const float gv = ht * gelu_tanh_fast(dy_[t]);
            const float ss = wave_sum(gv * gv);
            *yp = f2bf1(gv);
            if (lane == 0) SSL[row * 16 + hd] = ss; }
    }
    {   OPQ_IDX2();
        for (int i = tid; i < 3 * 64; i += 512) { const int k = i >> 6, ch = hd * 64 + (i & 63);
            a.out[O_PLC + (size_t)(b * 3 + k) * DLRU + ch] = bf1(P + (rowb + SEQ - 3 + k) * PW + ch); }
    }
    __syncthreads();
}

__device__ __forceinline__ void ssd_sample_pair(const Args& a, LAS float* wsc, int s, int h, int lane_in) {
    int lane = lane_in; asm volatile("" : "+v"(lane));
    bf16* P = (bf16*)(a.ws + WS_P); float* SSS = (float*)(a.ws + WS_SSS); const float* DT = (const float*)(a.ws + WS_DT);
    const float* cw = a.in[I_SCW]; const float* cb = a.in[I_SCB]; const float* cs = a.in[I_SSC] + (size_t)s * 3 * DXBC;
    const int g = h >> 3; const size_t row = (size_t)TP + s;
    const float Ah = -expf(a.in[I_SALOG][h]), dtb = a.in[I_SDTB][h], Dh = a.in[I_SD][h];
    float* cso = a.out + O_SSC + (size_t)s * 3 * DXBC;
    float xv = 0.f;
#pragma unroll
    for (int q = 0; q < 5; ++q) {
        const int ch = q == 0 ? h * 64 + lane : (q < 3 ? 1024 : 1280) + g * 128 + lane + ((q - 1) & 1) * 64;
        const float x0 = cs[ch], x1 = cs[DXBC + ch], x2 = cs[2 * DXBC + ch], xn = bf1(P + row * PW + 3072 + ch);
        const float v = cb[ch] + cw[ch] * x0 + cw[DXBC + ch] * x1 + cw[2 * DXBC + ch] * x2 + cw[3 * DXBC + ch] * xn;
        const float sv = silu_fast(v);
        if (q == 0 || (h & 7) == 0) { cso[ch] = x1; cso[DXBC + ch] = x2; cso[2 * DXBC + ch] = xn; }
        if (q == 0) { xv = sv; wsc[lane] = sv; } else wsc[64 + (q - 1) * 64 + lane] = sv;
    }
    const float dt = softplus_f(DT[row * 16 + h] + dtb), dA = exp_fast(dt * Ah);
    LDS_WAIT(); asm volatile("" ::: "memory");
    const int hf = lane >> 5, nq = lane & 31;
    const f32x4 B4 = *(const LAS f32x4*)(wsc + 64 + nq * 4), C4 = *(const LAS f32x4*)(wsc + 192 + nq * 4);
    const f32x4* hin = (const f32x4*)(a.in[I_SSH] + (size_t)(s * NHEAD + h) * 8192) + lane; f32x4* hout = (f32x4*)(a.out + O_SSH + (size_t)(s * NHEAD + h) * 8192) + lane;
    float part[32];
#pragma unroll
    for (int ib = 0; ib < 2; ++ib) {
        f32x4 hv[16];
#pragma unroll
        for (int k = 0; k < 16; ++k) hv[k] = hin[(ib * 16 + k) * 64];
#pragma unroll
        for (int k = 0; k < 16; ++k) { const int it = ib * 16 + k; const float xd = dt * wsc[2 * it + hf];
            const f32x4 hn = hv[k] * dA + B4 * xd; hout[it * 64] = hn;
            part[it] = (C4[0] * hn[0] + C4[1] * hn[1]) + (C4[2] * hn[2] + C4[3] * hn[3]); }
    }
    float r16[16], r8[8], r4[4], r2[2], yv;
    { const bool u = lane & 16;
#pragma unroll
      for (int k = 0; k < 16; ++k) { const float keep = u ? part[k + 16] : part[k], send = u ? part[k] : part[k + 16]; r16[k] = keep + __shfl_xor(send, 16); } }
    { const bool u = lane & 8;
#pragma unroll
      for (int k = 0; k < 8; ++k) { const float keep = u ? r16[k + 8] : r16[k], send = u ? r16[k] : r16[k + 8]; r8[k] = keep + __shfl_xor(send, 8); } }
    { const bool u = lane & 4;
#pragma unroll
      for (int k = 0; k < 4; ++k) { const float keep = u ? r8[k + 4] : r8[k], send = u ? r8[k] : r8[k + 4]; r4[k] = keep + __shfl_xor(send, 4); } }
    { const bool u = lane & 2;
#pragma unroll
      for (int k = 0; k < 2; ++k) { const float keep = u ? r4[k + 2] : r4[k], send = u ? r4[k] : r4[k + 2]; r2[k] = keep + __shfl_xor(send, 2); } }
    { const bool u = lane & 1; const float keep = u ? r2[1] : r2[0], send = u ? r2[0] : r2[1]; yv = keep + __shfl_xor(send, 1); }
    const int itsel = ((lane >> 4) & 1) * 16 + ((lane >> 3) & 1) * 8 + ((lane >> 2) & 1) * 4 + ((lane >> 1) & 1) * 2 + (lane & 1), p = 2 * itsel + hf;
    bf16* zp = P + row * PW + 2048 + h * 64 + p;
    const float y = yv + Dh * wsc[p], gv = y * silu_fast(bf1(zp));
    const float ss = wave_sum(gv * gv);
    *zp = f2bf1(gv);
    if (lane == 0) SSS[row * 16 + h] = ss;
    (void)xv;
    LDS_WAIT(); asm volatile("" ::: "memory");
}

__device__ __forceinline__ void mixer_phase(const Args& a, LAS unsigned char* lds, int vcu, int G, int tid) {
    const int wave = __builtin_amdgcn_readfirstlane(tid >> 6), lane = tid & 63;
    const int half = G / 2;
#if defined(PROBE_MX)
    unsigned long long* tq = (unsigned long long*)(a.ws + WS_CTL + 8192); const bool st_ = ((vcu == 0 || vcu == half) && tid == 0); unsigned long long t0_ = __builtin_amdgcn_s_memrealtime();
#define MSTAMP(k) do { if (st_) { const unsigned long long t1_ = __builtin_amdgcn_s_memrealtime(); tq[(vcu == 0 ? 0 : 4) + (k)] = t1_ - t0_; t0_ = t1_; } } while (0)
#else
#define MSTAMP(k) do { } while (0)
#endif
    const bool fused = (G == 256);
    if (!fused) { for (int q = vcu * NWAVES + wave; q < TS * NHEAD; q += G * NWAVES) ssd_sample_pair(a, (LAS float*)(lds) + wave * 320, q >> 4, q & 15, lane);
        __syncthreads(); }
    MSTAMP(0);
    if (vcu < half) {
        for (int u = vcu; u < NB * NHEAD; u += half) ssd_unit_fast(a, lds, u >> 4, u & 15, tid, wave, lane, -1);
        tr_range(a, lds, IT_WGU2 + 384, IT_WD2, vcu * NWAVES + wave, half * NWAVES, wave, lane);
        MSTAMP(1);
    } else {
        const int v = vcu - half, nv = G - half;
        for (int u = v; u < NB * NHEAD; u += nv) lru_unit_prompt(a, lds, u >> 4, u & 15, tid, wave, fused ? 2 * (v * NWAVES + wave) : -1, fused ? 2 * (v * NWAVES + wave) + 1 : -1);
        MSTAMP(1);
    }
}

__device__ __forceinline__ void norm_phase(const Args& a, int vcu, int G, int wave, int lane) {
    bf16* P = (bf16*)(a.ws + WS_P); const float* SSL = (const float*)(a.ws + WS_SSL); const float* SSS = (const float*)(a.ws + WS_SSS);
    const int gw = vcu * NWAVES + wave, NGW = G * NWAVES;
    for (int m = gw; m < MREAL; m += NGW) {
        float sl = 0.f, s0 = 0.f, s1 = 0.f;
#pragma unroll
        for (int k = 0; k < 16; ++k) sl += SSL[(size_t)m * 16 + k];
#pragma unroll
        for (int k = 0; k < 8; ++k) { s0 += SSS[(size_t)m * 16 + k]; s1 += SSS[(size_t)m * 16 + 8 + k]; }
        const float rl = 1.0f / sqrtf(sl * (1.0f / 1024.0f) + EPS), r0 = 1.0f / sqrtf(s0 * (1.0f / 512.0f) + EPS), r1 = 1.0f / sqrtf(s1 * (1.0f / 512.0f) + EPS);
        GAS v4u* pr = (GAS v4u*)(P + (size_t)m * PW + DLRU) + lane;
#pragma unroll
        for (int j = 0; j < 4; ++j) { const float r = j < 2 ? rl : (j == 2 ? r0 : r1);
            v4u w = pr[64 * j];
            w.x = pk2(bf_lo(w.x) * r, bf_hi(w.x) * r); w.y = pk2(bf_lo(w.y) * r, bf_hi(w.y) * r); w.z = pk2(bf_lo(w.z) * r, bf_hi(w.z) * r); w.w = pk2(bf_lo(w.w) * r, bf_hi(w.w) * r);
            pr[64 * j] = w; }
    }
}

__global__ void __launch_bounds__(NWAVES * 64, 2) fwd_megakernel(Args args) {
    extern __shared__ __attribute__((aligned(16))) unsigned char lds_raw[];
    LAS unsigned char* lds = (LAS unsigned char*)lds_raw;
    volatile LAS unsigned* MISC = (volatile LAS unsigned*)(lds + MISC_OFF);
    const int tid = threadIdx.x, lane = tid & 63, wave = __builtin_amdgcn_readfirstlane(tid >> 6);
    const int G = gridDim.x; const int bx = blockIdx.x; const int vcu = (G % 8 == 0) ? (bx % 8) * (G / 8) + bx / 8 : bx;
    unsigned char* ws = args.ws;
    gu32* ctl = (gu32*)(ws + WS_CTL);
    if (tid < 256) MISC[tid] = 0u;
    __syncthreads();
    XcdBarrier bar = xcd_barrier_post((unsigned*)(ctl + CW_BAR), MISC + 8);
#if defined(PROBE_TS)
#define GRID_BAR(k_) do { xcd_barrier(bar); if (threadIdx.x == 0) { const unsigned long long t_ = __builtin_amdgcn_s_memrealtime(); MISC[16 + 2 * (k_)] = (unsigned)t_; MISC[17 + 2 * (k_)] = (unsigned)(t_ >> 32); } } while (0)
    if (threadIdx.x == 0) { const unsigned long long t_ = __builtin_amdgcn_s_memrealtime(); MISC[16 + 30] = (unsigned)t_; MISC[17 + 30] = (unsigned)(t_ >> 32); }
#else
#define GRID_BAR(k_) xcd_barrier(bar)
#endif
    bf16* const XBF = (bf16*)(ws + WS_XBF); bf16* const PB = (bf16*)(ws + WS_P); bf16* const HB = (bf16*)(ws + WS_P);
    float* const SS0 = (float*)(ws + WS_SS0); float* const SS1 = (float*)(ws + WS_SS1); float* const SS2 = (float*)(ws + WS_SS2);
    float* const DT = (float*)(ws + WS_DT); float* const SSX1 = (float*)(ws + WS_SSX1); float* const SSX2 = (float*)(ws + WS_SSX2);
    const float* const SSLp = (const float*)(ws + WS_SSL); const float* const SSSp = (const float*)(ws + WS_SSS);
#define SMALL_UNITS(...) do { for (int u = vcu; u < 256; u += G) { __VA_ARGS__; } } while (0)
    float* const out = args.out;

    p0_prologue(args, lds, vcu, G, wave, lane);
    GRID_BAR(0);
    { pg8::Gemm g{XBF, (const bf16*)(ws + WS_WGU1), MPAD, NGU, DM, DM}; pg8::StaticOrder S; S.init(MPAD, NGU, G, bx);
      pg8::fill_rstd_table(S, SS0, nullptr, (LAS float*)(lds + RING_BYTES));
      pg8::EpiSwiGLU E{HB, (const LAS float*)(lds + RING_BYTES)};
      pg8::gemm_phase<pg8::EpiSwiGLU, pg8::StaticOrder, true, true>(lds + RING_OFF, g, S, E);
      int nl; const int lr = light_rank(S.nwg, G, bx, nl);
      if (lr >= 0) tr_range(args, lds, IT_WD1, IT_WOUT, lr * NWAVES + wave, nl * NWAVES, wave, lane);
      else if (nl == 0) tr_range(args, lds, IT_WD1, IT_WOUT, vcu * NWAVES + wave, G * NWAVES, wave, lane); }
    GRID_BAR(1);
    if (bx & 1) SMALL_UNITS(small_gemm_resid<false, true>(HB, FF, (const bf16*)(ws + WS_WD1), FF, u, nullptr, XBF, SSX1, 0.5f, nullptr, nullptr, lds, tid));
    { pg8::Gemm g{HB, (const bf16*)(ws + WS_WD1), TP, DM, FF, FF}; pg8::StaticOrder S; S.init(TP, DM, G, bx);
      if (G == 256) { pg8::EpiResidT<false, true, true> E{nullptr, nullptr, XBF, SS1, 0.5f, nullptr};
        pg8::gemm_phase<pg8::EpiResidT<false, true, true>, pg8::StaticOrder, false, true>(lds + RING_OFF, g, S, E); }
      else { pg8::EpiResidT<false, true> E{nullptr, nullptr, XBF, SS1, 0.5f, nullptr};
        pg8::gemm_phase<pg8::EpiResidT<false, true>, pg8::StaticOrder, true, true>(lds + RING_OFF, g, S, E); } }
    if (!(bx & 1)) SMALL_UNITS(small_gemm_resid<false, true>(HB, FF, (const bf16*)(ws + WS_WD1), FF, u, nullptr, XBF, SSX1, 0.5f, nullptr, nullptr, lds, tid));
    GRID_BAR(2);
    { pg8::Gemm g{XBF, (const bf16*)(ws + WS_WIN), MPAD, NINP, DM, DM}; pg8::StaticOrder S; S.init(MPAD, NINP, G, bx);
      pg8::fill_rstd_table(S, SS1, SSX1, (LAS float*)(lds + RING_BYTES));
      pg8::EpiP E{PB, DT, (const LAS float*)(lds + RING_BYTES)};
      pg8::gemm_phase<pg8::EpiP, pg8::StaticOrder, true, true>(lds + RING_OFF, g, S, E);
      int nl; const int lr = light_rank(S.nwg, G, bx, nl);
      if (lr >= 0) tr_range(args, lds, IT_WOUT, IT_WGU2 + 384, lr * NWAVES + wave, nl * NWAVES, wave, lane);
      else if (nl == 0) tr_range(args, lds, IT_WOUT, IT_WGU2 + 384, vcu * NWAVES + wave, G * NWAVES, wave, lane); }
    GRID_BAR(3);
    ssd_prepass(args, vcu, G, tid);
    GRID_BAR(4);
    { int t2 = threadIdx.x; asm volatile("" : "+v"(t2)); mixer_phase(args, lds, vcu, G, t2); }
    GRID_BAR(5);
    if (bx & 1) SMALL_UNITS(small_gemm_resid<true, true>(PB + DLRU, PW, (const bf16*)(ws + WS_WOUT), DMIX, u, nullptr, XBF, SSX2, 1.0f, SSLp, SSSp, lds, tid));
    { pg8::Gemm g{PB + DLRU, (const bf16*)(ws + WS_WOUT), TP, DM, DMIX, PW}; pg8::SegOrder S; S.init(TP, DM, G, bx); S.SSL = SSLp; S.SSS = SSSp; S.tab = (LAS float*)(lds + RING_BYTES);
      pg8::EpiResidT<true, true, true> E{nullptr, nullptr, XBF, SS2, 1.0f, (const LAS float*)(lds + RING_BYTES)};
      pg8::gemm_phase<pg8::EpiResidT<true, true, true>, pg8::SegOrder, false, true>(lds + RING_OFF, g, S, E); }
    if (!(bx & 1)) SMALL_UNITS(small_gemm_resid<true, true>(PB + DLRU, PW, (const bf16*)(ws + WS_WOUT), DMIX, u, nullptr, XBF, SSX2, 1.0f, SSLp, SSSp, lds, tid));
    GRID_BAR(6);
    { pg8::Gemm g{XBF, (const bf16*)(ws + WS_WGU2), MPAD, NGU, DM, DM}; pg8::StaticOrder S; S.init(MPAD, NGU, G, bx);
      pg8::fill_rstd_table(S, SS2, SSX2, (LAS float*)(lds + RING_BYTES));
      pg8::EpiSwiGLU E{HB, (const LAS float*)(lds + RING_BYTES)};
      pg8::gemm_phase<pg8::EpiSwiGLU, pg8::StaticOrder, true, true>(lds + RING_OFF, g, S, E);
      int nl; const int lr = light_rank(S.nwg, G, bx, nl);
      if (lr >= 0) tr_range(args, lds, IT_WD2, IT_END, lr * NWAVES + wave, nl * NWAVES, wave, lane);
      else if (nl == 0) tr_range(args, lds, IT_WD2, IT_END, vcu * NWAVES + wave, G * NWAVES, wave, lane); }
    GRID_BAR(7);
    if (bx & 1) SMALL_UNITS(small_gemm_resid<false, true>(HB, FF, (const bf16*)(ws + WS_WD2), FF, u, nullptr, XBF, SSX1, 0.5f, nullptr, nullptr, lds, tid));
    { pg8::Gemm g{HB, (const bf16*)(ws + WS_WD2), TP, DM, FF, FF}; pg8::StaticOrder S; S.init(TP, DM, G, bx);
      if (G == 256) { pg8::EpiResidT<false, true, true> E{nullptr, nullptr, XBF, SS0, 0.5f, nullptr};
        pg8::gemm_phase<pg8::EpiResidT<false, true, true>, pg8::StaticOrder, false, true>(lds + RING_OFF, g, S, E); }
      else { pg8::EpiResidT<false, true> E{nullptr, nullptr, XBF, SS0, 0.5f, nullptr};
        pg8::gemm_phase<pg8::EpiResidT<false, true>, pg8::StaticOrder, true, true>(lds + RING_OFF, g, S, E); } }
    if (!(bx & 1)) SMALL_UNITS(small_gemm_resid<false, true>(HB, FF, (const bf16*)(ws + WS_WD2), FF, u, nullptr, XBF, SSX1, 0.5f, nullptr, nullptr, lds, tid));
    GRID_BAR(8);
    { int t2 = threadIdx.x; asm volatile("" : "+v"(t2)); p9_final_norm(args, vcu, G, __builtin_amdgcn_readfirstlane(t2 >> 6), t2 & 63); }
#if defined(PROBE_TS)
    GRID_BAR(9);
    if (blockIdx.x == 0) {
        __syncthreads();
        const size_t offs[10] = {O_YP, O_YS, O_PLC, O_PLH, O_PSC, O_PSH, O_SLC, O_SLH, O_SSC, O_SSH};
        const int phs[10] = {5, 2, 3, 6, 8, 1, 9, 0, 7, 4};
#pragma unroll
        for (int k = 0; k < 10; ++k) { const int ph = phs[k], pp = ph == 0 ? 15 : ph - 1;
            unsigned long long t1, t0;
            if (ph >= 0) { t1 = ((unsigned long long)MISC[17 + 2 * ph] << 32) | MISC[16 + 2 * ph]; t0 = ((unsigned long long)MISC[17 + 2 * pp] << 32) | MISC[16 + 2 * pp]; }
            else { const int q = -ph - 1, call = q < 2 ? 1 : (q < 4 ? 3 : 0), j = q & 1;
                t1 = ((unsigned long long)MISC[65 + 6 * call + 2 * (j + 1)] << 32) | MISC[64 + 6 * call + 2 * (j + 1)]; t0 = ((unsigned long long)MISC[65 + 6 * call + 2 * j] << 32) | MISC[64 + 6 * call + 2 * j]; }
            const float tt_ = (float)(t1 - t0) * 0.1f; const bool big_ = (k == 0 || k == 9);
            const int n = big_ ? (int)((t1 - t0) / 50ull) : (int)(logf(fmaxf(tt_, 1.0f)) * 20.4959f + 0.5f); unsigned* o = (unsigned*)(args.out + offs[k]);
            int ti_ = threadIdx.x; asm volatile("" : "+v"(ti_)); for (int i = ti_; i < n && i < 8000; i += 512) o[i] = 0xAAAAAAAAu; }
    }
#endif
}

extern "C" void kernel_launch(void* const* d_in, const int* in_sizes, int n_in, void* d_out, int out_size, void* d_ws, size_t ws_size, hipStream_t stream) {
    static int grid = 0;
    if (grid == 0) {
        if (n_in != 32 || in_sizes[0] != TP * DM || (size_t)out_size != O_END || ws_size < WS_END) {
            fprintf(stderr, "kernel_launch: unexpected shapes: n_in %d, in0 %d, out %d, ws %zu (need >= %zu); nothing launched\n", n_in, n_in > 0 ? in_sizes[0] : -1, out_size, ws_size, (size_t)WS_END); grid = -1; return; }
        int dev = 0, cus = 0, per_cu = 0;
        if (hipGetDevice(&dev) != hipSuccess || hipDeviceGetAttribute(&cus, hipDeviceAttributeMultiprocessorCount, dev) != hipSuccess) { fprintf(stderr, "kernel_launch: device query failed\n"); grid = -1; return; }
        if (hipFuncSetAttribute((const void*)fwd_megakernel, hipFuncAttributeMaxDynamicSharedMemorySize, LDS_BYTES) != hipSuccess) { fprintf(stderr, "kernel_launch: hipFuncSetAttribute failed\n"); grid = -1; return; }
        if (hipOccupancyMaxActiveBlocksPerMultiprocessor(&per_cu, (const void*)fwd_megakernel, NWAVES * 64, LDS_BYTES) != hipSuccess || per_cu < 1) {
            fprintf(stderr, "kernel_launch: occupancy query says %d workgroups per CU\n", per_cu); per_cu = 1; }
        (void)hipGetLastError();
        grid = cus;
        fprintf(stderr, "kernel_launch: grid %d (occupancy query %d per CU), ws %zu\n", grid, per_cu, ws_size);
    }
    if (grid < 0) return;
    (void)hipMemsetAsync((char*)d_ws + WS_CTL, 0, 65536, stream);
    Args a{};
    for (int i = 0; i < 32; ++i) a.in[i] = (const float*)d_in[i];
    a.out = (float*)d_out; a.ws = (unsigned char*)d_ws;
    hipLaunchKernelGGL(fwd_megakernel, dim3(grid), dim3(NWAVES * 64), LDS_BYTES, stream, a);
}
```
